# Optimizing an MI355X kernel written in HIP

```python
import jax, jax.numpy as jnp
from jax import lax
import numpy as np

D_MODEL = 1024
BATCH = 4
SEQ = 4096
DEPTH = 2

CTX_LEN = 256
GRID_W = 64

A_HEADS = 4
A_DK = 128
A_DV = 128
A_WIDTH = A_HEADS * A_DV
A_CHUNK = 64
B_GROUPS = 4
B_GW = 64
B_WIDTH = B_GROUPS * B_GW
B_CHUNK = 128
C_GROUPS = 4
C_WIDTH = 256
C_KERNEL = 31
MIX_WIDTH = A_WIDTH + B_WIDTH + C_WIDTH
IN_COLS = 5 * A_WIDTH + 2 * B_WIDTH + 2 * C_WIDTH
SPLITS = (A_WIDTH, 2 * A_WIDTH, 3 * A_WIDTH, 4 * A_WIDTH, 5 * A_WIDTH,
          5 * A_WIDTH + B_WIDTH, 5 * A_WIDTH + 2 * B_WIDTH, 5 * A_WIDTH + 2 * B_WIDTH + C_WIDTH)
D_FF = -(-8 * D_MODEL // (3 * 256)) * 256
EPS = 1e-6

kernel_name = 'hybrid_hgrn2_gmlp_conformer_dit'


def _rms_norm(x, g):
    x32 = x.astype(jnp.float32)
    y = x32 * lax.rsqrt(jnp.mean(x32 * x32, axis=-1, keepdims=True) + EPS)
    return (y * g.astype(jnp.float32)).astype(x.dtype)


def _group_layer_norm(x, g, b, groups):
    shp = x.shape
    x32 = x.astype(jnp.float32).reshape(shp[:-1] + (groups, shp[-1] // groups))
    mu = jnp.mean(x32, axis=-1, keepdims=True)
    var = jnp.mean(jnp.square(x32 - mu), axis=-1, keepdims=True)
    y = ((x32 - mu) * lax.rsqrt(var + EPS)).reshape(shp)
    return (y * g.astype(jnp.float32) + b.astype(jnp.float32)).astype(x.dtype)


def _modulate(h, shift, scale):
    return h * (1 + scale) + shift


def _hgrn2_chunk_scan(q, log_f, k, v, s0):
    bsz, t_len, h, _ = q.shape
    dv = v.shape[-1]
    n = t_len // A_CHUNK

    def to_chunks(a):
        return a.reshape(bsz, n, A_CHUNK, h, a.shape[-1]).transpose(1, 0, 3, 2, 4)

    mask = jnp.tril(jnp.ones((A_CHUNK, A_CHUNK), dtype=bool))[:, :, None]

    def step(s, inp):
        qc, lfc, kc, vc = inp
        b = jnp.cumsum(lfc, axis=2)
        inter = jnp.einsum('bhtk,bhkv->bhtv', qc * jnp.exp(b), s)
        diff = b[:, :, :, None, :] - b[:, :, None, :, :]
        decay = jnp.where(mask, jnp.exp(jnp.where(mask, diff, 0.0)), 0.0)
        scores = jnp.einsum('bhtk,bhtsk,bhsk->bhts', qc, decay, kc)
        intra = jnp.einsum('bhts,bhsv->bhtv', scores, vc)
        b_last = b[:, :, -1, :]
        k_dec = kc * jnp.exp(b_last[:, :, None, :] - b)
        s_new = jnp.exp(b_last)[..., None] * s + jnp.einsum('bhsk,bhsv->bhkv', k_dec, vc)
        return s_new, inter + intra

    s_t, o = lax.scan(step, s0, (to_chunks(q), to_chunks(log_f), to_chunks(k), to_chunks(v)))
    o = o.transpose(1, 0, 3, 2, 4).reshape(bsz, t_len, h, dv)
    return o, s_t


def _bidir_hgrn2(q, zf_fwd, zf_bwd, vi, lb, s0_f, s0_b):
    bsz, t_len, _ = q.shape
    lb = lb.astype(jnp.float32)

    def heads(a):
        return a.astype(jnp.float32).reshape(bsz, t_len, A_HEADS, -1)

    def gates(z, lb_d):
        z32 = z.astype(jnp.float32)
        f = lb_d + (1.0 - lb_d) * jax.nn.sigmoid(z32)
        k = (1.0 - lb_d) * jax.nn.sigmoid(-z32)
        return heads(jnp.log(f)), heads(k)

    qh, vh = heads(q), heads(vi)
    lf_f, k_f = gates(zf_fwd, lb[0])
    lf_b, k_b = gates(zf_bwd, lb[1])
    o_f, s_f = _hgrn2_chunk_scan(qh, lf_f, k_f, vh, s0_f)
    o_b, s_b = _hgrn2_chunk_scan(qh[:, ::-1], lf_b[:, ::-1], k_b[:, ::-1], vh[:, ::-1], s0_b)
    return o_f + o_b[:, ::-1], s_f, s_b


def _chunk_token_mlp(u, v, ln_g, ln_b, w_s, b_s):
    bsz, t_len, _ = u.shape
    n = t_len // B_CHUNK
    u = jax.nn.gelu(u)
    v = _group_layer_norm(jax.nn.gelu(v), ln_g, ln_b, B_GROUPS)
    vg = v.reshape(bsz, n, B_CHUNK, B_GROUPS, B_GW)
    mixed = jnp.einsum('gts,bnsgd->bntgd', w_s, vg) + b_s.T[:, :, None]
    return u * mixed.reshape(bsz, t_len, B_WIDTH)


def _conv_module(a, gate, dw_w, dw_b, ln_g, ln_b, pw_w, pw_b, n_seg):
    z = a * jax.nn.sigmoid(gate)
    bsz, t_len, ch = z.shape
    zs = z.reshape(bsz * n_seg, t_len // n_seg, ch)
    zs = lax.conv_general_dilated(zs, dw_w[:, None, :], window_strides=(1,),
                                  padding=[(C_KERNEL // 2, C_KERNEL // 2)],
                                  dimension_numbers=('NWC', 'WIO', 'NWC'),
                                  feature_group_count=ch)
    z = zs.reshape(bsz, t_len, ch) + dw_b
    z = jax.nn.silu(_group_layer_norm(z, ln_g, ln_b, C_GROUPS))
    return z @ pw_w + pw_b


def _token_mixer(p, lw, lb, s0_f, s0_b, n_seg):
    q, zf, zb, vi, g, u, v, ca, cg = jnp.split(p, SPLITS, axis=-1)
    bsz, t_len, _ = p.shape
    o, s_f, s_b = _bidir_hgrn2(q, zf, zb, vi, lb, s0_f, s0_b)
    o = o * lax.rsqrt(jnp.mean(o * o, axis=-1, keepdims=True) + EPS)
    o = o.reshape(bsz, t_len, A_WIDTH) * lw['hgrn_onorm_g'].astype(jnp.float32)
    ya = (o * jax.nn.silu(g.astype(jnp.float32))).astype(p.dtype)
    yb = _chunk_token_mlp(u, v, lw['gmlp_ln_g'], lw['gmlp_ln_b'], lw['gmlp_w_s'], lw['gmlp_b_s'])
    yc = _conv_module(ca, cg, lw['conv_dw_w'], lw['conv_dw_b'], lw['conv_ln_g'], lw['conv_ln_b'],
                      lw['conv_pw_w'], lw['conv_pw_b'], n_seg)
    y = jnp.concatenate([ya, yb, yc], axis=-1) @ lw['w_out']
    return y, s_f, s_b


def _swiglu(h, w13, w2):
    a, b = jnp.split(h @ w13, 2, axis=-1)
    return (jax.nn.silu(a) * b) @ w2


def _layer(x, ctx, c, c_ctx, lw, lb, rows, last):
    mod = jax.nn.silu(c) @ lw['ada_w'] + lw['ada_b']
    mod_ctx = jax.nn.silu(c_ctx) @ lw['ada_w'] + lw['ada_b']
    sh1, sc1, g1, sh2, sc2, g2 = jnp.split(mod[:, None, :], 6, axis=-1)
    csh1, csc1, cg1, csh2, csc2, cg2 = jnp.split(mod_ctx, 6)
    zero = jnp.zeros((x.shape[0], A_HEADS, A_DK, A_DV), jnp.float32)
    pc = _modulate(_rms_norm(ctx, lw['norm1_g']), csh1, csc1) @ lw['w_in']
    if last:
        qc, zfc, zbc, vic = jnp.split(pc[..., :4 * A_WIDTH], 4, axis=-1)
        _, s_f, s_b = _bidir_hgrn2(qc, zfc, zbc, vic, lb, zero, zero)
    else:
        yc, s_f, s_b = _token_mixer(pc, lw, lb, zero, zero, 1)
        ctx = ctx + cg1 * yc
        hc = _modulate(_rms_norm(ctx, lw['norm2_g']), csh2, csc2)
        ctx = ctx + cg2 * _swiglu(hc, lw['ffn_w13'], lw['ffn_w2'])
    px = _modulate(_rms_norm(x, lw['norm1_g']), sh1, sc1) @ lw['w_in']
    y, _, _ = _token_mixer(px, lw, lb, s_f, s_b, rows)
    x = x + g1 * y
    hx = _modulate(_rms_norm(x, lw['norm2_g']), sh2, sc2)
    x = x + g2 * _swiglu(hx, lw['ffn_w13'], lw['ffn_w2'])
    return x, ctx


def setup_inputs(seed: int = 0) -> dict:
    key = jax.random.key(seed)
    ks = jax.random.split(key, 25)
    f32 = jnp.float32
    L, D = DEPTH, D_MODEL

    def nrm(k, shape, scale):
        return jax.random.normal(k, shape, f32) * scale

    def gain(k, shape):
        return 1.0 + 0.01 * jax.random.normal(k, shape, f32)

    return {
        'x': nrm(ks[0], (BATCH, SEQ, D), 1.0),
        'c': nrm(ks[1], (BATCH, D), 1.0),
        'ctx': nrm(ks[2], (BATCH, CTX_LEN, D), 1.0),
        'c_ctx': nrm(ks[3], (D,), 1.0),
        'ada_w': nrm(ks[4], (L, D, 6 * D), 0.5 * D ** -0.5),
        'ada_b': nrm(ks[5], (L, 6 * D), 0.01),
        'norm1_g': gain(ks[6], (L, D)),
        'w_in': nrm(ks[7], (L, D, IN_COLS), D ** -0.5),
        'hgrn_lb_logits': nrm(ks[8], (L, 2, A_WIDTH), 1.0),
        'hgrn_onorm_g': gain(ks[9], (L, A_WIDTH)),
        'gmlp_ln_g': gain(ks[10], (L, B_WIDTH)),
        'gmlp_ln_b': nrm(ks[11], (L, B_WIDTH), 0.01),
        'gmlp_w_s': nrm(ks[12], (L, B_GROUPS, B_CHUNK, B_CHUNK), B_CHUNK ** -0.5),
        'gmlp_b_s': gain(ks[13], (L, B_GROUPS, B_CHUNK)),
        'conv_dw_w': nrm(ks[14], (L, C_KERNEL, C_WIDTH), C_KERNEL ** -0.5),
        'conv_dw_b': nrm(ks[15], (L, C_WIDTH), 0.01),
        'conv_ln_g': gain(ks[16], (L, C_WIDTH)),
        'conv_ln_b': nrm(ks[17], (L, C_WIDTH), 0.01),
        'conv_pw_w': nrm(ks[18], (L, C_WIDTH, C_WIDTH), C_WIDTH ** -0.5),
        'conv_pw_b': nrm(ks[19], (L, C_WIDTH), 0.01),
        'w_out': nrm(ks[20], (L, MIX_WIDTH, D), MIX_WIDTH ** -0.5),
        'norm2_g': gain(ks[21], (L, D)),
        'ffn_w13': nrm(ks[22], (L, D, 2 * D_FF), D ** -0.5),
        'ffn_w2': nrm(ks[23], (L, D_FF, D), D_FF ** -0.5),
        'final_norm_g': gain(ks[24], (D,)),
    }


def reference(x, c, ctx, c_ctx, ada_w, ada_b, norm1_g, w_in, hgrn_lb_logits, hgrn_onorm_g,
              gmlp_ln_g, gmlp_ln_b, gmlp_w_s, gmlp_b_s, conv_dw_w, conv_dw_b, conv_ln_g,
              conv_ln_b, conv_pw_w, conv_pw_b, w_out, norm2_g, ffn_w13, ffn_w2, final_norm_g):
    rows = x.shape[1] // GRID_W
    lb_p = jax.nn.softmax(hgrn_lb_logits.astype(jnp.float32), axis=0)
    lbs = jnp.cumsum(lb_p, axis=0) - lb_p[0:1]
    for l in range(DEPTH):
        lw = {
            'ada_w': ada_w[l], 'ada_b': ada_b[l], 'norm1_g': norm1_g[l], 'w_in': w_in[l],
            'hgrn_onorm_g': hgrn_onorm_g[l], 'gmlp_ln_g': gmlp_ln_g[l], 'gmlp_ln_b': gmlp_ln_b[l],
            'gmlp_w_s': gmlp_w_s[l], 'gmlp_b_s': gmlp_b_s[l], 'conv_dw_w': conv_dw_w[l],
            'conv_dw_b': conv_dw_b[l], 'conv_ln_g': conv_ln_g[l], 'conv_ln_b': conv_ln_b[l],
            'conv_pw_w': conv_pw_w[l], 'conv_pw_b': conv_pw_b[l], 'w_out': w_out[l],
            'norm2_g': norm2_g[l], 'ffn_w13': ffn_w13[l], 'ffn_w2': ffn_w2[l],
        }
        x, ctx = _layer(x, ctx, c, c_ctx, lw, lbs[l], rows, l == DEPTH - 1)
    return _rms_norm(x, final_norm_g)
```

```cpp
#include <hip/hip_runtime.h>
#include <hip/hip_cooperative_groups.h>
#include <cstdio>
namespace cg = cooperative_groups;
#define USE_XCD_BAR 1
#ifndef USE_XCD_BAR
#define GRID_BAR() grid.sync()
#else
#define GRID_BAR() xcd_barrier(bar)
#endif

#define LAS __attribute__((address_space(3)))
typedef unsigned short bf16_t;
typedef short bf16x8 __attribute__((ext_vector_type(8)));
typedef float f32x4 __attribute__((ext_vector_type(4)));
typedef float f32x2 __attribute__((ext_vector_type(2)));
typedef unsigned u32x4 __attribute__((ext_vector_type(4)));
typedef unsigned u32x2 __attribute__((ext_vector_type(2)));

constexpr int DM = 1024, NBATCH = 4, SEQ = 4096, CTXL = 256;
constexpr int MC = NBATCH * CTXL;
constexpr int ML = NBATCH * SEQ;
constexpr int MT = MC + ML;
constexpr int INC = 3584, DFF = 2816;
constexpr float EPS = 1e-6f;
constexpr int NTHR = 512;
constexpr int LDS_BYTES = 139264;
constexpr int LDS_BARW = LDS_BYTES - 64;

constexpr size_t WS_CTL = 0;
constexpr size_t CTL_BYTES = 16384;
constexpr size_t WS_MOD = 65536;
constexpr size_t WS_DEC = WS_MOD + 262144;
constexpr size_t WS_WT = WS_DEC + 524288;
constexpr size_t WT_IN = 0, WT_OUT = WT_IN + (size_t)INC * DM * 2, WT_13 = WT_OUT + (size_t)DM * DM * 2,
                 WT_2 = WT_13 + (size_t)2 * DFF * DM * 2, WT_PW = WT_2 + (size_t)DM * DFF * 2, WT_LAYER = WT_PW + (size_t)256 * 256 * 2;
constexpr size_t WS_XC = WS_WT + 2 * WT_LAYER;
constexpr size_t WS_ABF = WS_XC + (size_t)MC * DM * 4;
constexpr size_t WS_PX = WS_ABF + (size_t)MT * DM * 2;
constexpr size_t WS_US = WS_PX + (size_t)MT * INC * 2;
constexpr size_t WS_END = WS_US + (size_t)32 * 16 * 128 * 128 * 4;

__device__ __forceinline__ float bf2f(bf16_t v) { return __uint_as_float(((unsigned)v) << 16); }
__device__ __forceinline__ float bflo(unsigned w) { return __uint_as_float(w << 16); }
__device__ __forceinline__ float bfhi(unsigned w) { return __uint_as_float(w & 0xffff0000u); }
typedef __bf16 bf16x2_t __attribute__((ext_vector_type(2)));
__device__ __forceinline__ unsigned pk2(float lo, float hi) { const f32x2 v = {lo, hi}; const bf16x2_t b = __builtin_convertvector(v, bf16x2_t); return __builtin_bit_cast(unsigned, b); }
__device__ __forceinline__ bf16_t f2bf(float v) { return (bf16_t)(pk2(v, 0.f) & 0xffffu); }
__device__ __forceinline__ float sigmoidf_(float x) { return 1.0f / (1.0f + __expf(-x)); }
__device__ __forceinline__ float siluf_(float x) { return x * sigmoidf_(x); }
__device__ __forceinline__ float gelu_tanh(float x) { const float y = 0.7978845608028654f * (x + 0.044715f * x * x * x); return x * sigmoidf_(2.0f * y); }
__device__ __forceinline__ float wave_sum(float v) {
#pragma unroll
    for (int o = 1; o < 64; o <<= 1) v += __shfl_xor(v, o);
    return v;
}
__device__ __forceinline__ f32x4 mfma16(bf16x8 a, bf16x8 b, f32x4 c) { return __builtin_amdgcn_mfma_f32_16x16x32_bf16(a, b, c, 0, 0, 0); }
#define LDS_WAIT() asm volatile("s_waitcnt lgkmcnt(0)" ::: "memory")
__device__ __forceinline__ int fresh_tid() { int t = threadIdx.x; asm volatile("" : "+v"(t)); return t; }
#define PHASE_IDS() const int tid = fresh_tid(), lane = tid & 63, wid = __builtin_amdgcn_readfirstlane(tid >> 6); (void)lane; (void)wid

#define XB_TMO      128
#define XB_XCNT(j)  (256  + 64 * (j))
#define XB_XSUB(j)  (1280 + 64 * (j))
#define XB_XGEN(j)  (2304 + 64 * (j))
#define XB_TOP      3328
#define XB_TOPGEN   3392
#define XCD_BAR_WORDS 3456
#define XB_SPIN_CAP (1u << 20)
__device__ __forceinline__ unsigned xb_ld(unsigned* p)              { return __hip_atomic_load(p, __ATOMIC_RELAXED, __HIP_MEMORY_SCOPE_AGENT); }
__device__ __forceinline__ unsigned xb_add(unsigned* p, unsigned v) { return __hip_atomic_fetch_add(p, v, __ATOMIC_RELAXED, __HIP_MEMORY_SCOPE_AGENT); }
__device__ __forceinline__ unsigned xb_xcc_id() { return (unsigned)__builtin_amdgcn_s_getreg((3 << 11) | 20) & 0xFu; }
#define XB_SPIN(cond, bar) do { unsigned _sp = 0; while (cond) { __builtin_amdgcn_s_sleep(1); \
    if ((++_sp & 255u) == 0u) { if (xb_ld(&(bar)[XB_TMO])) break; if (_sp > XB_SPIN_CAP) { atomicAdd(&(bar)[XB_TMO], 1u); break; } } } } while (0)
struct XcdBarrier { unsigned* bar; unsigned x; volatile LAS unsigned* st; };
__device__ __forceinline__ XcdBarrier xcd_barrier_post(unsigned* bar, volatile LAS unsigned* st) {
    XcdBarrier b; b.bar = bar; b.x = xb_xcc_id(); b.st = st;
    if (threadIdx.x == 0) (void)xb_add(&bar[XB_XCNT(b.x)], 1u);
    return b;
}
__device__ __forceinline__ void xcd_barrier_complete(unsigned* bar, unsigned x, unsigned& nloc, unsigned& nx) {
    const unsigned G = gridDim.x * gridDim.y * gridDim.z;
    unsigned sum, cnt, mine, sp = 0u;
    for (;;) {
        sum = 0u; cnt = 0u; mine = 0u;
#pragma unroll
        for (unsigned j = 0; j < 16; ++j) { const unsigned c = xb_ld(&bar[XB_XCNT(j)]); sum += c; cnt += (c > 0u) ? 1u : 0u; mine = (j == x) ? c : mine; }
        if (sum == G) break;
        __builtin_amdgcn_s_sleep(1);
        if ((++sp & 255u) == 0u) { if (xb_ld(&bar[XB_TMO])) break; if (sp > XB_SPIN_CAP) { atomicAdd(&bar[XB_TMO], 1u); break; } }
    }
    nloc = mine > 0u ? mine : 1u; nx = cnt > 0u ? cnt : 1u;
}
__device__ __forceinline__ void xcd_barrier(const XcdBarrier& b) {
    asm volatile("s_waitcnt vmcnt(0)" ::: "memory");
    __syncthreads();
    if (threadIdx.x == 0) {
        unsigned* bar = b.bar;
        __builtin_amdgcn_s_waitcnt(0);
        unsigned nloc = b.st[0], nx = b.st[1];
        if (nloc == 0u) { xcd_barrier_complete(bar, b.x, nloc, nx); b.st[0] = nloc; b.st[1] = nx; }
        const unsigned old = xb_add(&bar[XB_XSUB(b.x)], 1u);
        const unsigned gen = old / nloc;
        if (old + 1u == (gen + 1u) * nloc) {
            __builtin_amdgcn_fence(__ATOMIC_RELEASE, "agent");
            asm volatile("s_waitcnt vmcnt(0)" ::: "memory");
            const unsigned og = xb_add(&bar[XB_TOP], 1u);
            const unsigned tg = og / nx;
            if (og + 1u == (tg + 1u) * nx) xb_add(&bar[XB_TOPGEN], 1u);
            else XB_SPIN(xb_ld(&bar[XB_TOPGEN]) == tg, bar);
            __builtin_amdgcn_fence(__ATOMIC_ACQUIRE, "agent");
            xb_add(&bar[XB_XGEN(b.x)], 1u);
            asm volatile("s_waitcnt vmcnt(0)" ::: "memory");
        } else {
            XB_SPIN(xb_ld(&bar[XB_XGEN(b.x)]) == gen, bar);
            __builtin_amdgcn_fence(__ATOMIC_ACQUIRE, "agent");
            asm volatile("s_waitcnt vmcnt(0)" ::: "memory");
        }
    }
    __syncthreads();
}

namespace pg8 {
constexpr int BM = 256, BK = 64, HALF = 128, HTB = HALF * BK * 2, STAGE_BYTES = 8 * HTB, NXCD = 8, WGM = 8;
__device__ __forceinline__ int lds_byte(int r, int c) { const int st = (r >> 4) * 2 + (c >> 5), rr = r & 15, cc = c & 31, ob = rr * 64 + cc * 2; return st * 1024 + (ob ^ (((ob >> 9) & 1) << 5)); }
__device__ __forceinline__ void stage_rc(int b, int& R, int& C) { const int st = b / 1024, sb = b % 1024, swz = sb ^ (((sb >> 9) & 1) << 5); R = (st >> 1) * 16 + swz / 64; C = (st & 1) * 32 + (swz % 64) / 2; }
__device__ __forceinline__ int perm32(int rho) { const int n = rho >> 4, i = rho & 15; return 8 * (i >> 2) + 4 * n + (i & 3); }
struct Unit { int pm, pn; };
struct Gemm { const bf16_t* A; const bf16_t* Bt; int M, N, K; };
struct StaticOrder {
    int nM, nN, nwg, G, c, pm0;
    __device__ void init(int nM_, int nN_, int G_, int c_, int pm0_) { nM = nM_; nN = nN_; nwg = nM * nN; G = G_; c = c_; pm0 = pm0_; }
    __device__ bool next(int i, Unit& u) const {
        const long L = (long)i * G + c; if (L >= nwg) return false;
        int wgid = (int)L; { const int q = nwg / NXCD, r = nwg % NXCD, xcd = wgid % NXCD, off = wgid / NXCD; wgid = (xcd < r ? xcd * (q + 1) : r * (q + 1) + (xcd - r) * q) + off; }
        const int nig = WGM * nN, gid = wgid / nig, fm = gid * WGM, gsz = (nM - fm) < WGM ? (nM - fm) : WGM;
        u.pm = pm0 + fm + ((wgid % nig) % gsz); u.pn = (wgid % nig) / gsz; return true;
    }
};

struct EpiBf16 {
    static constexpr bool PERM = true;
    bf16_t* O; int ldc;
    __device__ __forceinline__ void operator()(const f32x4 (&acc)[2][2][4][2], const Unit& u, int wr, int wc, int fr, int fq) const {
        const int row0 = u.pm * BM + wr * 64 + fr; const int col0 = u.pn * BM + wc * 32 + 8 * fq;
#pragma unroll
        for (int ai = 0; ai < 2; ++ai)
#pragma unroll
            for (int m = 0; m < 4; ++m) { bf16_t* rowp = O + (size_t)(row0 + ai * HALF + m * 16) * ldc + col0;
#pragma unroll
                for (int bj = 0; bj < 2; ++bj) { const f32x4 v0 = acc[ai][bj][m][0], v1 = acc[ai][bj][m][1];
                    u32x4 w; w.x = pk2(v0[0], v0[1]); w.y = pk2(v0[2], v0[3]); w.z = pk2(v1[0], v1[1]); w.w = pk2(v1[2], v1[3]);
                    *(u32x4*)(rowp + bj * HALF) = w; } }
    }
};
struct EpiSwiglu {
    static constexpr bool PERM = true;
    bf16_t* O; int ldc;
    __device__ __forceinline__ void operator()(const f32x4 (&acc)[2][2][4][2], const Unit& u, int wr, int wc, int fr, int fq) const {
        const int row0 = u.pm * BM + wr * 64 + fr; const int col0 = u.pn * HALF + wc * 32 + 8 * fq;
#pragma unroll
        for (int ai = 0; ai < 2; ++ai)
#pragma unroll
            for (int m = 0; m < 4; ++m) { bf16_t* rowp = O + (size_t)(row0 + ai * HALF + m * 16) * ldc + col0;
                float o[8];
#pragma unroll
                for (int n = 0; n < 2; ++n)
#pragma unroll
                    for (int j = 0; j < 4; ++j) { const float a = acc[ai][0][m][n][j], b = acc[ai][1][m][n][j]; o[n * 4 + j] = siluf_(a) * b; }
                u32x4 w; w.x = pk2(o[0], o[1]); w.y = pk2(o[2], o[3]); w.z = pk2(o[4], o[5]); w.w = pk2(o[6], o[7]);
                *(u32x4*)rowp = w; }
    }
};
struct EpiRes {
    static constexpr bool PERM = false;
    const float* base_c; const float* base_l; float* out_c; float* out_l; const float* gate;
    __device__ __forceinline__ void operator()(const f32x4 (&acc)[2][2][4][2], const Unit& u, int wr, int wc, int fr, int fq) const {
        const int bi = (u.pm < 4) ? 4 : ((u.pm - 4) >> 4);
        const float* base = (u.pm < 4) ? base_c + (size_t)u.pm * BM * DM : base_l + (size_t)(u.pm - 4) * BM * DM;
        float* out = (u.pm < 4) ? out_c + (size_t)u.pm * BM * DM : out_l + (size_t)(u.pm - 4) * BM * DM;
        const int row0 = wr * 64 + fr, col0 = u.pn * BM + wc * 32 + 4 * fq;
        f32x4 gv[2][2];
#pragma unroll
        for (int bj = 0; bj < 2; ++bj)
#pragma unroll
            for (int n = 0; n < 2; ++n) gv[bj][n] = *(const f32x4*)(gate + (size_t)bi * 6144 + col0 + bj * HALF + n * 16);
#pragma unroll
        for (int ai = 0; ai < 2; ++ai)
#pragma unroll
            for (int m = 0; m < 4; ++m) { const size_t off = (size_t)(row0 + ai * HALF + m * 16) * DM + col0;
#pragma unroll
                for (int bj = 0; bj < 2; ++bj)
#pragma unroll
                    for (int n = 0; n < 2; ++n) { const f32x4 bs = *(const f32x4*)(base + off + bj * HALF + n * 16);
                        *(f32x4*)(out + off + bj * HALF + n * 16) = bs + gv[bj][n] * acc[ai][bj][m][n]; }
                asm volatile("" ::: "memory"); }
    }
};

template <class Epi, class Sched>
__device__ __forceinline__ void gemm_phase(LAS unsigned char* lds, const Gemm g, const Sched& S, const Epi& E) {
    const int tid = fresh_tid(), wid = __builtin_amdgcn_readfirstlane(tid >> 6), lane = tid & 63, wr = wid >> 2, wc = wid & 3, fr = lane & 15, fq = lane >> 4;
    const int K = g.K, nt = K / BK;
    unsigned voffA[2], voffB[2];
#pragma unroll
    for (int i = 0; i < 2; ++i) { int R, C; stage_rc(tid * 16 + i * 8192, R, C); const int Rb = Epi::PERM ? ((R & ~31) + perm32(R & 31)) : R;
        voffA[i] = (unsigned)(R * K + C) * 2u; voffB[i] = (unsigned)(Rb * K + C) * 2u; }
    const size_t kstep = (size_t)(BK * 2);
    const size_t hstep = (size_t)HALF * K * 2;
    const size_t tstep = 2 * hstep;
    const unsigned ldsw = (unsigned)wid * 1024u;
    const int aoff = lds_byte(wr * 64 + fr, fq * 8), boff = lds_byte(wc * 32 + fr, fq * 8);
#define PG8_SA(b, h) (((b) * 2 + (h)) * HTB)
#define PG8_SB(b, h) ((4 + (b) * 2 + (h)) * HTB)
#define PG8_STAGE(bufoff, gbase, voff) do { _Pragma("unroll") for (int _i = 0; _i < 2; ++_i) \
        __builtin_amdgcn_global_load_lds((const unsigned*)((const char*)(gbase) + (voff)[_i]), (LAS unsigned*)(lds + (bufoff) + ldsw + _i * 8192), 16, 0, 0); } while (0)
#define PG8_LDA(dst, b, h) do { _Pragma("unroll") for (int m = 0; m < 4; ++m) _Pragma("unroll") for (int k = 0; k < 2; ++k) dst[m][k] = *(const LAS bf16x8*)(lds + PG8_SA(b, h) + aoff + m * 2048 + k * 1024); } while (0)
#define PG8_LDB(dst, b, h) do { _Pragma("unroll") for (int n = 0; n < 2; ++n) _Pragma("unroll") for (int k = 0; k < 2; ++k) dst[n][k] = *(const LAS bf16x8*)(lds + PG8_SB(b, h) + boff + n * 2048 + k * 1024); } while (0)
#define PG8_MMA(ai, bj, At, Bt) do { __builtin_amdgcn_s_setprio(1); _Pragma("unroll") for (int m = 0; m < 4; ++m) _Pragma("unroll") for (int n = 0; n < 2; ++n) _Pragma("unroll") for (int k = 0; k < 2; ++k) \
        acc[ai][bj][m][n] = __builtin_amdgcn_mfma_f32_16x16x32_bf16(Bt[n][k], At[m][k], acc[ai][bj][m][n], 0, 0, 0); __builtin_amdgcn_s_setprio(0); } while (0)
#define PG8_WAIT_V(n) asm volatile("s_waitcnt vmcnt(" #n ")" ::: "memory")
#define PG8_WAIT_L(n) asm volatile("s_waitcnt lgkmcnt(" #n ")" ::: "memory")
#define PG8_BAR __builtin_amdgcn_s_barrier()
#define PG8_SCHED __builtin_amdgcn_sched_barrier(0)
    Unit cur, nxt; int ui = 0;
    if (!S.next(0, cur)) return;
    f32x4 acc[2][2][4][2];
#pragma unroll
    for (int a = 0; a < 2; ++a)
#pragma unroll
        for (int b = 0; b < 2; ++b)
#pragma unroll
            for (int m = 0; m < 4; ++m)
#pragma unroll
                for (int n = 0; n < 2; ++n) acc[a][b][m][n] = (f32x4){0.f, 0.f, 0.f, 0.f};
    bf16x8 At[4][2], B0[2][2], B1[2][2];
    const char* cA = (const char*)g.A + (size_t)cur.pm * tstep; const char* cB = (const char*)g.Bt + (size_t)cur.pn * tstep;
    PG8_STAGE(PG8_SB(0, 0), cB, voffB); PG8_STAGE(PG8_SA(0, 0), cA, voffA); PG8_STAGE(PG8_SB(0, 1), cB + hstep, voffB); PG8_STAGE(PG8_SA(0, 1), cA + hstep, voffA);
    if (wr == 1) PG8_BAR;
    PG8_WAIT_V(4); PG8_BAR;
    PG8_STAGE(PG8_SB(1, 0), cB + kstep, voffB); PG8_STAGE(PG8_SA(1, 0), cA + kstep, voffA); PG8_STAGE(PG8_SB(1, 1), cB + hstep + kstep, voffB);
    PG8_WAIT_V(6); PG8_BAR;
    for (;;) {
        const bool has_next = S.next(ui + 1, nxt);
        const char* nA = has_next ? (const char*)g.A + (size_t)nxt.pm * tstep : cA; const char* nB = has_next ? (const char*)g.Bt + (size_t)nxt.pn * tstep : cB;
        for (int t = 0; t < nt; t += 2) {
            const bool last = (t == nt - 2);
            const char* a1 = cA + (size_t)(t + 1) * kstep;
            const char* a2 = last ? nA : cA + (size_t)(t + 2) * kstep; const char* b2 = last ? nB : cB + (size_t)(t + 2) * kstep;
            const char* a3 = a2 + kstep; const char* b3 = b2 + kstep;
            PG8_LDB(B0, 0, 0); PG8_SCHED; PG8_LDA(At, 0, 0); PG8_STAGE(PG8_SA(1, 1), a1 + hstep, voffA);
            PG8_WAIT_L(8); PG8_BAR; PG8_WAIT_L(0); PG8_MMA(0, 0, At, B0); PG8_BAR; PG8_SCHED;
            PG8_LDB(B1, 0, 1); PG8_STAGE(PG8_SB(0, 0), b2, voffB);
            PG8_BAR; PG8_WAIT_L(0); PG8_MMA(0, 1, At, B1); PG8_BAR;
            PG8_LDA(At, 0, 1); PG8_STAGE(PG8_SA(0, 0), a2, voffA);
            PG8_BAR; PG8_WAIT_L(0); PG8_MMA(1, 0, At, B0); PG8_BAR; PG8_SCHED;
            PG8_STAGE(PG8_SB(0, 1), b2 + hstep, voffB);
            PG8_WAIT_V(6); PG8_BAR; PG8_MMA(1, 1, At, B1); PG8_BAR;
            PG8_LDB(B0, 1, 0); PG8_SCHED; PG8_LDA(At, 1, 0); PG8_STAGE(PG8_SA(0, 1), a2 + hstep, voffA);
            PG8_WAIT_L(8); PG8_BAR; PG8_WAIT_L(0); PG8_MMA(0, 0, At, B0); PG8_BAR; PG8_SCHED;
            PG8_LDB(B1, 1, 1); PG8_STAGE(PG8_SB(1, 0), b3, voffB);
            PG8_BAR; PG8_WAIT_L(0); PG8_MMA(0, 1, At, B1); PG8_BAR;
            PG8_LDA(At, 1, 1); PG8_STAGE(PG8_SA(1, 0), a3, voffA);
            PG8_BAR; PG8_WAIT_L(0); PG8_MMA(1, 0, At, B0); PG8_BAR; PG8_SCHED;
            PG8_STAGE(PG8_SB(1, 1), b3 + hstep, voffB);
            PG8_WAIT_V(6); PG8_BAR; PG8_MMA(1, 1, At, B1); PG8_BAR;
        }
        E(acc, cur, wr, wc, fr, fq);
        if (!has_next) break;
#pragma unroll
        for (int a = 0; a < 2; ++a)
#pragma unroll
            for (int b = 0; b < 2; ++b)
#pragma unroll
                for (int m = 0; m < 4; ++m)
#pragma unroll
                    for (int n = 0; n < 2; ++n) acc[a][b][m][n] = (f32x4){0.f, 0.f, 0.f, 0.f};
        cur = nxt; cA = nA; cB = nB; ++ui;
    }
    PG8_WAIT_V(0);
    if (wr == 0) PG8_BAR;
    PG8_BAR;
#undef PG8_SA
#undef PG8_SB
#undef PG8_STAGE
#undef PG8_LDA
#undef PG8_LDB
#undef PG8_MMA
#undef PG8_WAIT_V
#undef PG8_WAIT_L
#undef PG8_BAR
#undef PG8_SCHED
}
}

struct Args {
    const float* in[25];
    float* out;
    unsigned char* ws;
};

struct Ctx {
    LAS unsigned char* lds;
    int G, bid;
};


__device__ __forceinline__ void transpose_item(const float* W, int K, int N, int k0, int nsrc0, bf16_t* WT, int ndst0, LAS float* scr, int lane) {
#pragma unroll 8
    for (int i = 0; i < 32; ++i) { const int kk = 2 * i + (lane >> 5); scr[kk * 33 + (lane & 31)] = W[(size_t)(k0 + kk) * N + nsrc0 + (lane & 31)]; }
    LDS_WAIT();
    const int c = lane & 7;
#pragma unroll
    for (int j = 0; j < 4; ++j) { const int n = (lane >> 3) + 8 * j; const LAS float* s = scr + (8 * c) * 33 + n;
        u32x4 o; o.x = pk2(s[0 * 33], s[1 * 33]); o.y = pk2(s[2 * 33], s[3 * 33]); o.z = pk2(s[4 * 33], s[5 * 33]); o.w = pk2(s[6 * 33], s[7 * 33]);
        *(u32x4*)(WT + (size_t)(ndst0 + n) * K + k0 + 8 * c) = o; }
    LDS_WAIT();
}

__device__ __forceinline__ void phase_p0(const Ctx& C, const Args& a) {
    PHASE_IDS();
    {
        LAS float* sc = (LAS float*)(C.lds);
        LAS float* red = (LAS float*)(C.lds + 20480);
        float* MOD = (float*)(a.ws + WS_MOD);
        for (int idx = tid; idx < 5 * 1024; idx += NTHR) { const int bi = idx >> 10, k = idx & 1023; const float v = bi < 4 ? a.in[1][bi * 1024 + k] : a.in[3][k]; sc[idx] = siluf_(v); }
        __syncthreads();
        for (int u = C.bid; u < 192; u += C.G) {
            const int l = u / 96, cb = u % 96, col = cb * 64 + lane;
            const float* W = a.in[4] + ((size_t)l * 1024 + wid * 128) * 6144 + col;
            float acc[5] = {0.f, 0.f, 0.f, 0.f, 0.f};
#pragma unroll 8
            for (int kk = 0; kk < 128; ++kk) { const float w = W[(size_t)kk * 6144]; const int k = wid * 128 + kk;
#pragma unroll
                for (int bi = 0; bi < 5; ++bi) acc[bi] += sc[bi * 1024 + k] * w; }
#pragma unroll
            for (int bi = 0; bi < 5; ++bi) red[(wid * 5 + bi) * 64 + lane] = acc[bi];
            __syncthreads();
            if (tid < 320) { const int bi = tid >> 6, ln = tid & 63; float s = a.in[5][l * 6144 + cb * 64 + ln];
#pragma unroll
                for (int w = 0; w < 8; ++w) s += red[(w * 5 + bi) * 64 + ln];
                MOD[((size_t)l * 5 + bi) * 6144 + cb * 64 + ln] = s; }
            __syncthreads();
        }
    }
    {
        LAS float* scr = (LAS float*)(C.lds + wid * 8448);
        const int gw = C.bid * 8 + wid, NGW = C.G * 8;
        constexpr int I_IN = 16 * 112, I_OUT = 16 * 32, I_13 = 16 * 176, I_2 = 44 * 32, I_PW = 4 * 8, I_L = I_IN + I_OUT + I_13 + I_2 + I_PW;
        for (int it = gw; it < 2 * I_L; it += NGW) {
            const int l = it / I_L; int r = it % I_L;
            unsigned char* wt = a.ws + WS_WT + (size_t)l * WT_LAYER;
            if (r < I_IN) { const int kb = r / 112, nb = r % 112; transpose_item(a.in[7] + (size_t)l * DM * INC, DM, INC, kb * 64, nb * 32, (bf16_t*)(wt + WT_IN), nb * 32, scr, lane); continue; } r -= I_IN;
            if (r < I_OUT) { const int kb = r / 32, nb = r % 32; transpose_item(a.in[20] + (size_t)l * DM * DM, DM, DM, kb * 64, nb * 32, (bf16_t*)(wt + WT_OUT), nb * 32, scr, lane); continue; } r -= I_OUT;
            if (r < I_13) { const int kb = r / 176, nb = r % 176; const int nd = nb * 32, pn = nd >> 8, bj = (nd >> 7) & 1, j = nd & 127;
                transpose_item(a.in[22] + (size_t)l * DM * 2 * DFF, DM, 2 * DFF, kb * 64, bj * DFF + pn * 128 + j, (bf16_t*)(wt + WT_13), nd, scr, lane); continue; } r -= I_13;
            if (r < I_2) { const int kb = r / 32, nb = r % 32; transpose_item(a.in[23] + (size_t)l * DFF * DM, DFF, DM, kb * 64, nb * 32, (bf16_t*)(wt + WT_2), nb * 32, scr, lane); continue; } r -= I_2;
            { const int kb = r / 8, nb = r % 8; transpose_item(a.in[18] + (size_t)l * 256 * 256, 256, 256, kb * 64, nb * 32, (bf16_t*)(wt + WT_PW), nb * 32, scr, lane); }
        }
    }
}

__device__ __forceinline__ void phase_norm(const Ctx& C, const float* srcc, const float* srcl, const float* g, const float* mod_l  , int shift_idx, int scale_idx, bf16_t* dst, int r_lo) {
    PHASE_IDS();
    const int gw = C.bid * 8 + wid, NGW = C.G * 8;
    f32x4 gv[4];
#pragma unroll
    for (int j = 0; j < 4; ++j) gv[j] = *(const f32x4*)(g + 4 * lane + 256 * j);
    for (int r = r_lo + gw; r < MT; r += NGW) {
        const float* xr = (r < MC) ? srcc + (size_t)r * DM : srcl + (size_t)(r - MC) * DM;
        const int bi = (r < MC) ? 4 : ((r - MC) >> 12);
        const float* sh = mod_l + (size_t)bi * 6144 + shift_idx * 1024; const float* sc = mod_l + (size_t)bi * 6144 + scale_idx * 1024;
        f32x4 v[4]; float s = 0.f;
#pragma unroll
        for (int j = 0; j < 4; ++j) { v[j] = *(const f32x4*)(xr + 4 * lane + 256 * j); s += (v[j][0] * v[j][0] + v[j][1] * v[j][1]) + (v[j][2] * v[j][2] + v[j][3] * v[j][3]); }
        const float rs = rsqrtf(wave_sum(s) * (1.0f / DM) + EPS);
#pragma unroll
        for (int j = 0; j < 4; ++j) { const f32x4 shv = *(const f32x4*)(sh + 4 * lane + 256 * j), scv = *(const f32x4*)(sc + 4 * lane + 256 * j);
            const f32x4 y = v[j] * rs * gv[j] * (scv + 1.0f) + shv;
            u32x2 w; w.x = pk2(y[0], y[1]); w.y = pk2(y[2], y[3]);
            *(u32x2*)(dst + (size_t)r * DM + 4 * lane + 256 * j) = w; }
    }
}
__device__ __forceinline__ void phase_final(const Ctx& C, float* out, const float* g) {
    PHASE_IDS();
    const int gw = C.bid * 8 + wid, NGW = C.G * 8;
    f32x4 gv[4];
#pragma unroll
    for (int j = 0; j < 4; ++j) gv[j] = *(const f32x4*)(g + 4 * lane + 256 * j);
    for (int r = gw; r < ML; r += NGW) {
        float* xr = out + (size_t)r * DM;
        f32x4 v[4]; float s = 0.f;
#pragma unroll
        for (int j = 0; j < 4; ++j) { v[j] = *(const f32x4*)(xr + 4 * lane + 256 * j); s += (v[j][0] * v[j][0] + v[j][1] * v[j][1]) + (v[j][2] * v[j][2] + v[j][3] * v[j][3]); }
        const float rs = rsqrtf(wave_sum(s) * (1.0f / DM) + EPS);
#pragma unroll
        for (int j = 0; j < 4; ++j) *(f32x4*)(xr + 4 * lane + 256 * j) = v[j] * rs * gv[j];
    }
}

constexpr int SC_QT = 0, SC_QS = 17408, SC_KT = 34816, SC_KDT = 52224, SC_VT = 70656, SC_ST = 89088, SC_P = 123904, SC_SEG = 133120, SC_DK = 135168;
template <int PASS>
__device__ __forceinline__ void scan_unit(const Ctx& C, int tid, bf16_t* px, float* US, float* DEC, const float* lbl, int layer, int seq, int sc) {
    const int dir = seq & 1, h = (seq >> 1) & 3, b = seq >> 3;
    const int lane = tid & 63, wid = __builtin_amdgcn_readfirstlane(tid >> 6), fr = lane & 15, fq = lane >> 4;
    LAS bf16_t* QT = (LAS bf16_t*)(C.lds + SC_QT);
    LAS bf16_t* QS = (LAS bf16_t*)(C.lds + SC_QS);
    LAS bf16_t* KT = (LAS bf16_t*)(C.lds + SC_KT);
    LAS bf16_t* KDT = (LAS bf16_t*)(C.lds + SC_KDT);
    LAS bf16_t* VT = (LAS bf16_t*)(C.lds + SC_VT);
    LAS bf16_t* ST = (LAS bf16_t*)(C.lds + SC_ST);
    LAS bf16_t* P = (LAS bf16_t*)(C.lds + SC_P);
    LAS float* SEG = (LAS float*)(C.lds + SC_SEG);
    LAS float* DK = (LAS float*)(C.lds + SC_DK);
    const int k = tid & 127, sg = tid >> 7;
    float lb = 0.f;
    if (layer == 1) { const float l0 = lbl[(0 * 2 + dir) * 512 + h * 128 + k], l1 = lbl[(1 * 2 + dir) * 512 + h * 128 + k]; lb = sigmoidf_(l1 - l0); }
    const float omlb = 1.0f - lb;
    const int zcol = (dir ? 1024 : 512) + h * 128;

    f32x4 accS[8];
    if (PASS == 1 || sc == 0) {
#pragma unroll
        for (int vb = 0; vb < 8; ++vb) accS[vb] = (f32x4){0.f, 0.f, 0.f, 0.f};
    } else {
        const float* S0 = US + ((size_t)(seq * 16 + sc - 1) * 128) * 128;
#pragma unroll
        for (int vb = 0; vb < 8; ++vb)
#pragma unroll
            for (int j = 0; j < 4; ++j) accS[vb][j] = S0[(size_t)(wid * 16 + 4 * fq + j) * 128 + vb * 16 + fr];
    }
    if (PASS == 3) {
#pragma unroll
        for (int vb = 0; vb < 8; ++vb) { u32x2 w; w.x = pk2(accS[vb][0], accS[vb][1]); w.y = pk2(accS[vb][2], accS[vb][3]);
            *(LAS u32x2*)(ST + (vb * 16 + fr) * 136 + wid * 16 + 4 * fq) = w; }
    }
    float dtot[4] = {1.f, 1.f, 1.f, 1.f};

    for (int c = 0; c < 4; ++c) {
        const int p0 = sc * 256 + c * 64;
        const int rbase = (p0 < 256) ? (b * 256 + (dir ? 255 - p0 : p0)) : (MC + b * 4096 + (dir ? 4095 - (p0 - 256) : (p0 - 256)));
        const int rstep = dir ? -1 : 1;
        float cq[16], ck[16], cb[16]; bf16_t vv[16];
        float run = 0.f;
#pragma unroll
        for (int i = 0; i < 16; ++i) {
            const int r = rbase + rstep * (sg * 16 + i);
            const bf16_t* base = px + (size_t)r * INC + h * 128 + k;
            const float z = bf2f(base[zcol - h * 128]);
            if (PASS == 3) cq[i] = bf2f(base[0]);
            vv[i] = base[1536];
            const float e = __expf(-fabsf(z)); const float inv = 1.0f / (1.0f + e); const float big = inv, small = e * inv;
            const float sig = z >= 0.f ? big : small, nsig = z >= 0.f ? small : big;
            ck[i] = omlb * nsig;
            const float f = fmaxf(lb + omlb * sig, 1e-30f);
            run += __logf(f); cb[i] = run;
        }
        SEG[sg * 128 + k] = run;
        __syncthreads();
        const float s0 = SEG[k], s1 = SEG[128 + k], s2 = SEG[256 + k], s3 = SEG[384 + k];
        const float off = (sg > 0 ? s0 : 0.f) + (sg > 1 ? s1 : 0.f) + (sg > 2 ? s2 : 0.f);
        const float blast = (s0 + s1) + (s2 + s3), rr = 0.5f * blast, er = __expf(rr);
        if (sg == 0) DK[k] = er * er;
        unsigned kdp[8], vvp[8];
#pragma unroll
        for (int i = 0; i < 16; i += 2) {
            float kd2[2];
#pragma unroll
            for (int e = 0; e < 2; ++e) {
                const int ii = i + e; const int tau = sg * 16 + ii;
                const float bt = off + cb[ii];
                const float kt = ck[ii] * __expf(rr - bt);
                kd2[e] = kt * er;
                if (PASS == 3) { const float qt = cq[ii] * __expf(bt - rr); QT[tau * 136 + k] = f2bf(qt); QS[tau * 136 + k] = f2bf(qt * er); KT[tau * 136 + k] = f2bf(kt); }
            }
            kdp[i >> 1] = pk2(kd2[0], kd2[1]);
            vvp[i >> 1] = (unsigned)vv[i] | ((unsigned)vv[i + 1] << 16);
        }
        *(LAS u32x4*)(KDT + k * 72 + sg * 16) = (u32x4){kdp[0], kdp[1], kdp[2], kdp[3]};
        *(LAS u32x4*)(KDT + k * 72 + sg * 16 + 8) = (u32x4){kdp[4], kdp[5], kdp[6], kdp[7]};
        *(LAS u32x4*)(VT + k * 72 + sg * 16) = (u32x4){vvp[0], vvp[1], vvp[2], vvp[3]};
        *(LAS u32x4*)(VT + k * 72 + sg * 16 + 8) = (u32x4){vvp[4], vvp[5], vvp[6], vvp[7]};
        __syncthreads();

        if (PASS == 3) {
            f32x4 oacc[4];
#pragma unroll
            for (int tb = 0; tb < 4; ++tb) oacc[tb] = (f32x4){0.f, 0.f, 0.f, 0.f};
#pragma unroll
            for (int ks = 0; ks < 4; ++ks) { const bf16x8 av = *(const LAS bf16x8*)(ST + (wid * 16 + fr) * 136 + ks * 32 + fq * 8);
#pragma unroll
                for (int tb = 0; tb < 4; ++tb) { const bf16x8 bq = *(const LAS bf16x8*)(QS + (tb * 16 + fr) * 136 + ks * 32 + fq * 8); oacc[tb] = mfma16(av, bq, oacc[tb]); } }
#pragma unroll
            for (int e = 0; e < 2; ++e) { const int id = 2 * wid + e, sb = id >> 2, tb = id & 3;
                f32x4 sacc = (f32x4){0.f, 0.f, 0.f, 0.f};
                if (sb <= tb) {
#pragma unroll
                    for (int ks = 0; ks < 4; ++ks) { const bf16x8 av = *(const LAS bf16x8*)(KT + (sb * 16 + fr) * 136 + ks * 32 + fq * 8);
                        const bf16x8 bq = *(const LAS bf16x8*)(QT + (tb * 16 + fr) * 136 + ks * 32 + fq * 8); sacc = mfma16(av, bq, sacc); } }
                const int t = tb * 16 + fr, s = sb * 16 + 4 * fq;
                float m[4];
#pragma unroll
                for (int j = 0; j < 4; ++j) m[j] = (s + j <= t) ? sacc[j] : 0.f;
                u32x2 w; w.x = pk2(m[0], m[1]); w.y = pk2(m[2], m[3]);
                *(LAS u32x2*)(P + t * 72 + s) = w; }
            __syncthreads();
#pragma unroll
            for (int ks = 0; ks < 2; ++ks) { const bf16x8 av = *(const LAS bf16x8*)(VT + (wid * 16 + fr) * 72 + ks * 32 + fq * 8);
#pragma unroll
                for (int tb = 0; tb < 4; ++tb) { const bf16x8 bq = *(const LAS bf16x8*)(P + (tb * 16 + fr) * 72 + ks * 32 + fq * 8); oacc[tb] = mfma16(av, bq, oacc[tb]); } }
#pragma unroll
            for (int tb = 0; tb < 4; ++tb) { const int r = rbase + rstep * (tb * 16 + fr);
                u32x2 w; w.x = pk2(oacc[tb][0], oacc[tb][1]); w.y = pk2(oacc[tb][2], oacc[tb][3]);
                *(u32x2*)(px + (size_t)r * INC + zcol + wid * 16 + 4 * fq) = w; }
        }
        {
            float dk[4];
#pragma unroll
            for (int j = 0; j < 4; ++j) { dk[j] = DK[wid * 16 + 4 * fq + j]; dtot[j] *= dk[j]; }
#pragma unroll
            for (int vb = 0; vb < 8; ++vb)
#pragma unroll
                for (int j = 0; j < 4; ++j) accS[vb][j] *= dk[j];
#pragma unroll
            for (int ks = 0; ks < 2; ++ks) { const bf16x8 av = *(const LAS bf16x8*)(KDT + (wid * 16 + fr) * 72 + ks * 32 + fq * 8);
#pragma unroll
                for (int vb = 0; vb < 8; ++vb) { const bf16x8 bq = *(const LAS bf16x8*)(VT + (vb * 16 + fr) * 72 + ks * 32 + fq * 8); accS[vb] = mfma16(av, bq, accS[vb]); } }
            if (PASS == 3 && c < 3) {
#pragma unroll
                for (int vb = 0; vb < 8; ++vb) { u32x2 w; w.x = pk2(accS[vb][0], accS[vb][1]); w.y = pk2(accS[vb][2], accS[vb][3]);
                    *(LAS u32x2*)(ST + (vb * 16 + fr) * 136 + wid * 16 + 4 * fq) = w; }
            }
        }
        __syncthreads();
    }
    if (PASS == 1) {
        float* S1 = US + ((size_t)(seq * 16 + sc) * 128) * 128;
#pragma unroll
        for (int vb = 0; vb < 8; ++vb)
#pragma unroll
            for (int j = 0; j < 4; ++j) S1[(size_t)(wid * 16 + 4 * fq + j) * 128 + vb * 16 + fr] = accS[vb][j];
        if (fr == 0) {
#pragma unroll
            for (int j = 0; j < 4; ++j) DEC[(size_t)(seq * 17 + sc) * 128 + wid * 16 + 4 * fq + j] = dtot[j];
        }
    }
}

__device__ __forceinline__ void phase_s2(const Ctx& C, float* US, const float* DEC) {
    PHASE_IDS();
    for (int idx = C.bid * NTHR + tid; idx < 32 * 4096; idx += C.G * NTHR) {
        const int seq = idx >> 12, kk = (idx & 4095) >> 5, v4 = idx & 31;
        f32x4 S = (f32x4){0.f, 0.f, 0.f, 0.f};
#pragma unroll 4
        for (int sc = 0; sc < 16; ++sc) {
            float* p = US + ((size_t)(seq * 16 + sc) * 128 + kk) * 128 + v4 * 4;
            const f32x4 U = *(const f32x4*)p; const float d = DEC[(size_t)(seq * 17 + sc) * 128 + kk];
            S = S * d + U;
            *(f32x4*)p = S;
        }
    }
}

__device__ __forceinline__ void gmlp_unit(const Ctx& C, int tid, const bf16_t* px, bf16_t* ycat, const float* w_s  , const float* b_s  , const float* ln_g, const float* ln_b, int cidx, int g) {
    LAS bf16_t* Wl = (LAS bf16_t*)(C.lds);
    LAS bf16_t* VnT = (LAS bf16_t*)(C.lds + 34816);
    const int r0 = cidx * 128, lane = tid & 63, wid = __builtin_amdgcn_readfirstlane(tid >> 6), fr = lane & 15, fq = lane >> 4;
    const float* W = w_s + (size_t)g * 128 * 128;
#pragma unroll
    for (int i = 0; i < 8; ++i) { const int f4 = tid + NTHR * i, t = f4 >> 5, s4 = (f4 & 31) * 4; const f32x4 v = *(const f32x4*)(W + t * 128 + s4);
        u32x2 w; w.x = pk2(v[0], v[1]); w.y = pk2(v[2], v[3]); *(LAS u32x2*)(Wl + t * 136 + s4) = w; }
    {
        const int s = tid >> 2, part = tid & 3, d0 = part * 16;
        const bf16_t* src = px + (size_t)(r0 + s) * INC + 2816 + g * 64 + d0;
        const u32x4 w0 = *(const u32x4*)src, w1 = *(const u32x4*)(src + 8);
        float x[16];
        x[0] = bflo(w0.x); x[1] = bfhi(w0.x); x[2] = bflo(w0.y); x[3] = bfhi(w0.y); x[4] = bflo(w0.z); x[5] = bfhi(w0.z); x[6] = bflo(w0.w); x[7] = bfhi(w0.w);
        x[8] = bflo(w1.x); x[9] = bfhi(w1.x); x[10] = bflo(w1.y); x[11] = bfhi(w1.y); x[12] = bflo(w1.z); x[13] = bfhi(w1.z); x[14] = bflo(w1.w); x[15] = bfhi(w1.w);
        float sm = 0.f;
#pragma unroll
        for (int i = 0; i < 16; ++i) { x[i] = gelu_tanh(x[i]); sm += x[i]; }
        sm += __shfl_xor(sm, 1); sm += __shfl_xor(sm, 2);
        const float mu = sm * (1.0f / 64.0f); float q = 0.f;
#pragma unroll
        for (int i = 0; i < 16; ++i) { x[i] -= mu; q += x[i] * x[i]; }
        q += __shfl_xor(q, 1); q += __shfl_xor(q, 2);
        const float rs = rsqrtf(q * (1.0f / 64.0f) + EPS);
#pragma unroll
        for (int i = 0; i < 16; ++i) { const int d = d0 + i; const float y = x[i] * rs * ln_g[g * 64 + d] + ln_b[g * 64 + d]; VnT[d * 136 + s] = f2bf(y); }
    }
    __syncthreads();
    f32x4 acc[4];
#pragma unroll
    for (int db = 0; db < 4; ++db) acc[db] = (f32x4){0.f, 0.f, 0.f, 0.f};
#pragma unroll
    for (int ks = 0; ks < 4; ++ks) { const bf16x8 bw = *(const LAS bf16x8*)(Wl + (wid * 16 + fr) * 136 + ks * 32 + fq * 8);
#pragma unroll
        for (int db = 0; db < 4; ++db) { const bf16x8 av = *(const LAS bf16x8*)(VnT + (db * 16 + fr) * 136 + ks * 32 + fq * 8); acc[db] = mfma16(av, bw, acc[db]); } }
    {
        const int t = wid * 16 + fr, r = r0 + t; const float bias = b_s[g * 128 + t];
#pragma unroll
        for (int db = 0; db < 4; ++db) { const int col = g * 64 + db * 16 + 4 * fq;
            const u32x2 uw = *(const u32x2*)(px + (size_t)r * INC + 2560 + col);
            const float u0 = gelu_tanh(bflo(uw.x)), u1 = gelu_tanh(bfhi(uw.x)), u2 = gelu_tanh(bflo(uw.y)), u3 = gelu_tanh(bfhi(uw.y));
            u32x2 w; w.x = pk2(u0 * (acc[db][0] + bias), u1 * (acc[db][1] + bias)); w.y = pk2(u2 * (acc[db][2] + bias), u3 * (acc[db][3] + bias));
            *(u32x2*)(ycat + (size_t)r * DM + 512 + col) = w; }
    }
    __syncthreads();
}

__device__ __forceinline__ void conv_unit(const Ctx& C, int tid, const bf16_t* px, bf16_t* ycat, const float* dw_w  , const float* dw_b, const float* ln_g, const float* ln_b, const bf16_t* pwt  , const float* pw_b, int tix) {
    LAS float* Z = (LAS float*)(C.lds);
    LAS bf16_t* Hn = (LAS bf16_t*)(C.lds + 96256);
    const int r0 = tix * 64, lane = tid & 63, wid = __builtin_amdgcn_readfirstlane(tid >> 6), fr = lane & 15, fq = lane >> 4;
    const int seg_lo = (r0 < MC) ? (r0 & ~255) : r0, seg_hi = seg_lo + ((r0 < MC) ? 256 : 64);
    for (int it = tid; it < 94 * 32; it += NTHR) {
        const int zr = it >> 5, c8 = (it & 31) * 8, r = r0 - 15 + zr;
        f32x4 z0 = (f32x4){0.f, 0.f, 0.f, 0.f}, z1 = z0;
        if (r >= seg_lo && r < seg_hi) {
            const u32x4 aw = *(const u32x4*)(px + (size_t)r * INC + 3072 + c8), gw = *(const u32x4*)(px + (size_t)r * INC + 3328 + c8);
            z0[0] = bflo(aw.x) * sigmoidf_(bflo(gw.x)); z0[1] = bfhi(aw.x) * sigmoidf_(bfhi(gw.x)); z0[2] = bflo(aw.y) * sigmoidf_(bflo(gw.y)); z0[3] = bfhi(aw.y) * sigmoidf_(bfhi(gw.y));
            z1[0] = bflo(aw.z) * sigmoidf_(bflo(gw.z)); z1[1] = bfhi(aw.z) * sigmoidf_(bfhi(gw.z)); z1[2] = bflo(aw.w) * sigmoidf_(bflo(gw.w)); z1[3] = bfhi(aw.w) * sigmoidf_(bfhi(gw.w));
        }
        *(LAS f32x4*)(Z + zr * 256 + c8) = z0; *(LAS f32x4*)(Z + zr * 256 + c8 + 4) = z1;
    }
    __syncthreads();
    {
        const int t0 = wid * 8, c4 = lane * 4;
        f32x4 acc[8], win[8];
#pragma unroll
        for (int t = 0; t < 8; ++t) acc[t] = (f32x4){0.f, 0.f, 0.f, 0.f};
#pragma unroll
        for (int t = 0; t < 7; ++t) win[t] = *(const LAS f32x4*)(Z + (t0 + t) * 256 + c4);
#pragma unroll 1
        for (int j = 0; j < 31; ++j) {
            win[7] = *(const LAS f32x4*)(Z + (t0 + j + 7) * 256 + c4);
            const f32x4 wj = *(const f32x4*)(dw_w + j * 256 + c4);
#pragma unroll
            for (int t = 0; t < 8; ++t) acc[t] += win[t] * wj;
#pragma unroll
            for (int t = 0; t < 7; ++t) win[t] = win[t + 1];
        }
        const f32x4 bv = *(const f32x4*)(dw_b + c4), gv = *(const f32x4*)(ln_g + c4), bb = *(const f32x4*)(ln_b + c4);
#pragma unroll
        for (int t = 0; t < 8; ++t) {
            f32x4 x = acc[t] + bv;
            float sm = (x[0] + x[1]) + (x[2] + x[3]);
            sm += __shfl_xor(sm, 1); sm += __shfl_xor(sm, 2); sm += __shfl_xor(sm, 4); sm += __shfl_xor(sm, 8);
            const float mu = sm * (1.0f / 64.0f);
            x = x - mu;
            float q = (x[0] * x[0] + x[1] * x[1]) + (x[2] * x[2] + x[3] * x[3]);
            q += __shfl_xor(q, 1); q += __shfl_xor(q, 2); q += __shfl_xor(q, 4); q += __shfl_xor(q, 8);
            const float rs = rsqrtf(q * (1.0f / 64.0f) + EPS);
            const f32x4 y = x * rs * gv + bb;
            u32x2 w; w.x = pk2(siluf_(y[0]), siluf_(y[1])); w.y = pk2(siluf_(y[2]), siluf_(y[3]));
            *(LAS u32x2*)(Hn + (t0 + t) * 264 + c4) = w;
        }
    }
    __syncthreads();
    {
        f32x4 acc[2][4];
#pragma unroll
        for (int e = 0; e < 2; ++e)
#pragma unroll
            for (int tb = 0; tb < 4; ++tb) acc[e][tb] = (f32x4){0.f, 0.f, 0.f, 0.f};
#pragma unroll
        for (int ks = 0; ks < 8; ++ks) {
            bf16x8 bh[4];
#pragma unroll
            for (int tb = 0; tb < 4; ++tb) bh[tb] = *(const LAS bf16x8*)(Hn + (tb * 16 + fr) * 264 + ks * 32 + fq * 8);
#pragma unroll
            for (int e = 0; e < 2; ++e) { const bf16x8 aw = *(const bf16x8*)(pwt + (size_t)((2 * wid + e) * 16 + fr) * 256 + ks * 32 + fq * 8);
#pragma unroll
                for (int tb = 0; tb < 4; ++tb) acc[e][tb] = mfma16(aw, bh[tb], acc[e][tb]); }
        }
#pragma unroll
        for (int e = 0; e < 2; ++e) { const int o = (2 * wid + e) * 16 + 4 * fq; const f32x4 pb = *(const f32x4*)(pw_b + o);
#pragma unroll
            for (int tb = 0; tb < 4; ++tb) { const int r = r0 + tb * 16 + fr; const f32x4 y = acc[e][tb] + pb;
                u32x2 w; w.x = pk2(y[0], y[1]); w.y = pk2(y[2], y[3]);
                *(u32x2*)(ycat + (size_t)r * DM + 768 + o) = w; } }
    }
    __syncthreads();
}

__device__ __forceinline__ void phase_xa(const Ctx& C, const bf16_t* px, bf16_t* ycat, const float* onorm_g) {
    PHASE_IDS();
    const int gw = C.bid * 8 + wid, NGW = C.G * 8;
    for (int r = gw; r < MT; r += NGW) {
        const bf16_t* pr = px + (size_t)r * INC;
#pragma unroll
        for (int h = 0; h < 4; ++h) {
            const int col = h * 128 + 2 * lane;
            const unsigned wf = *(const unsigned*)(pr + 512 + col), wb = *(const unsigned*)(pr + 1024 + col), wg = *(const unsigned*)(pr + 2048 + col);
            const float o0 = bflo(wf) + bflo(wb), o1 = bfhi(wf) + bfhi(wb);
            const float ss = wave_sum(o0 * o0 + o1 * o1);
            const float rs = rsqrtf(ss * (1.0f / 128.0f) + EPS);
            const f32x2 gn = *(const f32x2*)(onorm_g + col);
            const float y0 = o0 * rs * gn[0] * siluf_(bflo(wg)), y1 = o1 * rs * gn[1] * siluf_(bfhi(wg));
            *(unsigned*)(ycat + (size_t)r * DM + col) = pk2(y0, y1);
        }
    }
}


#ifdef DBG_STOP
__device__ __forceinline__ void dbg_digest(const Ctx& C, const XcdBarrier& bar, float* out, const bf16_t* pb, size_t nb, const float* pf, size_t nf) {
    xcd_barrier(bar);
    const size_t NO = (size_t)ML * DM;
    for (size_t i = (size_t)C.bid * NTHR + threadIdx.x; i < NO; i += (size_t)C.G * NTHR) {
        float s = 0.f;
        for (size_t j = i; j < nb; j += NO) s += bf2f(pb[j]);
        for (size_t j = i; j < nf; j += NO) s += pf[j];
        if (!(fabsf(s) < 1e30f)) s = 7777.0f;
        out[i] = s;
    }
}
#define DBG_AT(n, pb, nb, pf, nf) if (DBG_STOP == (n) && l == DBG_L) { dbg_digest(C, bar, a.out, (pb), (nb), (pf), (nf)); return; }
#else
#define DBG_AT(n, pb, nb, pf, nf)
#define DBG_L 0
#endif
__global__ void __launch_bounds__(NTHR, 2) fwd_megakernel(Args a) {
    extern __shared__ __attribute__((aligned(16))) unsigned char lds_raw[];
    cg::grid_group grid = cg::this_grid();
    Ctx C;
    C.lds = (LAS unsigned char*)lds_raw;
    C.G = gridDim.x; C.bid = blockIdx.x;
    volatile LAS unsigned* barw = (volatile LAS unsigned*)(C.lds + LDS_BARW);
    if (threadIdx.x < 4) barw[threadIdx.x] = 0u;
    __syncthreads();
    XcdBarrier bar = xcd_barrier_post((unsigned*)(a.ws + WS_CTL), barw);

    float* MOD = (float*)(a.ws + WS_MOD);
    float* DEC = (float*)(a.ws + WS_DEC);
    float* XC = (float*)(a.ws + WS_XC);
    bf16_t* ABF = (bf16_t*)(a.ws + WS_ABF);
    bf16_t* PX = (bf16_t*)(a.ws + WS_PX);
    float* US = (float*)(a.ws + WS_US);

    phase_p0(C, a);
    grid.sync();

    const int dbgl = (a.in[0] == nullptr) ? 1 : 0; (void)dbgl;
    for (int l = 0; l < 2; ++l) {
        unsigned char* wt = a.ws + WS_WT + (size_t)l * WT_LAYER;
        const float* mod_l = MOD + (size_t)l * 5 * 6144;
        const float* srcc = (l == 0) ? a.in[2] : XC;
        const float* srcl = (l == 0) ? a.in[0] : a.out;
        DBG_AT(17, PX, 0, a.out, (size_t)ML * DM)
        phase_norm(C, srcc, srcl, a.in[6] + l * DM, mod_l, 0, 1, ABF, 0);
        GRID_BAR();

#if defined(DBG_STOP) && DBG_STOP == 14
        if (l == 1) {
            xcd_barrier(bar);
            const bf16_t* w1 = (const bf16_t*)(a.ws + WS_WT + WT_LAYER + WT_IN);
            for (size_t i = (size_t)C.bid * NTHR + threadIdx.x; i < (size_t)ML * DM; i += (size_t)C.G * NTHR) {
                float v = 0.f;
                #define BADF(x) (!(fabsf(x) < 1e30f))
                if (BADF(bf2f(ABF[i])) || (i + (size_t)ML * DM < (size_t)MT * DM && BADF(bf2f(ABF[i + (size_t)ML * DM])))) v = 500.f;
                if (i < (size_t)MC * DM && BADF(XC[i])) v = 1000.f;
                if (BADF(a.out[i])) v = 2000.f;
                if (i < 61440 && BADF(MOD[i])) v = 3000.f;
                if (i < (size_t)INC * DM && BADF(bf2f(w1[i]))) v = 4000.f;
                a.out[i] = v;
            }
            return;
        }
#endif
        DBG_AT(15, PX, 0, a.out, (size_t)ML * DM)
        DBG_AT(16, ABF, (size_t)MT * DM, XC, (size_t)MC * DM)
        { pg8::Gemm g{ABF, (const bf16_t*)(wt + WT_IN), MT, INC, DM}; pg8::StaticOrder S; S.init(MT / 256, INC / 256, C.G, C.bid, 0);
          pg8::EpiBf16 E{PX, INC}; pg8::gemm_phase(C.lds, g, S, E); }
        GRID_BAR();
        DBG_AT(1, PX, (size_t)MT * INC, MOD, (size_t)2 * 5 * 6144)
        { const int tid = fresh_tid(); for (int u = C.bid; u < 32 * 16; u += C.G) scan_unit<1>(C, tid, PX, US, DEC, a.in[8], l, u & 31, u >> 5); }
        GRID_BAR();
        phase_s2(C, US, DEC);
        GRID_BAR();
        DBG_AT(2, PX, 0, US, (size_t)32 * 16 * 128 * 128)
        {
            const int nS = 32 * 17, nB = 136 * 4, nC = 272; const int tid = fresh_tid();
            for (int u = C.bid; u < nS + nB + nC; u += C.G) {
                if (u < nS) scan_unit<3>(C, tid, PX, US, DEC, a.in[8], l, u & 31, u >> 5);
                else if (u < nS + nB) { const int v = u - nS; gmlp_unit(C, tid, PX, ABF, a.in[12] + (size_t)l * 4 * 128 * 128, a.in[13] + l * 512, a.in[10] + l * 256, a.in[11] + l * 256, v >> 2, v & 3); }
                else { const int v = u - nS - nB; conv_unit(C, tid, PX, ABF, a.in[14] + (size_t)l * 31 * 256, a.in[15] + l * 256, a.in[16] + l * 256, a.in[17] + l * 256, (const bf16_t*)(wt + WT_PW), a.in[19] + l * 256, v); }
            }
        }
        GRID_BAR();
        DBG_AT(3, PX, (size_t)MT * INC, US, 0)
        DBG_AT(4, ABF, (size_t)MT * DM, US, 0)
        phase_xa(C, PX, ABF, a.in[9] + l * 512);
        GRID_BAR();
        DBG_AT(5, ABF, (size_t)MT * DM, US, 0)
        { const int pm0 = (l == 0) ? 0 : 4;
          pg8::Gemm g{ABF, (const bf16_t*)(wt + WT_OUT), MT, DM, DM}; pg8::StaticOrder S; S.init(MT / 256 - pm0, DM / 256, C.G, C.bid, pm0);
          pg8::EpiRes E{srcc, srcl, XC, a.out, mod_l + 2 * 1024}; pg8::gemm_phase(C.lds, g, S, E); }
        GRID_BAR();
        DBG_AT(6, PX, 0, a.out, (size_t)ML * DM)
        DBG_AT(11, ABF, (size_t)MC * DM, XC, (size_t)MC * DM)
        phase_norm(C, XC, a.out, a.in[21] + l * DM, mod_l, 3, 4, ABF, (l == 0) ? 0 : MC);
        GRID_BAR();
        DBG_AT(7, ABF, (size_t)MT * DM, US, 0)
        { const int pm0 = (l == 0) ? 0 : 4;
          pg8::Gemm g{ABF, (const bf16_t*)(wt + WT_13), MT, 2 * DFF, DM}; pg8::StaticOrder S; S.init(MT / 256 - pm0, 2 * DFF / 256, C.G, C.bid, pm0);
          pg8::EpiSwiglu E{PX, DFF}; pg8::gemm_phase(C.lds, g, S, E); }
        GRID_BAR();
        DBG_AT(8, PX, (size_t)MT * DFF, US, 0)
        { const int pm0 = (l == 0) ? 0 : 4;
          pg8::Gemm g{PX, (const bf16_t*)(wt + WT_2), MT, DM, DFF}; pg8::StaticOrder S; S.init(MT / 256 - pm0, DM / 256, C.G, C.bid, pm0);
          pg8::EpiRes E{XC, a.out, XC, a.out, mod_l + 5 * 1024}; pg8::gemm_phase(C.lds, g, S, E); }
        GRID_BAR();
        DBG_AT(10, PX, 0, a.out, (size_t)ML * DM)
    }
    { const int l = DBG_L; DBG_AT(9, PX, 0, a.out, (size_t)ML * DM) }
    phase_final(C, a.out, a.in[24]);
}

extern "C" void kernel_launch(void* const* d_in, const int* in_sizes, int n_in, void* d_out, int out_size, void* d_ws, size_t ws_size, hipStream_t stream) {
    static int grid = 0;
    if (grid == 0) {
        int dev = 0, cus = 0, per_cu = 0;
        hipGetDevice(&dev);
        hipDeviceGetAttribute(&cus, hipDeviceAttributeMultiprocessorCount, dev);
        hipFuncSetAttribute((const void*)fwd_megakernel, hipFuncAttributeMaxDynamicSharedMemorySize, LDS_BYTES);
        hipOccupancyMaxActiveBlocksPerMultiprocessor(&per_cu, (const void*)fwd_megakernel, NTHR, LDS_BYTES);
        if (per_cu < 1) per_cu = 1;
        grid = cus;
        if (ws_size < WS_END) fprintf(stderr, "kernel_launch: workspace too small: %zu < %zu\n", ws_size, (size_t)WS_END);
        (void)hipGetLastError();
    }
    hipMemsetAsync((char*)d_ws + WS_CTL, 0, CTL_BYTES, stream);
    Args a{};
    for (int i = 0; i < 25; ++i) a.in[i] = (const float*)d_in[i];
    a.out = (float*)d_out; a.ws = (unsigned char*)d_ws;
    void* args[] = {&a};
    hipError_t e = hipLaunchCooperativeKernel((const void*)fwd_megakernel, dim3(grid), dim3(NTHR), args, LDS_BYTES, stream);
    if (e != hipSuccess) fprintf(stderr, "cooperative launch failed: %s (grid %d)\n", hipGetErrorString(e), grid);
}
```

```cpp
#include <hip/hip_runtime.h>
#include <hip/hip_cooperative_groups.h>
#include <cstdio>
namespace cg = cooperative_groups;
#define USE_XCD_BAR 1
#ifndef USE_XCD_BAR
#define GRID_BAR() grid.sync()
#else
#define GRID_BAR() xcd_barrier(bar)
#endif

#define LAS __attribute__((address_space(3)))
typedef unsigned short bf16_t;
typedef short bf16x8 __attribute__((ext_vector_type(8)));
typedef float f32x4 __attribute__((ext_vector_type(4)));
typedef float f32x2 __attribute__((ext_vector_type(2)));
typedef unsigned u32x4 __attribute__((ext_vector_type(4)));
typedef unsigned u32x2 __attribute__((ext_vector_type(2)));

constexpr int DM = 1024, NBATCH = 4, SEQ = 4096, CTXL = 256;
constexpr int MC = NBATCH * CTXL;
constexpr int ML = NBATCH * SEQ;
constexpr int MT = MC + ML;
constexpr int INC = 3584, DFF = 2816;
constexpr float EPS = 1e-6f;
constexpr int NTHR = 512;
constexpr int LDS_BYTES = 163840;
constexpr int LDS_BARW = LDS_BYTES - 64;

constexpr size_t WS_CTL = 0;
constexpr size_t CTL_BYTES = 131072;
constexpr size_t WS_CNT = 16384;
constexpr size_t WS_XB = 131072;
constexpr size_t WS_MOD = WS_XB + 1048576;
constexpr size_t WS_DEC = WS_MOD + 262144;
constexpr size_t WS_WT = WS_DEC + 524288;
constexpr size_t WT_IN = 0, WT_OUT = WT_IN + (size_t)INC * DM * 2, WT_13 = WT_OUT + (size_t)DM * DM * 2,
                 WT_2 = WT_13 + (size_t)2 * DFF * DM * 2, WT_PW = WT_2 + (size_t)DM * DFF * 2, WT_LAYER = WT_PW + (size_t)256 * 256 * 2;
constexpr size_t WS_XC = WS_WT + 2 * WT_LAYER;
constexpr size_t WS_ABF = WS_XC + (size_t)MC * DM * 4;
constexpr size_t WS_PX = WS_ABF + (size_t)MT * DM * 2;
constexpr size_t WS_US = WS_PX + (size_t)MT * INC * 2;
constexpr size_t WS_END = WS_US + (size_t)32 * 16 * 128 * 128 * 4;

__device__ __forceinline__ float bf2f(bf16_t v) { return __uint_as_float(((unsigned)v) << 16); }
__device__ __forceinline__ float bflo(unsigned w) { return __uint_as_float(w << 16); }
__device__ __forceinline__ float bfhi(unsigned w) { return __uint_as_float(w & 0xffff0000u); }
typedef __bf16 bf16x2_t __attribute__((ext_vector_type(2)));
__device__ __forceinline__ unsigned pk2(float lo, float hi) { const f32x2 v = {lo, hi}; const bf16x2_t b = __builtin_convertvector(v, bf16x2_t); return __builtin_bit_cast(unsigned, b); }
__device__ __forceinline__ bf16_t f2bf(float v) { return (bf16_t)(pk2(v, 0.f) & 0xffffu); }
__device__ __forceinline__ float sigmoidf_(float x) { return __builtin_amdgcn_rcpf(1.0f + __expf(-x)); }
__device__ __forceinline__ float siluf_(float x) { return x * sigmoidf_(x); }
__device__ __forceinline__ float gelu_tanh(float x) { const float y = 0.7978845608028654f * (x + 0.044715f * x * x * x); return x * sigmoidf_(2.0f * y); }
__device__ __forceinline__ void logsig2(float zl, float& ls, float& ln) {
    const float e = __builtin_amdgcn_exp2f(-fabsf(zl));
    const float L2 = __builtin_amdgcn_logf(1.0f + e);
    ls = fminf(zl, 0.f) - L2; ln = ls - zl;
}
constexpr float LOG2E = 1.4426950408889634f;
__device__ __forceinline__ float wave_sum(float v) {
#pragma unroll
    for (int o = 1; o < 64; o <<= 1) v += __shfl_xor(v, o);
    return v;
}
__device__ __forceinline__ f32x4 mfma16(bf16x8 a, bf16x8 b, f32x4 c) { return __builtin_amdgcn_mfma_f32_16x16x32_bf16(a, b, c, 0, 0, 0); }
#define LDS_WAIT() asm volatile("s_waitcnt lgkmcnt(0)" ::: "memory")
#define LBAR() do { asm volatile("s_waitcnt lgkmcnt(0)" ::: "memory"); __builtin_amdgcn_s_barrier(); asm volatile("" ::: "memory"); } while (0)
__device__ __forceinline__ int fresh_tid() { int t = threadIdx.x; asm volatile("" : "+v"(t)); return t; }
#define PHASE_IDS() const int tid = fresh_tid(), lane = tid & 63, wid = __builtin_amdgcn_readfirstlane(tid >> 6); (void)lane; (void)wid

#define XB_TMO      128
#define XB_XCNT(j)  (256  + 64 * (j))
#define XB_XSUB(j)  (1280 + 64 * (j))
#define XB_XGEN(j)  (2304 + 64 * (j))
#define XB_TOP      3328
#define XB_TOPGEN   3392
#define XCD_BAR_WORDS 3456
#define XB_SPIN_CAP (1u << 20)
__device__ __forceinline__ unsigned xb_ld(unsigned* p)              { return __hip_atomic_load(p, __ATOMIC_RELAXED, __HIP_MEMORY_SCOPE_AGENT); }
__device__ __forceinline__ unsigned xb_add(unsigned* p, unsigned v) { return __hip_atomic_fetch_add(p, v, __ATOMIC_RELAXED, __HIP_MEMORY_SCOPE_AGENT); }
__device__ __forceinline__ unsigned xb_xcc_id() { return (unsigned)__builtin_amdgcn_s_getreg((3 << 11) | 20) & 0xFu; }
#define XB_SPIN(cond, bar) do { unsigned _sp = 0; while (cond) { __builtin_amdgcn_s_sleep(1); \
    if ((++_sp & 255u) == 0u) { if (xb_ld(&(bar)[XB_TMO])) break; if (_sp > XB_SPIN_CAP) { atomicAdd(&(bar)[XB_TMO], 1u); break; } } } } while (0)
struct XcdBarrier { unsigned* bar; unsigned x; volatile LAS unsigned* st; };
__device__ __forceinline__ XcdBarrier xcd_barrier_post(unsigned* bar, volatile LAS unsigned* st) {
    XcdBarrier b; b.bar = bar; b.x = xb_xcc_id(); b.st = st;
    if (threadIdx.x == 0) (void)xb_add(&bar[XB_XCNT(b.x)], 1u);
    return b;
}
__device__ __forceinline__ void xcd_barrier_complete(unsigned* bar, unsigned x, unsigned& nloc, unsigned& nx) {
    const unsigned G = gridDim.x * gridDim.y * gridDim.z;
    unsigned sum, cnt, mine, sp = 0u;
    for (;;) {
        sum = 0u; cnt = 0u; mine = 0u;
#pragma unroll
        for (unsigned j = 0; j < 16; ++j) { const unsigned c = xb_ld(&bar[XB_XCNT(j)]); sum += c; cnt += (c > 0u) ? 1u : 0u; mine = (j == x) ? c : mine; }
        if (sum == G) break;
        __builtin_amdgcn_s_sleep(1);
        if ((++sp & 255u) == 0u) { if (xb_ld(&bar[XB_TMO])) break; if (sp > XB_SPIN_CAP) { atomicAdd(&bar[XB_TMO], 1u); break; } }
    }
    nloc = mine > 0u ? mine : 1u; nx = cnt > 0u ? cnt : 1u;
}
__device__ __forceinline__ void xcd_barrier(const XcdBarrier& b) {
    asm volatile("s_waitcnt vmcnt(0)" ::: "memory");
    __syncthreads();
    if (threadIdx.x == 0) {
        unsigned* bar = b.bar;
        __builtin_amdgcn_s_waitcnt(0);
        unsigned nloc = b.st[0], nx = b.st[1];
        if (nloc == 0u) { xcd_barrier_complete(bar, b.x, nloc, nx); b.st[0] = nloc; b.st[1] = nx; }
        const unsigned old = xb_add(&bar[XB_XSUB(b.x)], 1u);
        const unsigned gen = old / nloc;
        if (old + 1u == (gen + 1u) * nloc) {
            __builtin_amdgcn_fence(__ATOMIC_RELEASE, "agent");
            asm volatile("s_waitcnt vmcnt(0)" ::: "memory");
            const unsigned og = xb_add(&bar[XB_TOP], 1u);
            const unsigned tg = og / nx;
            if (og + 1u == (tg + 1u) * nx) xb_add(&bar[XB_TOPGEN], 1u);
            else XB_SPIN(xb_ld(&bar[XB_TOPGEN]) == tg, bar);
            __builtin_amdgcn_fence(__ATOMIC_ACQUIRE, "agent");
            xb_add(&bar[XB_XGEN(b.x)], 1u);
            asm volatile("s_waitcnt vmcnt(0)" ::: "memory");
        } else {
            XB_SPIN(xb_ld(&bar[XB_XGEN(b.x)]) == gen, bar);
            __builtin_amdgcn_fence(__ATOMIC_ACQUIRE, "agent");
            asm volatile("s_waitcnt vmcnt(0)" ::: "memory");
        }
    }
    __syncthreads();
}

namespace pg8 {
constexpr int BM = 256, BK = 64, HALF = 128, HTB = HALF * BK * 2, STAGE_BYTES = 8 * HTB, NXCD = 8, WGM = 4;
__device__ __forceinline__ int lds_byte(int r, int c) { const int st = (r >> 4) * 2 + (c >> 5), rr = r & 15, cc = c & 31, ob = rr * 64 + cc * 2; return st * 1024 + (ob ^ (((ob >> 9) & 1) << 5)); }
__device__ __forceinline__ void stage_rc(int b, int& R, int& C) { const int st = b / 1024, sb = b % 1024, swz = sb ^ (((sb >> 9) & 1) << 5); R = (st >> 1) * 16 + swz / 64; C = (st & 1) * 32 + (swz % 64) / 2; }
__device__ __forceinline__ int perm32(int rho) { const int n = rho >> 4, i = rho & 15; return 8 * (i >> 2) + 4 * n + (i & 3); }
struct Unit { int pm, pn, k0; };
struct Gemm { const bf16_t* A; const bf16_t* Bt; };
struct StaticOrder {
    int nM, nN, nwg, G, c, pm0;
    __device__ void init(int nM_, int nN_, int G_, int c_, int pm0_) { nM = nM_; nN = nN_; nwg = nM * nN; G = G_; c = c_; pm0 = pm0_; }
    __device__ bool next(int i, Unit& u) const {
        const long L = (long)i * G + c; if (L >= nwg) return false;
        int wgid = (int)L; { const int q = nwg / NXCD, r = nwg % NXCD, xcd = wgid % NXCD, off = wgid / NXCD; wgid = (xcd < r ? xcd * (q + 1) : r * (q + 1) + (xcd - r) * q) + off; }
        const int nig = WGM * nN, gid = wgid / nig, fm = gid * WGM, gsz = (nM - fm) < WGM ? (nM - fm) : WGM;
        u.pm = pm0 + fm + ((wgid % nig) % gsz); u.pn = (wgid % nig) / gsz; u.k0 = 0; return true;
    }
};

struct EpiBf16 {
    static constexpr bool PERM = true, AFTER_DRAIN = false;
    bf16_t* O; int ldc;
    __device__ __forceinline__ void operator()(const f32x4 (&acc)[2][2][4][2], const Unit& u, int wr, int wc, int fr, int fq) const {
        const int row0 = u.pm * BM + wr * 64 + fr; const int col0 = u.pn * BM + wc * 32 + 8 * fq;
#pragma unroll
        for (int ai = 0; ai < 2; ++ai)
#pragma unroll
            for (int m = 0; m < 4; ++m) { bf16_t* rowp = O + (size_t)(row0 + ai * HALF + m * 16) * ldc + col0;
#pragma unroll
                for (int bj = 0; bj < 2; ++bj) { const f32x4 v0 = acc[ai][bj][m][0], v1 = acc[ai][bj][m][1];
                    u32x4 w; w.x = pk2(v0[0], v0[1]); w.y = pk2(v0[2], v0[3]); w.z = pk2(v1[0], v1[1]); w.w = pk2(v1[2], v1[3]);
                    *(u32x4*)(rowp + bj * HALF) = w; } }
    }
};
struct EpiSwiglu {
    static constexpr bool PERM = true, AFTER_DRAIN = false;
    bf16_t* O; int ldc;
    __device__ __forceinline__ void operator()(const f32x4 (&acc)[2][2][4][2], const Unit& u, int wr, int wc, int fr, int fq) const {
        const int row0 = u.pm * BM + wr * 64 + fr; const int col0 = u.pn * HALF + wc * 32 + 8 * fq;
#pragma unroll
        for (int ai = 0; ai < 2; ++ai)
#pragma unroll
            for (int m = 0; m < 4; ++m) { bf16_t* rowp = O + (size_t)(row0 + ai * HALF + m * 16) * ldc + col0;
                float o[8];
#pragma unroll
                for (int n = 0; n < 2; ++n)
#pragma unroll
                    for (int j = 0; j < 4; ++j) { const float a = acc[ai][0][m][n][j], b = acc[ai][1][m][n][j]; o[n * 4 + j] = siluf_(a) * b; }
                u32x4 w; w.x = pk2(o[0], o[1]); w.y = pk2(o[2], o[3]); w.z = pk2(o[4], o[5]); w.w = pk2(o[6], o[7]);
                *(u32x4*)rowp = w; }
    }
};
struct EpiRes {
    static constexpr bool PERM = false, AFTER_DRAIN = false;
    const float* base_c; const float* base_l; float* out_c; float* out_l; const float* gate;
    __device__ __forceinline__ void operator()(const f32x4 (&acc)[2][2][4][2], const Unit& u, int wr, int wc, int fr, int fq) const {
        const int bi = (u.pm < 4) ? 4 : ((u.pm - 4) >> 4);
        const float* base = (u.pm < 4) ? base_c + (size_t)u.pm * BM * DM : base_l + (size_t)(u.pm - 4) * BM * DM;
        float* out = (u.pm < 4) ? out_c + (size_t)u.pm * BM * DM : out_l + (size_t)(u.pm - 4) * BM * DM;
        const int row0 = wr * 64 + fr, col0 = u.pn * BM + wc * 32 + 4 * fq;
        f32x4 gv[2][2];
#pragma unroll
        for (int bj = 0; bj < 2; ++bj)
#pragma unroll
            for (int n = 0; n < 2; ++n) gv[bj][n] = *(const f32x4*)(gate + (size_t)bi * 6144 + col0 + bj * HALF + n * 16);
#pragma unroll
        for (int ai = 0; ai < 2; ++ai)
#pragma unroll
            for (int mh = 0; mh < 2; ++mh) {
                f32x4 bs[2][2][2];
#pragma unroll
                for (int m2 = 0; m2 < 2; ++m2) { const size_t off = (size_t)(row0 + ai * HALF + (mh * 2 + m2) * 16) * DM + col0;
#pragma unroll
                    for (int bj = 0; bj < 2; ++bj)
#pragma unroll
                        for (int n = 0; n < 2; ++n) bs[m2][bj][n] = *(const f32x4*)(base + off + bj * HALF + n * 16); }
#pragma unroll
                for (int m2 = 0; m2 < 2; ++m2) { const size_t off = (size_t)(row0 + ai * HALF + (mh * 2 + m2) * 16) * DM + col0;
#pragma unroll
                    for (int bj = 0; bj < 2; ++bj)
#pragma unroll
                        for (int n = 0; n < 2; ++n) *(f32x4*)(out + off + bj * HALF + n * 16) = bs[m2][bj][n] + gv[bj][n] * acc[ai][bj][mh * 2 + m2][n]; }
            }
    }
};

struct EpiResNorm {
    static constexpr bool PERM = false, AFTER_DRAIN = true;
    const float* base_l; float* out_l; const float* gate;
    const float* ng; const float* nsh; const float* nsc;
    bf16_t* hn; float* xbuf; unsigned* cnt;
    __device__ __forceinline__ void fused(f32x4 (&acc)[2][2][4][2], const Unit& u, int wr, int wc, int fr, int fq, LAS unsigned char* lds, int wid, int lane) const {
        const int pl = u.pm - 4, bi = pl >> 4;
        const float* base = base_l + (size_t)pl * BM * DM; float* out = out_l + (size_t)pl * BM * DM;
        const int row0 = wr * 64 + fr, col0 = u.pn * BM + wc * 32 + 4 * fq;
        LAS float* P = (LAS float*)lds;
        LAS float* S = (LAS float*)(lds + 4096);
        f32x4 gv[2][2];
#pragma unroll
        for (int bj = 0; bj < 2; ++bj)
#pragma unroll
            for (int n = 0; n < 2; ++n) gv[bj][n] = *(const f32x4*)(gate + (size_t)bi * 6144 + col0 + bj * HALF + n * 16);
#pragma unroll
        for (int ai = 0; ai < 2; ++ai)
#pragma unroll
            for (int mh = 0; mh < 2; ++mh) {
                f32x4 bs[2][2][2];
#pragma unroll
                for (int m2 = 0; m2 < 2; ++m2) { const size_t off = (size_t)(row0 + ai * HALF + (mh * 2 + m2) * 16) * DM + col0;
#pragma unroll
                    for (int bj = 0; bj < 2; ++bj)
#pragma unroll
                        for (int n = 0; n < 2; ++n) bs[m2][bj][n] = *(const f32x4*)(base + off + bj * HALF + n * 16); }
#pragma unroll
                for (int m2 = 0; m2 < 2; ++m2) { const int m = mh * 2 + m2; const size_t off = (size_t)(row0 + ai * HALF + m * 16) * DM + col0;
                    float sq = 0.f;
#pragma unroll
                    for (int bj = 0; bj < 2; ++bj)
#pragma unroll
                        for (int n = 0; n < 2; ++n) { const f32x4 x = bs[m2][bj][n] + gv[bj][n] * acc[ai][bj][m][n]; acc[ai][bj][m][n] = x;
                            if (hn) *(f32x4*)(out + off + bj * HALF + n * 16) = x;
                            sq += (x[0] * x[0] + x[1] * x[1]) + (x[2] * x[2] + x[3] * x[3]); }
                    sq += __shfl_xor(sq, 16); sq += __shfl_xor(sq, 32);
                    if (fq == 0) P[(ai * HALF + wr * 64 + m * 16 + fr) * 4 + wc] = sq; }
            }
        f32x4 ngv[2][2], shv[2][2];
#pragma unroll
        for (int bj = 0; bj < 2; ++bj)
#pragma unroll
            for (int n = 0; n < 2; ++n) { const int c = col0 + bj * HALF + n * 16; ngv[bj][n] = *(const f32x4*)(ng + c);
                if (nsh) { shv[bj][n] = *(const f32x4*)(nsh + (size_t)bi * 6144 + c); ngv[bj][n] = ngv[bj][n] * (*(const f32x4*)(nsc + (size_t)bi * 6144 + c) + 1.0f); }
                else shv[bj][n] = (f32x4){0.f, 0.f, 0.f, 0.f}; }
        asm volatile("s_waitcnt lgkmcnt(0)" ::: "memory"); __builtin_amdgcn_s_barrier(); asm volatile("" ::: "memory");
        const int row = wid * 32 + (lane & 31);
        if (lane < 32) { const float t = (P[row * 4 + 0] + P[row * 4 + 1]) + (P[row * 4 + 2] + P[row * 4 + 3]);
            __hip_atomic_store(xbuf + ((size_t)(pl * BM + row) * 4 + u.pn), t, __ATOMIC_RELAXED, __HIP_MEMORY_SCOPE_AGENT); }
        asm volatile("s_waitcnt vmcnt(0)" ::: "memory");
        if (lane == 0) __hip_atomic_fetch_add(cnt + 64 * pl, 1u, __ATOMIC_RELAXED, __HIP_MEMORY_SCOPE_AGENT);
        if (wid == 0) {
            unsigned sp = 0;
            while ((unsigned)__builtin_amdgcn_readfirstlane(__hip_atomic_load(cnt + 64 * pl, __ATOMIC_RELAXED, __HIP_MEMORY_SCOPE_AGENT)) < 32u) { __builtin_amdgcn_s_sleep(2); if (++sp > (1u << 22)) break; }
            __builtin_amdgcn_fence(__ATOMIC_ACQUIRE, "agent");
        }
        asm volatile("s_waitcnt vmcnt(0) lgkmcnt(0)" ::: "memory"); __builtin_amdgcn_s_barrier(); asm volatile("" ::: "memory");
        if (lane < 32) { const float* sl = xbuf + (size_t)(pl * BM + row) * 4; float ss = 0.f;
#pragma unroll
            for (int t = 0; t < 4; ++t) ss += __hip_atomic_load(sl + t, __ATOMIC_RELAXED, __HIP_MEMORY_SCOPE_AGENT);
            S[row] = rsqrtf(ss * (1.0f / DM) + EPS); }
        asm volatile("s_waitcnt lgkmcnt(0)" ::: "memory"); __builtin_amdgcn_s_barrier(); asm volatile("" ::: "memory");
#pragma unroll
        for (int ai = 0; ai < 2; ++ai)
#pragma unroll
            for (int m = 0; m < 4; ++m) { const int r = ai * HALF + wr * 64 + m * 16 + fr; const float rs = S[r];
#pragma unroll
                for (int bj = 0; bj < 2; ++bj)
#pragma unroll
                    for (int n = 0; n < 2; ++n) { const f32x4 y = acc[ai][bj][m][n] * rs * ngv[bj][n] + shv[bj][n]; const int c = col0 + bj * HALF + n * 16;
                        if (hn) { u32x2 w; w.x = pk2(y[0], y[1]); w.y = pk2(y[2], y[3]); *(u32x2*)(hn + (size_t)(u.pm * BM + r) * DM + c) = w; }
                        else *(f32x4*)(out + (size_t)r * DM + c) = y; } }
        asm volatile("s_waitcnt lgkmcnt(0)" ::: "memory"); __builtin_amdgcn_s_barrier(); asm volatile("" ::: "memory");
    }
};
struct SliceOrder {
    int ns, nu, G, c;
    __device__ void init(int ns_, int G_, int c_) { ns = ns_; nu = 16 * ns_; G = G_; c = G_ - 1 - c_; }
    __device__ bool next(int i, Unit& u) const {
        const int L = i * G + c; if (L >= nu) return false;
        const int t = L / ns, sl = L % ns; u.pm = t >> 2; u.pn = t & 3; u.k0 = sl * 256; return true;
    }
};
struct EpiPartial {
    static constexpr bool PERM = false, AFTER_DRAIN = false;
    float* p0; float* p1; int split;
    __device__ __forceinline__ void operator()(const f32x4 (&acc)[2][2][4][2], const Unit& u, int wr, int wc, int fr, int fq) const {
        const int sl = u.k0 >> 8;
        float* out = ((sl < split) ? p0 + (size_t)sl * MC * DM : p1 + (size_t)(sl - split) * MC * DM) + (size_t)u.pm * BM * DM;
        const int row0 = wr * 64 + fr, col0 = u.pn * BM + wc * 32 + 4 * fq;
#pragma unroll
        for (int ai = 0; ai < 2; ++ai)
#pragma unroll
            for (int m = 0; m < 4; ++m) { const size_t off = (size_t)(row0 + ai * HALF + m * 16) * DM + col0;
#pragma unroll
                for (int bj = 0; bj < 2; ++bj)
#pragma unroll
                    for (int n = 0; n < 2; ++n) *(f32x4*)(out + off + bj * HALF + n * 16) = acc[ai][bj][m][n]; }
    }
};

template <int LD, int KLEN, bool ALIGN_EPI, class Epi, class Sched>
__device__ __forceinline__ void gemm_phase(LAS unsigned char* lds, const Gemm g, const Sched& S, const Epi& E) {
    const int tid = fresh_tid(), wid = __builtin_amdgcn_readfirstlane(tid >> 6), lane = tid & 63, wr = wid >> 2, wc = wid & 3, fr = lane & 15, fq = lane >> 4;
    constexpr int nt = KLEN / BK;
    unsigned voffA[2], voffB[2];
#pragma unroll
    for (int i = 0; i < 2; ++i) { int R, C; stage_rc(tid * 16 + i * 8192, R, C); const int Rb = Epi::PERM ? ((R & ~31) + perm32(R & 31)) : R;
        voffA[i] = (unsigned)(R * LD + C) * 2u; voffB[i] = (unsigned)(Rb * LD + C) * 2u; }
    const size_t kstep = (size_t)(BK * 2);
    constexpr size_t hstepA = (size_t)HALF * LD * 2, hstepB = hstepA;
    constexpr size_t tstepA = 2 * hstepA, tstepB = tstepA;
    const unsigned ldsw = (unsigned)wid * 1024u;
    const int aoff = lds_byte(wr * 64 + fr, fq * 8), boff = lds_byte(wc * 32 + fr, fq * 8);
#define PG8_SA(b, h) (((b) * 2 + (h)) * HTB)
#define PG8_SB(b, h) ((4 + (b) * 2 + (h)) * HTB)
#define PG8_STAGE(bufoff, gbase, voff) do { _Pragma("unroll") for (int _i = 0; _i < 2; ++_i) \
        __builtin_amdgcn_global_load_lds((const unsigned*)((const char*)(gbase) + (voff)[_i]), (LAS unsigned*)(lds + (bufoff) + ldsw + _i * 8192), 16, 0, 0); } while (0)
#define PG8_LDA(dst, b, h) do { _Pragma("unroll") for (int m = 0; m < 4; ++m) _Pragma("unroll") for (int k = 0; k < 2; ++k) dst[m][k] = *(const LAS bf16x8*)(lds + PG8_SA(b, h) + aoff + m * 2048 + k * 1024); } while (0)
#define PG8_LDB(dst, b, h) do { _Pragma("unroll") for (int n = 0; n < 2; ++n) _Pragma("unroll") for (int k = 0; k < 2; ++k) dst[n][k] = *(const LAS bf16x8*)(lds + PG8_SB(b, h) + boff + n * 2048 + k * 1024); } while (0)
#define PG8_MMA(ai, bj, At, Bt) do { __builtin_amdgcn_s_setprio(1); _Pragma("unroll") for (int m = 0; m < 4; ++m) _Pragma("unroll") for (int n = 0; n < 2; ++n) _Pragma("unroll") for (int k = 0; k < 2; ++k) \
        acc[ai][bj][m][n] = __builtin_amdgcn_mfma_f32_16x16x32_bf16(Bt[n][k], At[m][k], acc[ai][bj][m][n], 0, 0, 0); __builtin_amdgcn_s_setprio(0); } while (0)
#define PG8_WAIT_V(n) asm volatile("s_waitcnt vmcnt(" #n ")" ::: "memory")
#define PG8_WAIT_L(n) asm volatile("s_waitcnt lgkmcnt(" #n ")" ::: "memory")
#define PG8_BAR __builtin_amdgcn_s_barrier()
#define PG8_SCHED __builtin_amdgcn_sched_barrier(0)
    Unit cur, nxt; int ui = 0;
    if (!S.next(0, cur)) return;
    f32x4 acc[2][2][4][2];
#pragma unroll
    for (int a = 0; a < 2; ++a)
#pragma unroll
        for (int b = 0; b < 2; ++b)
#pragma unroll
            for (int m = 0; m < 4; ++m)
#pragma unroll
                for (int n = 0; n < 2; ++n) acc[a][b][m][n] = (f32x4){0.f, 0.f, 0.f, 0.f};
    bf16x8 At[4][2], B0[2][2], B1[2][2];
    const char* cA = (const char*)g.A + (size_t)cur.pm * tstepA + (size_t)cur.k0 * 2; const char* cB = (const char*)g.Bt + (size_t)cur.pn * tstepB + (size_t)cur.k0 * 2;
    PG8_STAGE(PG8_SB(0, 0), cB, voffB); PG8_STAGE(PG8_SB(0, 1), cB + hstepB, voffB); PG8_STAGE(PG8_SA(0, 0), cA, voffA); PG8_STAGE(PG8_SA(0, 1), cA + hstepA, voffA);
    if (wr == 1) PG8_BAR;
    PG8_WAIT_V(2); PG8_BAR;
    PG8_STAGE(PG8_SB(1, 0), cB + kstep, voffB); PG8_STAGE(PG8_SA(1, 0), cA + kstep, voffA); PG8_STAGE(PG8_SB(1, 1), cB + hstepB + kstep, voffB);
    PG8_WAIT_V(6); PG8_BAR;
    for (;;) {
        const bool has_next = S.next(ui + 1, nxt);
        const char* nA = has_next ? (const char*)g.A + (size_t)nxt.pm * tstepA + (size_t)nxt.k0 * 2 : cA; const char* nB = has_next ? (const char*)g.Bt + (size_t)nxt.pn * tstepB + (size_t)nxt.k0 * 2 : cB;
#pragma unroll 1
        for (int t = 0; t < nt; t += 2) {
            const bool last = (t == nt - 2);
            const char* a1 = cA + (size_t)(t + 1) * kstep;
            const char* a2 = last ? nA : cA + (size_t)(t + 2) * kstep; const char* b2 = last ? nB : cB + (size_t)(t + 2) * kstep;
            const char* a3 = a2 + kstep; const char* b3 = b2 + kstep;
            PG8_LDB(B0, 0, 0); PG8_LDB(B1, 0, 1); PG8_SCHED; PG8_LDA(At, 0, 0); PG8_STAGE(PG8_SA(1, 1), a1 + hstepA, voffA);
            PG8_WAIT_V(8); PG8_WAIT_L(0); PG8_BAR; PG8_MMA(0, 0, At, B0); PG8_MMA(0, 1, At, B1); PG8_BAR; PG8_SCHED;
            PG8_LDA(At, 0, 1); PG8_STAGE(PG8_SB(0, 0), b2, voffB); PG8_STAGE(PG8_SB(0, 1), b2 + hstepB, voffB); PG8_STAGE(PG8_SA(0, 0), a2, voffA);
            PG8_WAIT_V(8); PG8_WAIT_L(0); PG8_BAR; PG8_MMA(1, 0, At, B0); PG8_MMA(1, 1, At, B1); PG8_BAR; PG8_SCHED;
            PG8_LDB(B0, 1, 0); PG8_LDB(B1, 1, 1); PG8_SCHED; PG8_LDA(At, 1, 0); PG8_STAGE(PG8_SA(0, 1), a2 + hstepA, voffA);
            PG8_WAIT_V(8); PG8_WAIT_L(0); PG8_BAR; PG8_MMA(0, 0, At, B0); PG8_MMA(0, 1, At, B1); PG8_BAR; PG8_SCHED;
            PG8_LDA(At, 1, 1); PG8_STAGE(PG8_SB(1, 0), b3, voffB); PG8_STAGE(PG8_SB(1, 1), b3 + hstepB, voffB); PG8_STAGE(PG8_SA(1, 0), a3, voffA);
            PG8_WAIT_V(8); PG8_WAIT_L(0); PG8_BAR; PG8_MMA(1, 0, At, B0); PG8_MMA(1, 1, At, B1); PG8_BAR; PG8_SCHED;
        }
        if constexpr (ALIGN_EPI) { if (wr == 0) PG8_BAR; }
        if constexpr (!Epi::AFTER_DRAIN) E(acc, cur, wr, wc, fr, fq);
        if (!has_next) break;
#pragma unroll
        for (int a = 0; a < 2; ++a)
#pragma unroll
            for (int b = 0; b < 2; ++b)
#pragma unroll
                for (int m = 0; m < 4; ++m)
#pragma unroll
                    for (int n = 0; n < 2; ++n) acc[a][b][m][n] = (f32x4){0.f, 0.f, 0.f, 0.f};
        cur = nxt; cA = nA; cB = nB; ++ui;
        if constexpr (ALIGN_EPI) { if (wr == 1) PG8_BAR; }
    }
    PG8_WAIT_V(0);
    if constexpr (!ALIGN_EPI) { if (wr == 0) PG8_BAR; }
    PG8_BAR;
    if constexpr (Epi::AFTER_DRAIN) E.fused(acc, cur, wr, wc, fr, fq, lds, wid, lane);
#undef PG8_SA
#undef PG8_SB
#undef PG8_STAGE
#undef PG8_LDA
#undef PG8_LDB
#undef PG8_MMA
#undef PG8_WAIT_V
#undef PG8_WAIT_L
#undef PG8_BAR
#undef PG8_SCHED
}
}

struct Args {
    const float* in[25];
    float* out;
    unsigned char* ws;
};

struct Ctx {
    LAS unsigned char* lds;
    int G, bid;
};


__device__ __forceinline__ void transpose_item(const float* W, int K, int N, int k0, int nsrc0, bf16_t* WT, int ndst0, LAS float* scr, int lane) {
#pragma unroll
    for (int i = 0; i < 32; ++i) { const int kk = 2 * i + (lane >> 5); scr[kk * 33 + (lane & 31)] = W[(size_t)(k0 + kk) * N + nsrc0 + (lane & 31)]; }
    LDS_WAIT();
    const int c = lane & 7;
#pragma unroll
    for (int j = 0; j < 4; ++j) { const int n = (lane >> 3) + 8 * j; const LAS float* s = scr + (8 * c) * 33 + n;
        u32x4 o; o.x = pk2(s[0 * 33], s[1 * 33]); o.y = pk2(s[2 * 33], s[3 * 33]); o.z = pk2(s[4 * 33], s[5 * 33]); o.w = pk2(s[6 * 33], s[7 * 33]);
        *(u32x4*)(WT + (size_t)(ndst0 + n) * K + k0 + 8 * c) = o; }
    LDS_WAIT();
}

__device__ __forceinline__ void phase_p0(const Ctx& C, const Args& a) {
    PHASE_IDS();
    {
        LAS float* sc = (LAS float*)(C.lds);
        LAS float* red = (LAS float*)(C.lds + 20480);
        float* MOD = (float*)(a.ws + WS_MOD);
        for (int idx = tid; idx < 5 * 1024; idx += NTHR) { const int bi = idx >> 10, k = idx & 1023; const float v = bi < 4 ? a.in[1][bi * 1024 + k] : a.in[3][k]; sc[idx] = siluf_(v); }
        __syncthreads();
        for (int u = C.bid; u < 192; u += C.G) {
            const int l = u / 96, cb = u % 96, col = cb * 64 + lane;
            const float* W = a.in[4] + ((size_t)l * 1024 + wid * 128) * 6144 + col;
            float acc[5] = {0.f, 0.f, 0.f, 0.f, 0.f};
#pragma unroll 32
            for (int kk = 0; kk < 128; ++kk) { const float w = W[(size_t)kk * 6144]; const int k = wid * 128 + kk;
#pragma unroll
                for (int bi = 0; bi < 5; ++bi) acc[bi] += sc[bi * 1024 + k] * w; }
#pragma unroll
            for (int bi = 0; bi < 5; ++bi) red[(wid * 5 + bi) * 64 + lane] = acc[bi];
            __syncthreads();
            if (tid < 320) { const int bi = tid >> 6, ln = tid & 63; float s = a.in[5][l * 6144 + cb * 64 + ln];
#pragma unroll
                for (int w = 0; w < 8; ++w) s += red[(w * 5 + bi) * 64 + ln];
                MOD[((size_t)l * 5 + bi) * 6144 + cb * 64 + ln] = s; }
            __syncthreads();
        }
    }
    {
        LAS float* scr = (LAS float*)(C.lds + wid * 8448);
        const int gw = C.bid * 8 + wid, NGW = C.G * 8;
        constexpr int I_IN = 16 * 112, I_OUT = 16 * 32, I_13 = 16 * 176, I_2 = 44 * 32, I_PW = 4 * 8, I_L = I_IN + I_OUT + I_13 + I_2 + I_PW;
        for (int it = gw; it < 2 * I_L; it += NGW) {
            const int l = it / I_L; int r = it % I_L;
            unsigned char* wt = a.ws + WS_WT + (size_t)l * WT_LAYER;
            if (r < I_IN) { const int kb = r / 112, nb = r % 112; transpose_item(a.in[7] + (size_t)l * DM * INC, DM, INC, kb * 64, nb * 32, (bf16_t*)(wt + WT_IN), nb * 32, scr, lane); continue; } r -= I_IN;
            if (r < I_OUT) { const int kb = r / 32, nb = r % 32; transpose_item(a.in[20] + (size_t)l * DM * DM, DM, DM, kb * 64, nb * 32, (bf16_t*)(wt + WT_OUT), nb * 32, scr, lane); continue; } r -= I_OUT;
            if (r < I_13) { const int kb = r / 176, nb = r % 176; const int nd = nb * 32, pn = nd >> 8, bj = (nd >> 7) & 1, j = nd & 127;
                transpose_item(a.in[22] + (size_t)l * DM * 2 * DFF, DM, 2 * DFF, kb * 64, bj * DFF + pn * 128 + j, (bf16_t*)(wt + WT_13), nd, scr, lane); continue; } r -= I_13;
            if (r < I_2) { const int kb = r / 32, nb = r % 32; transpose_item(a.in[23] + (size_t)l * DFF * DM, DFF, DM, kb * 64, nb * 32, (bf16_t*)(wt + WT_2), nb * 32, scr, lane); continue; } r -= I_2;
            { const int kb = r / 8, nb = r % 8; transpose_item(a.in[18] + (size_t)l * 256 * 256, 256, 256, kb * 64, nb * 32, (bf16_t*)(wt + WT_PW), nb * 32, scr, lane); }
        }
    }
}

__device__ __forceinline__ void norm_row_load(const float* srcc, const float* srcl, const float* mod_l, int shift_idx, int scale_idx, int r, int lane, f32x4 (&v)[4], f32x4 (&shv)[4], f32x4 (&scv)[4]) {
    const float* xr = (r < MC) ? srcc + (size_t)r * DM : srcl + (size_t)(r - MC) * DM;
    const int bi = (r < MC) ? 4 : ((r - MC) >> 12);
    const float* sh = mod_l + (size_t)bi * 6144 + shift_idx * 1024; const float* sc = mod_l + (size_t)bi * 6144 + scale_idx * 1024;
#pragma unroll
    for (int j = 0; j < 4; ++j) { v[j] = *(const f32x4*)(xr + 4 * lane + 256 * j); shv[j] = *(const f32x4*)(sh + 4 * lane + 256 * j); scv[j] = *(const f32x4*)(sc + 4 * lane + 256 * j); }
}
__device__ __forceinline__ void norm_row_store(bf16_t* dst, int r, int lane, const f32x4 (&v)[4], const f32x4 (&shv)[4], const f32x4 (&scv)[4], const f32x4 (&gv)[4], float rs) {
#pragma unroll
    for (int j = 0; j < 4; ++j) { const f32x4 y = v[j] * rs * gv[j] * (scv[j] + 1.0f) + shv[j];
        u32x2 w; w.x = pk2(y[0], y[1]); w.y = pk2(y[2], y[3]);
        *(u32x2*)(dst + (size_t)r * DM + 4 * lane + 256 * j) = w; }
}
__device__ __forceinline__ float sumsq4(const f32x4 (&v)[4]) { float s = 0.f;
#pragma unroll
    for (int j = 0; j < 4; ++j) s += (v[j][0] * v[j][0] + v[j][1] * v[j][1]) + (v[j][2] * v[j][2] + v[j][3] * v[j][3]);
    return s; }
struct CtxFix { const float* p0; const float* p1; int split, ns; const float* gate; float* xc_out; };
__device__ __forceinline__ void phase_norm(const Ctx& C, const float* srcc, const float* srcl, const float* g, const float* mod_l  , int shift_idx, int scale_idx, bf16_t* dst, int r_lo, int r_hi, const CtxFix fx) {
    PHASE_IDS();
    const int gw = C.bid * 8 + wid, NGW = C.G * 8;
    f32x4 gv[4];
#pragma unroll
    for (int j = 0; j < 4; ++j) gv[j] = *(const f32x4*)(g + 4 * lane + 256 * j);
    for (int r = r_lo + gw; r < r_hi; r += 2 * NGW) {
        const int r2 = r + NGW; const bool two = r2 < r_hi;
        f32x4 v0[4], sh0[4], sc0[4], v1[4], sh1[4], sc1[4];
        norm_row_load(srcc, srcl, mod_l, shift_idx, scale_idx, r, lane, v0, sh0, sc0);
        if (two) norm_row_load(srcc, srcl, mod_l, shift_idx, scale_idx, r2, lane, v1, sh1, sc1);
        if (r < MC && fx.ns > 0) {
            f32x4 ps[4];
#pragma unroll
            for (int j = 0; j < 4; ++j) ps[j] = (f32x4){0.f, 0.f, 0.f, 0.f};
            for (int s0 = 0; s0 < fx.ns; s0 += 4) {
                f32x4 pl[4][4];
#pragma unroll
                for (int q = 0; q < 4; ++q) { const int sl = (s0 + q < fx.ns) ? s0 + q : s0;
                    const float* pr = ((sl < fx.split) ? fx.p0 + (size_t)sl * MC * DM : fx.p1 + (size_t)(sl - fx.split) * MC * DM) + (size_t)r * DM;
#pragma unroll
                    for (int j = 0; j < 4; ++j) pl[q][j] = *(const f32x4*)(pr + 4 * lane + 256 * j); }
#pragma unroll
                for (int q = 0; q < 4; ++q) if (s0 + q < fx.ns) {
#pragma unroll
                    for (int j = 0; j < 4; ++j) ps[j] += pl[q][j]; }
            }
#pragma unroll
            for (int j = 0; j < 4; ++j) { v0[j] += *(const f32x4*)(fx.gate + 4 * lane + 256 * j) * ps[j];
                if (fx.xc_out) *(f32x4*)(fx.xc_out + (size_t)r * DM + 4 * lane + 256 * j) = v0[j]; }
        }
        float s0 = sumsq4(v0), s1 = two ? sumsq4(v1) : 0.f;
#pragma unroll
        for (int o = 1; o < 64; o <<= 1) { s0 += __shfl_xor(s0, o); s1 += __shfl_xor(s1, o); }
        norm_row_store(dst, r, lane, v0, sh0, sc0, gv, rsqrtf(s0 * (1.0f / DM) + EPS));
        if (two) norm_row_store(dst, r2, lane, v1, sh1, sc1, gv, rsqrtf(s1 * (1.0f / DM) + EPS));
    }
}
__device__ __forceinline__ void phase_final(const Ctx& C, float* out, const float* g) {
    PHASE_IDS();
    const int gw = C.bid * 8 + wid, NGW = C.G * 8;
    f32x4 gv[4];
#pragma unroll
    for (int j = 0; j < 4; ++j) gv[j] = *(const f32x4*)(g + 4 * lane + 256 * j);
    for (int r = gw; r < ML; r += 2 * NGW) {
        float* x0 = out + (size_t)r * DM; float* x1 = out + (size_t)(r + NGW) * DM;
        f32x4 v0[4], v1[4];
#pragma unroll
        for (int j = 0; j < 4; ++j) { v0[j] = *(const f32x4*)(x0 + 4 * lane + 256 * j); v1[j] = *(const f32x4*)(x1 + 4 * lane + 256 * j); }
        float s0 = sumsq4(v0), s1 = sumsq4(v1);
#pragma unroll
        for (int o = 1; o < 64; o <<= 1) { s0 += __shfl_xor(s0, o); s1 += __shfl_xor(s1, o); }
        const float r0s = rsqrtf(s0 * (1.0f / DM) + EPS), r1s = rsqrtf(s1 * (1.0f / DM) + EPS);
#pragma unroll
        for (int j = 0; j < 4; ++j) { *(f32x4*)(x0 + 4 * lane + 256 * j) = v0[j] * r0s * gv[j]; *(f32x4*)(x1 + 4 * lane + 256 * j) = v1[j] * r1s * gv[j]; }
    }
}

constexpr int SC_QT = 0, SC_QS = 17408, SC_KT = 34816, SC_KDT = 52224, SC_VT = 70656, SC_ST = 89088, SC_P = 123904, SC_SEG = 133120, SC_DK = 135168;
template <int PASS, bool L0>
__device__ __forceinline__ void scan_unit(const Ctx& C, int tid, bf16_t* px, float* US, float* DEC, const float* lbl, int layer, int seq, int sc) {
    const int dir = seq & 1, h = (seq >> 1) & 3, b = seq >> 3;
    const int lane = tid & 63, wid = __builtin_amdgcn_readfirstlane(tid >> 6), fr = lane & 15, fq = lane >> 4;
    LAS bf16_t* QT = (LAS bf16_t*)(C.lds + SC_QT);
    LAS bf16_t* QS = (LAS bf16_t*)(C.lds + SC_QS);
    LAS bf16_t* KT = (LAS bf16_t*)(C.lds + SC_KT);
    LAS bf16_t* KDT = (LAS bf16_t*)(C.lds + SC_KDT);
    LAS bf16_t* VT = (LAS bf16_t*)(C.lds + SC_VT);
    LAS bf16_t* ST = (LAS bf16_t*)(C.lds + SC_ST);
    LAS bf16_t* P = (LAS bf16_t*)(C.lds + SC_P);
    LAS float* SEG = (LAS float*)(C.lds + SC_SEG);
    LAS float* DK = (LAS float*)(C.lds + SC_DK);
    const int k = tid & 127, sg = tid >> 7;
    float lb = 0.f;
    if (!L0) { const float l0 = lbl[(0 * 2 + dir) * 512 + h * 128 + k], l1 = lbl[(1 * 2 + dir) * 512 + h * 128 + k]; lb = sigmoidf_(l1 - l0); }
    const float omlb = 1.0f - lb;
    const int zcol = (dir ? 1024 : 512) + h * 128;
    const unsigned zo = (unsigned)(zcol - h * 128);

    unsigned pz[16], pq[16], pv[16];
    {
        const int p00 = sc * 256;
        const int rb0 = (p00 < 256) ? (b * 256 + (dir ? 255 - p00 : p00)) : (MC + b * 4096 + (dir ? 4095 - (p00 - 256) : (p00 - 256)));
        const int rs0 = dir ? -1 : 1;
#pragma unroll
        for (int i = 0; i < 16; ++i) { const unsigned idx = (unsigned)((rb0 + rs0 * (sg * 16 + i)) * INC + h * 128 + k);
            pz[i] = px[idx + zo]; pq[i] = px[idx]; pv[i] = px[idx + 1536]; }
    }
    f32x4 accS[8];
    if (PASS == 1 || sc == 0) {
#pragma unroll
        for (int vb = 0; vb < 8; ++vb) accS[vb] = (f32x4){0.f, 0.f, 0.f, 0.f};
    } else {
        const float* S0 = US + ((size_t)(seq * 16 + sc - 1) * 128) * 128;
#pragma unroll
        for (int vb = 0; vb < 8; ++vb)
#pragma unroll
            for (int j = 0; j < 4; ++j) accS[vb][j] = S0[(size_t)(wid * 16 + 4 * fq + j) * 128 + vb * 16 + fr];
    }
    if (PASS == 3) {
#pragma unroll
        for (int vb = 0; vb < 8; ++vb) { u32x2 w; w.x = pk2(accS[vb][0], accS[vb][1]); w.y = pk2(accS[vb][2], accS[vb][3]);
            *(LAS u32x2*)(ST + (vb * 16 + fr) * 136 + wid * 16 + 4 * fq) = w; }
    }
    float dtot[4] = {1.f, 1.f, 1.f, 1.f};

    for (int c = 0; c < 4; ++c) {
        const int p0 = sc * 256 + c * 64;
        const int rbase = (p0 < 256) ? (b * 256 + (dir ? 255 - p0 : p0)) : (MC + b * 4096 + (dir ? 4095 - (p0 - 256) : (p0 - 256)));
        const int rstep = dir ? -1 : 1;
        float cq[16], ck[16], cb[16]; bf16_t vv[16];
        float run = 0.f;
#pragma unroll
        for (int i = 0; i < 16; ++i) {
            const float zl = __uint_as_float(pz[i] << 16) * LOG2E;
            if (PASS == 3) cq[i] = __uint_as_float(pq[i] << 16);
            vv[i] = (bf16_t)pv[i];
            if (L0) { float ls, ln; logsig2(zl, ls, ln); ck[i] = ln; run += ls; }
            else {
                const float e = __builtin_amdgcn_exp2f(-fabsf(zl)); const float inv = __builtin_amdgcn_rcpf(1.0f + e); const float big = inv, small = e * inv;
                const float sig = zl >= 0.f ? big : small, nsig = zl >= 0.f ? small : big;
                ck[i] = omlb * nsig;
                run += __builtin_amdgcn_logf(fmaxf(lb + omlb * sig, 1e-30f));
            }
            cb[i] = run;
        }
        SEG[sg * 128 + k] = run;
        LBAR();
        const float s0 = SEG[k], s1 = SEG[128 + k], s2 = SEG[256 + k], s3 = SEG[384 + k];
        const float off = (sg > 0 ? s0 : 0.f) + (sg > 1 ? s1 : 0.f) + (sg > 2 ? s2 : 0.f);
        const float blast = (s0 + s1) + (s2 + s3), rr = 0.5f * blast, er = __builtin_amdgcn_exp2f(rr);
        if (sg == 0) DK[k] = er * er;
        unsigned kdp[8], vvp[8];
#pragma unroll
        for (int i = 0; i < 16; i += 2) {
            float kd2[2];
#pragma unroll
            for (int e = 0; e < 2; ++e) {
                const int ii = i + e; const int tau = sg * 16 + ii;
                const float d = rr - (off + cb[ii]);
                const float kt = L0 ? __builtin_amdgcn_exp2f(ck[ii] + d) : ck[ii] * __builtin_amdgcn_exp2f(d);
                kd2[e] = kt * er;
                if (PASS == 3) { const float qt = cq[ii] * __builtin_amdgcn_exp2f(-d); QT[tau * 136 + k] = f2bf(qt); QS[tau * 136 + k] = f2bf(qt * er); KT[tau * 136 + k] = f2bf(kt); }
            }
            kdp[i >> 1] = pk2(kd2[0], kd2[1]);
            vvp[i >> 1] = (unsigned)vv[i] | ((unsigned)vv[i + 1] << 16);
        }
        *(LAS u32x4*)(KDT + k * 72 + sg * 16) = (u32x4){kdp[0], kdp[1], kdp[2], kdp[3]};
        *(LAS u32x4*)(KDT + k * 72 + sg * 16 + 8) = (u32x4){kdp[4], kdp[5], kdp[6], kdp[7]};
        *(LAS u32x4*)(VT + k * 72 + sg * 16) = (u32x4){vvp[0], vvp[1], vvp[2], vvp[3]};
        *(LAS u32x4*)(VT + k * 72 + sg * 16 + 8) = (u32x4){vvp[4], vvp[5], vvp[6], vvp[7]};
        LBAR();
        if (c < 3) {
            const int rb2 = rbase + rstep * 64;
#pragma unroll
            for (int i = 0; i < 16; ++i) { const unsigned idx = (unsigned)((rb2 + rstep * (sg * 16 + i)) * INC + h * 128 + k);
                pz[i] = px[idx + zo]; pq[i] = px[idx]; pv[i] = px[idx + 1536]; }
        }

        if (PASS == 3) {
            f32x4 oacc[4];
#pragma unroll
            for (int tb = 0; tb < 4; ++tb) oacc[tb] = (f32x4){0.f, 0.f, 0.f, 0.f};
#pragma unroll
            for (int kp = 0; kp < 2; ++kp) {
                bf16x8 av[2], bq[2][4];
#pragma unroll
                for (int k2 = 0; k2 < 2; ++k2) { const int ks = kp * 2 + k2; av[k2] = *(const LAS bf16x8*)(ST + (wid * 16 + fr) * 136 + ks * 32 + fq * 8);
#pragma unroll
                    for (int tb = 0; tb < 4; ++tb) bq[k2][tb] = *(const LAS bf16x8*)(QS + (tb * 16 + fr) * 136 + ks * 32 + fq * 8); }
                asm volatile("" ::: "memory");
#pragma unroll
                for (int k2 = 0; k2 < 2; ++k2)
#pragma unroll
                    for (int tb = 0; tb < 4; ++tb) oacc[tb] = mfma16(av[k2], bq[k2][tb], oacc[tb]);
            }
#pragma unroll
            for (int e = 0; e < 2; ++e) { const int id = 2 * wid + e, sb = id >> 2, tb = id & 3;
                f32x4 sacc = (f32x4){0.f, 0.f, 0.f, 0.f};
                if (sb <= tb) {
                    bf16x8 av[4], bq[4];
#pragma unroll
                    for (int ks = 0; ks < 4; ++ks) { av[ks] = *(const LAS bf16x8*)(KT + (sb * 16 + fr) * 136 + ks * 32 + fq * 8); bq[ks] = *(const LAS bf16x8*)(QT + (tb * 16 + fr) * 136 + ks * 32 + fq * 8); }
                    asm volatile("" ::: "memory");
#pragma unroll
                    for (int ks = 0; ks < 4; ++ks) sacc = mfma16(av[ks], bq[ks], sacc); }
                const int t = tb * 16 + fr, s = sb * 16 + 4 * fq;
                float m[4];
#pragma unroll
                for (int j = 0; j < 4; ++j) m[j] = (s + j <= t) ? sacc[j] : 0.f;
                u32x2 w; w.x = pk2(m[0], m[1]); w.y = pk2(m[2], m[3]);
                *(LAS u32x2*)(P + t * 72 + s) = w; }
            LBAR();
            {
                bf16x8 av[2], bq[2][4];
#pragma unroll
                for (int ks = 0; ks < 2; ++ks) { av[ks] = *(const LAS bf16x8*)(VT + (wid * 16 + fr) * 72 + ks * 32 + fq * 8);
#pragma unroll
                    for (int tb = 0; tb < 4; ++tb) bq[ks][tb] = *(const LAS bf16x8*)(P + (tb * 16 + fr) * 72 + ks * 32 + fq * 8); }
                asm volatile("" ::: "memory");
#pragma unroll
                for (int ks = 0; ks < 2; ++ks)
#pragma unroll
                    for (int tb = 0; tb < 4; ++tb) oacc[tb] = mfma16(av[ks], bq[ks][tb], oacc[tb]);
            }
#pragma unroll
            for (int tb = 0; tb < 4; ++tb) { const int r = rbase + rstep * (tb * 16 + fr);
                u32x2 w; w.x = pk2(oacc[tb][0], oacc[tb][1]); w.y = pk2(oacc[tb][2], oacc[tb][3]);
                *(u32x2*)(px + (size_t)r * INC + zcol + wid * 16 + 4 * fq) = w; }
        }
        {
            float dk[4];
#pragma unroll
            for (int j = 0; j < 4; ++j) { dk[j] = DK[wid * 16 + 4 * fq + j]; dtot[j] *= dk[j]; }
#pragma unroll
            for (int vb = 0; vb < 8; ++vb)
#pragma unroll
                for (int j = 0; j < 4; ++j) accS[vb][j] *= dk[j];
#pragma unroll
            for (int ks = 0; ks < 2; ++ks) {
                bf16x8 bq[8]; const bf16x8 av = *(const LAS bf16x8*)(KDT + (wid * 16 + fr) * 72 + ks * 32 + fq * 8);
#pragma unroll
                for (int vb = 0; vb < 8; ++vb) bq[vb] = *(const LAS bf16x8*)(VT + (vb * 16 + fr) * 72 + ks * 32 + fq * 8);
                asm volatile("" ::: "memory");
#pragma unroll
                for (int vb = 0; vb < 8; ++vb) accS[vb] = mfma16(av, bq[vb], accS[vb]);
            }
            if (PASS == 3 && c < 3) {
#pragma unroll
                for (int vb = 0; vb < 8; ++vb) { u32x2 w; w.x = pk2(accS[vb][0], accS[vb][1]); w.y = pk2(accS[vb][2], accS[vb][3]);
                    *(LAS u32x2*)(ST + (vb * 16 + fr) * 136 + wid * 16 + 4 * fq) = w; }
            }
        }
        LBAR();
    }
    if (PASS == 1) {
        float* S1 = US + ((size_t)(seq * 16 + sc) * 128) * 128;
#pragma unroll
        for (int vb = 0; vb < 8; ++vb)
#pragma unroll
            for (int j = 0; j < 4; ++j) S1[(size_t)(wid * 16 + 4 * fq + j) * 128 + vb * 16 + fr] = accS[vb][j];
        if (fr == 0) {
#pragma unroll
            for (int j = 0; j < 4; ++j) DEC[(size_t)(seq * 17 + sc) * 128 + wid * 16 + 4 * fq + j] = dtot[j];
        }
    }
}

template <bool L0>
__device__ __forceinline__ void scan_pass1_unit(const Ctx& C, int tid, const bf16_t* px, float* US, float* DEC, const float* lbl, int layer, int seq, int sc) {
    const int dir = seq & 1, h = (seq >> 1) & 3, b = seq >> 3;
    const int lane = tid & 63, wid = __builtin_amdgcn_readfirstlane(tid >> 6), fr = lane & 15, fq = lane >> 4;
    LAS bf16_t* KDT = (LAS bf16_t*)(C.lds);
    LAS bf16_t* VT = (LAS bf16_t*)(C.lds + 67584);
    LAS float* DKc = (LAS float*)(C.lds + 135168);
    const int k = tid & 127, c = tid >> 7;
    float lb = 0.f;
    if (!L0) { const float l0 = lbl[(0 * 2 + dir) * 512 + h * 128 + k], l1 = lbl[(1 * 2 + dir) * 512 + h * 128 + k]; lb = sigmoidf_(l1 - l0); }
    const float omlb = 1.0f - lb;
    const int zcol = (dir ? 1024 : 512) + h * 128;
    const unsigned zo = (unsigned)(zcol - h * 128);
    const int p0 = sc * 256 + c * 64;
    const int rbase = (p0 < 256) ? (b * 256 + (dir ? 255 - p0 : p0)) : (MC + b * 4096 + (dir ? 4095 - (p0 - 256) : (p0 - 256)));
    const int rstep = dir ? -1 : 1;
    float R = 0.f;
    unsigned rz[16], rv[16];
#pragma unroll
    for (int i = 0; i < 16; ++i) { const unsigned idx = (unsigned)((rbase + rstep * (48 + i)) * INC + h * 128 + k); rz[i] = px[idx + zo]; rv[i] = px[idx + 1536]; }
#pragma unroll
    for (int p = 3; p >= 0; --p) {
        unsigned nz[16], nv[16];
        if (p > 0) {
#pragma unroll
            for (int i = 0; i < 16; ++i) { const unsigned idx = (unsigned)((rbase + rstep * ((p - 1) * 16 + i)) * INC + h * 128 + k); nz[i] = px[idx + zo]; nv[i] = px[idx + 1536]; }
        }
#pragma unroll
        for (int gh = 1; gh >= 0; --gh) {
            const int g = 2 * p + gh;
            float kd[8];
#pragma unroll
            for (int i = 7; i >= 0; --i) {
                const float zl = __uint_as_float(rz[gh * 8 + i] << 16) * LOG2E;
                if (L0) { float ls, ln; logsig2(zl, ls, ln); kd[i] = __builtin_amdgcn_exp2f(R + ln); R += ls; }
                else {
                    const float e = __builtin_amdgcn_exp2f(-fabsf(zl)); const float inv = __builtin_amdgcn_rcpf(1.0f + e); const float big = inv, small = e * inv;
                    const float sig = zl >= 0.f ? big : small, nsig = zl >= 0.f ? small : big;
                    kd[i] = omlb * nsig * __builtin_amdgcn_exp2f(R);
                    R += __builtin_amdgcn_logf(fmaxf(lb + omlb * sig, 1e-30f));
                }
            }
            *(LAS u32x4*)(KDT + k * 264 + c * 64 + g * 8) = (u32x4){pk2(kd[0], kd[1]), pk2(kd[2], kd[3]), pk2(kd[4], kd[5]), pk2(kd[6], kd[7])};
            const unsigned* v8 = rv + gh * 8;
            *(LAS u32x4*)(VT + k * 264 + c * 64 + g * 8) = (u32x4){v8[0] | (v8[1] << 16), v8[2] | (v8[3] << 16), v8[4] | (v8[5] << 16), v8[6] | (v8[7] << 16)};
        }
        if (p > 0) {
#pragma unroll
            for (int i = 0; i < 16; ++i) { rz[i] = nz[i]; rv[i] = nv[i]; }
        }
    }
    DKc[c * 128 + k] = __builtin_amdgcn_exp2f(R);
    __syncthreads();
    f32x4 accS[8];
#pragma unroll
    for (int vb = 0; vb < 8; ++vb) accS[vb] = (f32x4){0.f, 0.f, 0.f, 0.f};
    float dtot[4] = {1.f, 1.f, 1.f, 1.f};
#pragma unroll
    for (int cc = 0; cc < 4; ++cc) {
        float dk[4];
#pragma unroll
        for (int j = 0; j < 4; ++j) { dk[j] = DKc[cc * 128 + wid * 16 + 4 * fq + j]; dtot[j] *= dk[j]; }
        if (cc > 0) {
#pragma unroll
            for (int vb = 0; vb < 8; ++vb)
#pragma unroll
                for (int j = 0; j < 4; ++j) accS[vb][j] *= dk[j];
        }
#pragma unroll
        for (int ks = 0; ks < 2; ++ks) {
            bf16x8 bq[8]; const bf16x8 av = *(const LAS bf16x8*)(KDT + (wid * 16 + fr) * 264 + cc * 64 + ks * 32 + fq * 8);
#pragma unroll
            for (int vb = 0; vb < 8; ++vb) bq[vb] = *(const LAS bf16x8*)(VT + (vb * 16 + fr) * 264 + cc * 64 + ks * 32 + fq * 8);
            asm volatile("" ::: "memory");
#pragma unroll
            for (int vb = 0; vb < 8; ++vb) accS[vb] = mfma16(av, bq[vb], accS[vb]);
        }
    }
    float* S1 = US + ((size_t)(seq * 16 + sc) * 128) * 128;
#pragma unroll
    for (int vb = 0; vb < 8; ++vb)
#pragma unroll
        for (int j = 0; j < 4; ++j) S1[(size_t)(wid * 16 + 4 * fq + j) * 128 + vb * 16 + fr] = accS[vb][j];
    if (fr == 0) {
#pragma unroll
        for (int j = 0; j < 4; ++j) DEC[(size_t)(seq * 17 + sc) * 128 + wid * 16 + 4 * fq + j] = dtot[j];
    }
    __syncthreads();
}

__device__ __forceinline__ void phase_s2(const Ctx& C, float* US, const float* DEC) {
    PHASE_IDS();
    for (int idx = C.bid * NTHR + tid; idx < 32 * 4096; idx += C.G * NTHR) {
        const int seq = idx >> 12, kk = (idx & 4095) >> 5, v4 = idx & 31;
        float* p = US + ((size_t)(seq * 16) * 128 + kk) * 128 + v4 * 4;
        const float* dp = DEC + (size_t)(seq * 17) * 128 + kk;
        f32x4 U[16]; float d[16];
#pragma unroll
        for (int sc = 0; sc < 16; ++sc) { U[sc] = *(const f32x4*)(p + (size_t)sc * 16384); d[sc] = dp[sc * 128]; }
        f32x4 S = (f32x4){0.f, 0.f, 0.f, 0.f};
#pragma unroll
        for (int sc = 0; sc < 16; ++sc) { S = S * d[sc] + U[sc]; *(f32x4*)(p + (size_t)sc * 16384) = S; }
    }
}

__device__ __forceinline__ void gmlp_unit(const Ctx& C, int tid, const bf16_t* px, bf16_t* ycat, const float* w_s  , const float* b_s  , const float* ln_g, const float* ln_b, int cidx, int g) {
    LAS bf16_t* Wl = (LAS bf16_t*)(C.lds);
    LAS bf16_t* VnT = (LAS bf16_t*)(C.lds + 34816);
    const int r0 = cidx * 128, lane = tid & 63, wid = __builtin_amdgcn_readfirstlane(tid >> 6), fr = lane & 15, fq = lane >> 4;
    const float* W = w_s + (size_t)g * 128 * 128;
#pragma unroll
    for (int i = 0; i < 8; ++i) { const int f4 = tid + NTHR * i, t = f4 >> 5, s4 = (f4 & 31) * 4; const f32x4 v = *(const f32x4*)(W + t * 128 + s4);
        u32x2 w; w.x = pk2(v[0], v[1]); w.y = pk2(v[2], v[3]); *(LAS u32x2*)(Wl + t * 136 + s4) = w; }
    {
        const int s = tid >> 2, part = tid & 3, d0 = part * 16;
        const bf16_t* src = px + (size_t)(r0 + s) * INC + 2816 + g * 64 + d0;
        const u32x4 w0 = *(const u32x4*)src, w1 = *(const u32x4*)(src + 8);
        float x[16];
        x[0] = bflo(w0.x); x[1] = bfhi(w0.x); x[2] = bflo(w0.y); x[3] = bfhi(w0.y); x[4] = bflo(w0.z); x[5] = bfhi(w0.z); x[6] = bflo(w0.w); x[7] = bfhi(w0.w);
        x[8] = bflo(w1.x); x[9] = bfhi(w1.x); x[10] = bflo(w1.y); x[11] = bfhi(w1.y); x[12] = bflo(w1.z); x[13] = bfhi(w1.z); x[14] = bflo(w1.w); x[15] = bfhi(w1.w);
        float sm = 0.f;
#pragma unroll
        for (int i = 0; i < 16; ++i) { x[i] = gelu_tanh(x[i]); sm += x[i]; }
        sm += __shfl_xor(sm, 1); sm += __shfl_xor(sm, 2);
        const float mu = sm * (1.0f / 64.0f); float q = 0.f;
#pragma unroll
        for (int i = 0; i < 16; ++i) { x[i] -= mu; q += x[i] * x[i]; }
        q += __shfl_xor(q, 1); q += __shfl_xor(q, 2);
        const float rs = rsqrtf(q * (1.0f / 64.0f) + EPS);
#pragma unroll
        for (int i = 0; i < 16; ++i) { const int d = d0 + i; const float y = x[i] * rs * ln_g[g * 64 + d] + ln_b[g * 64 + d]; VnT[d * 136 + s] = f2bf(y); }
    }
    __syncthreads();
    f32x4 acc[4];
#pragma unroll
    for (int db = 0; db < 4; ++db) acc[db] = (f32x4){0.f, 0.f, 0.f, 0.f};
#pragma unroll
    for (int ks = 0; ks < 4; ++ks) { const bf16x8 bw = *(const LAS bf16x8*)(Wl + (wid * 16 + fr) * 136 + ks * 32 + fq * 8);
#pragma unroll
        for (int db = 0; db < 4; ++db) { const bf16x8 av = *(const LAS bf16x8*)(VnT + (db * 16 + fr) * 136 + ks * 32 + fq * 8); acc[db] = mfma16(av, bw, acc[db]); } }
    {
        const int t = wid * 16 + fr, r = r0 + t; const float bias = b_s[g * 128 + t];
        u32x2 uw[4];
#pragma unroll
        for (int db = 0; db < 4; ++db) uw[db] = *(const u32x2*)(px + (size_t)r * INC + 2560 + g * 64 + db * 16 + 4 * fq);
#pragma unroll
        for (int db = 0; db < 4; ++db) { const int col = g * 64 + db * 16 + 4 * fq;
            const float u0 = gelu_tanh(bflo(uw[db].x)), u1 = gelu_tanh(bfhi(uw[db].x)), u2 = gelu_tanh(bflo(uw[db].y)), u3 = gelu_tanh(bfhi(uw[db].y));
            u32x2 w; w.x = pk2(u0 * (acc[db][0] + bias), u1 * (acc[db][1] + bias)); w.y = pk2(u2 * (acc[db][2] + bias), u3 * (acc[db][3] + bias));
            *(u32x2*)(ycat + (size_t)r * DM + 512 + col) = w; }
    }
    __syncthreads();
}

__device__ __forceinline__ void conv_unit(const Ctx& C, int tid, const bf16_t* px, bf16_t* ycat, const float* dw_w  , const float* dw_b, const float* ln_g, const float* ln_b, const bf16_t* pwt  , const float* pw_b, int tix) {
    LAS float* Z = (LAS float*)(C.lds);
    LAS bf16_t* Hn = (LAS bf16_t*)(C.lds + 96256);
    LAS float* Wd = (LAS float*)(C.lds + 130048);
    const int r0 = tix * 64, lane = tid & 63, wid = __builtin_amdgcn_readfirstlane(tid >> 6), fr = lane & 15, fq = lane >> 4;
    const int seg_lo = (r0 < MC) ? (r0 & ~255) : r0, seg_hi = seg_lo + ((r0 < MC) ? 256 : 64);
    {
        f32x4 wv[4]; u32x4 aw[6], gw[6]; bool zin[6];
#pragma unroll
        for (int q = 0; q < 4; ++q) { const int it = tid + q * NTHR; wv[q] = (it < 31 * 64) ? *(const f32x4*)(dw_w + it * 4) : (f32x4){0.f, 0.f, 0.f, 0.f}; }
#pragma unroll
        for (int q = 0; q < 6; ++q) { const int it = tid + q * NTHR, zr = it >> 5, c8 = (it & 31) * 8, r = r0 - 15 + zr;
            zin[q] = (it < 94 * 32) && r >= seg_lo && r < seg_hi;
            const size_t ro = (size_t)(zin[q] ? r : r0) * INC;
            aw[q] = *(const u32x4*)(px + ro + 3072 + c8); gw[q] = *(const u32x4*)(px + ro + 3328 + c8); }
#pragma unroll
        for (int q = 0; q < 4; ++q) { const int it = tid + q * NTHR; if (it < 31 * 64) *(LAS f32x4*)(Wd + it * 4) = wv[q]; }
#pragma unroll
        for (int q = 0; q < 6; ++q) { const int it = tid + q * NTHR, zr = it >> 5, c8 = (it & 31) * 8;
            if (it < 94 * 32) {
                f32x4 z0 = (f32x4){0.f, 0.f, 0.f, 0.f}, z1 = z0;
                if (zin[q]) {
                    z0[0] = bflo(aw[q].x) * sigmoidf_(bflo(gw[q].x)); z0[1] = bfhi(aw[q].x) * sigmoidf_(bfhi(gw[q].x)); z0[2] = bflo(aw[q].y) * sigmoidf_(bflo(gw[q].y)); z0[3] = bfhi(aw[q].y) * sigmoidf_(bfhi(gw[q].y));
                    z1[0] = bflo(aw[q].z) * sigmoidf_(bflo(gw[q].z)); z1[1] = bfhi(aw[q].z) * sigmoidf_(bfhi(gw[q].z)); z1[2] = bflo(aw[q].w) * sigmoidf_(bflo(gw[q].w)); z1[3] = bfhi(aw[q].w) * sigmoidf_(bfhi(gw[q].w));
                }
                *(LAS f32x4*)(Z + zr * 256 + c8) = z0; *(LAS f32x4*)(Z + zr * 256 + c8 + 4) = z1;
            }
        }
    }
    __syncthreads();
    {
        const int t0 = wid * 8, c4 = lane * 4;
        f32x4 acc[8], win[8];
#pragma unroll
        for (int t = 0; t < 8; ++t) acc[t] = (f32x4){0.f, 0.f, 0.f, 0.f};
#pragma unroll
        for (int t = 0; t < 7; ++t) win[t] = *(const LAS f32x4*)(Z + (t0 + t) * 256 + c4);
#pragma unroll 1
        for (int j0 = 0; j0 < 32; j0 += 8) {
#pragma unroll
            for (int jj = 0; jj < 8; ++jj) {
                const int j = j0 + jj;
                if (j < 31) {
                    win[(jj + 7) & 7] = *(const LAS f32x4*)(Z + (t0 + j + 7) * 256 + c4);
                    const f32x4 wj = *(const LAS f32x4*)(Wd + j * 256 + c4);
#pragma unroll
                    for (int t = 0; t < 8; ++t) acc[t] += win[(t + jj) & 7] * wj;
                }
            }
        }
        const f32x4 bv = *(const f32x4*)(dw_b + c4), gv = *(const f32x4*)(ln_g + c4), bb = *(const f32x4*)(ln_b + c4);
#pragma unroll
        for (int t = 0; t < 8; ++t) {
            f32x4 x = acc[t] + bv;
            float sm = (x[0] + x[1]) + (x[2] + x[3]);
            sm += __shfl_xor(sm, 1); sm += __shfl_xor(sm, 2); sm += __shfl_xor(sm, 4); sm += __shfl_xor(sm, 8);
            const float mu = sm * (1.0f / 64.0f);
            x = x - mu;
            float q = (x[0] * x[0] + x[1] * x[1]) + (x[2] * x[2] + x[3] * x[3]);
            q += __shfl_xor(q, 1); q += __shfl_xor(q, 2); q += __shfl_xor(q, 4); q += __shfl_xor(q, 8);
            const float rs = rsqrtf(q * (1.0f / 64.0f) + EPS);
            const f32x4 y = x * rs * gv + bb;
            u32x2 w; w.x = pk2(siluf_(y[0]), siluf_(y[1])); w.y = pk2(siluf_(y[2]), siluf_(y[3]));
            *(LAS u32x2*)(Hn + (t0 + t) * 264 + c4) = w;
        }
    }
    __syncthreads();
    {
        f32x4 acc[2][4];
#pragma unroll
        for (int e = 0; e < 2; ++e)
#pragma unroll
            for (int tb = 0; tb < 4; ++tb) acc[e][tb] = (f32x4){0.f, 0.f, 0.f, 0.f};
#pragma unroll
        for (int ks = 0; ks < 8; ++ks) {
            bf16x8 bh[4];
#pragma unroll
            for (int tb = 0; tb < 4; ++tb) bh[tb] = *(const LAS bf16x8*)(Hn + (tb * 16 + fr) * 264 + ks * 32 + fq * 8);
#pragma unroll
            for (int e = 0; e < 2; ++e) { const bf16x8 aw = *(const bf16x8*)(pwt + (size_t)((2 * wid + e) * 16 + fr) * 256 + ks * 32 + fq * 8);
#pragma unroll
                for (int tb = 0; tb < 4; ++tb) acc[e][tb] = mfma16(aw, bh[tb], acc[e][tb]); }
        }
#pragma unroll
        for (int e = 0; e < 2; ++e) { const int o = (2 * wid + e) * 16 + 4 * fq; const f32x4 pb = *(const f32x4*)(pw_b + o);
#pragma unroll
            for (int tb = 0; tb < 4; ++tb) { const int r = r0 + tb * 16 + fr; const f32x4 y = acc[e][tb] + pb;
                u32x2 w; w.x = pk2(y[0], y[1]); w.y = pk2(y[2], y[3]);
                *(u32x2*)(ycat + (size_t)r * DM + 768 + o) = w; } }
    }
    __syncthreads();
}

__device__ __forceinline__ void phase_xa(const Ctx& C, const bf16_t* px, bf16_t* ycat, const float* onorm_g, int r_lo) {
    PHASE_IDS();
    const int gw = C.bid * 8 + wid, NGW = C.G * 8;
    const int col = 8 * lane;
    const f32x4 gn0 = *(const f32x4*)(onorm_g + col), gn1 = *(const f32x4*)(onorm_g + col + 4);
    for (int r = r_lo + gw; r < MT; r += 4 * NGW) {
        u32x4 wf[4], wb[4], wg[4]; bool ok[4];
#pragma unroll
        for (int q = 0; q < 4; ++q) { const int rq = r + q * NGW; ok[q] = rq < MT; const bf16_t* pr = px + (size_t)(ok[q] ? rq : r) * INC;
            wf[q] = *(const u32x4*)(pr + 512 + col); wb[q] = *(const u32x4*)(pr + 1024 + col); wg[q] = *(const u32x4*)(pr + 2048 + col); }
#pragma unroll
        for (int q = 0; q < 4; ++q) {
            float o[8];
            o[0] = bflo(wf[q].x) + bflo(wb[q].x); o[1] = bfhi(wf[q].x) + bfhi(wb[q].x); o[2] = bflo(wf[q].y) + bflo(wb[q].y); o[3] = bfhi(wf[q].y) + bfhi(wb[q].y);
            o[4] = bflo(wf[q].z) + bflo(wb[q].z); o[5] = bfhi(wf[q].z) + bfhi(wb[q].z); o[6] = bflo(wf[q].w) + bflo(wb[q].w); o[7] = bfhi(wf[q].w) + bfhi(wb[q].w);
            float ss = 0.f;
#pragma unroll
            for (int i = 0; i < 8; ++i) ss += o[i] * o[i];
            ss += __shfl_xor(ss, 1); ss += __shfl_xor(ss, 2); ss += __shfl_xor(ss, 4); ss += __shfl_xor(ss, 8);
            const float rs = rsqrtf(ss * (1.0f / 128.0f) + EPS);
            const float g0 = siluf_(bflo(wg[q].x)), g1 = siluf_(bfhi(wg[q].x)), g2 = siluf_(bflo(wg[q].y)), g3 = siluf_(bfhi(wg[q].y));
            const float g4 = siluf_(bflo(wg[q].z)), g5 = siluf_(bfhi(wg[q].z)), g6 = siluf_(bflo(wg[q].w)), g7 = siluf_(bfhi(wg[q].w));
            u32x4 w;
            w.x = pk2(o[0] * rs * gn0[0] * g0, o[1] * rs * gn0[1] * g1); w.y = pk2(o[2] * rs * gn0[2] * g2, o[3] * rs * gn0[3] * g3);
            w.z = pk2(o[4] * rs * gn1[0] * g4, o[5] * rs * gn1[1] * g5); w.w = pk2(o[6] * rs * gn1[2] * g6, o[7] * rs * gn1[3] * g7);
            if (ok[q]) *(u32x4*)(ycat + (size_t)(r + q * NGW) * DM + col) = w;
        }
    }
}

#ifdef DBG_STOP
__device__ __forceinline__ void dbg_digest(const Ctx& C, const XcdBarrier& bar, float* out, const bf16_t* pb, size_t nb, const float* pf, size_t nf) {
    xcd_barrier(bar);
    const size_t NO = (size_t)ML * DM;
    for (size_t i = (size_t)C.bid * NTHR + threadIdx.x; i < NO; i += (size_t)C.G * NTHR) {
        float s = 0.f;
        for (size_t j = i; j < nb; j += NO) s += bf2f(pb[j]);
        for (size_t j = i; j < nf; j += NO) s += pf[j];
        if (!(fabsf(s) < 1e30f)) s = 7777.0f;
        out[i] = s;
    }
}
#define DBG_AT(n, pb, nb, pf, nf) if (DBG_STOP == (n) && l == DBG_L) { dbg_digest(C, bar, a.out, (pb), (nb), (pf), (nf)); return; }
#else
#define DBG_AT(n, pb, nb, pf, nf)
#define DBG_L 0
#endif
__global__ void __launch_bounds__(NTHR, 2) fwd_megakernel(Args a) {
    extern __shared__ __attribute__((aligned(16))) unsigned char lds_raw[];
    cg::grid_group grid = cg::this_grid();
    Ctx C;
    C.lds = (LAS unsigned char*)lds_raw;
    C.G = gridDim.x; C.bid = blockIdx.x;
    volatile LAS unsigned* barw = (volatile LAS unsigned*)(C.lds + LDS_BARW);
    if (threadIdx.x < 4) barw[threadIdx.x] = 0u;
    __syncthreads();
    XcdBarrier bar = xcd_barrier_post((unsigned*)(a.ws + WS_CTL), barw);

    float* MOD = (float*)(a.ws + WS_MOD);
    float* DEC = (float*)(a.ws + WS_DEC);
    float* XC = (float*)(a.ws + WS_XC);
    bf16_t* ABF = (bf16_t*)(a.ws + WS_ABF);
    bf16_t* PX = (bf16_t*)(a.ws + WS_PX);
    float* US = (float*)(a.ws + WS_US);
    float* PTAIL = (float*)(a.ws + WS_PX + (size_t)MT * DFF * 2);

#ifdef DBG_TIME
    unsigned long long t_last = __builtin_amdgcn_s_memrealtime(); unsigned long long t_cat[12] = {0,0,0,0,0,0,0,0,0,0,0,0};
#define TS(c) do { const unsigned long long _n = __builtin_amdgcn_s_memrealtime(); t_cat[c] += _n - t_last; t_last = _n; } while (0)
#else
#define TS(c)
#endif
    phase_p0(C, a);
    grid.sync();
    TS(0);

    const int dbgl = (a.in[0] == nullptr) ? 1 : 0; (void)dbgl;
    for (int l = 0; l < 2; ++l) {
        unsigned char* wt = a.ws + WS_WT + (size_t)l * WT_LAYER;
        const float* mod_l = MOD + (size_t)l * 5 * 6144;
        const float* srcc = (l == 0) ? a.in[2] : XC;
        const float* srcl = (l == 0) ? a.in[0] : a.out;
        DBG_AT(17, PX, 0, a.out, (size_t)ML * DM)
        { CtxFix fx{PTAIL, US, 6, (l == 0) ? 0 : 11, MOD + (size_t)4 * 6144 + 5 * 1024, nullptr};
          phase_norm(C, srcc, srcl, a.in[6] + l * DM, mod_l, 0, 1, ABF, 0, (l == 0) ? MT : MC, fx); }
        if (l == 0) { for (int i = C.bid * NTHR + threadIdx.x; i < MC * DM / 4; i += C.G * NTHR) ((f32x4*)XC)[i] = ((const f32x4*)a.in[2])[i]; }
        GRID_BAR();
        TS(1);

#if defined(DBG_STOP) && DBG_STOP == 14
        if (l == 1) {
            xcd_barrier(bar);
            const bf16_t* w1 = (const bf16_t*)(a.ws + WS_WT + WT_LAYER + WT_IN);
            for (size_t i = (size_t)C.bid * NTHR + threadIdx.x; i < (size_t)ML * DM; i += (size_t)C.G * NTHR) {
                float v = 0.f;
                #define BADF(x) (!(fabsf(x) < 1e30f))
                if (BADF(bf2f(ABF[i])) || (i + (size_t)ML * DM < (size_t)MT * DM && BADF(bf2f(ABF[i + (size_t)ML * DM])))) v = 500.f;
                if (i < (size_t)MC * DM && BADF(XC[i])) v = 1000.f;
                if (BADF(a.out[i])) v = 2000.f;
                if (i < 61440 && BADF(MOD[i])) v = 3000.f;
                if (i < (size_t)INC * DM && BADF(bf2f(w1[i]))) v = 4000.f;
                a.out[i] = v;
            }
            return;
        }
#endif
        DBG_AT(15, PX, 0, a.out, (size_t)ML * DM)
        DBG_AT(16, ABF, (size_t)MT * DM, XC, (size_t)MC * DM)
        { pg8::Gemm g{ABF, (const bf16_t*)(wt + WT_IN)}; pg8::StaticOrder S; S.init(MT / 256, INC / 256, C.G, C.bid, 0);
          pg8::EpiBf16 E{PX, INC}; pg8::gemm_phase<DM, DM, true>(C.lds, g, S, E); }
        GRID_BAR();
        TS(2);
        DBG_AT(1, PX, (size_t)MT * INC, MOD, (size_t)2 * 5 * 6144)
        { const int tid = fresh_tid(); for (int u = C.bid; u < 32 * 16; u += C.G) { if (l == 0) scan_pass1_unit<true>(C, tid, PX, US, DEC, a.in[8], l, u & 31, u >> 5); else scan_pass1_unit<false>(C, tid, PX, US, DEC, a.in[8], l, u & 31, u >> 5); } }
        GRID_BAR();
        TS(3);
        phase_s2(C, US, DEC);
        GRID_BAR();
        TS(4);
        DBG_AT(2, PX, 0, US, (size_t)32 * 16 * 128 * 128)
        {
            const int tid = fresh_tid();
            const int sc0 = (l == 0) ? 0 : 1, nS = 32 * (17 - sc0);
            const int cb0 = (l == 0) ? 0 : 8, nB = (136 - cb0) * 4, ct0 = (l == 0) ? 0 : 16, nC = 272 - ct0;
            int nscan = 0;
            for (int u = C.bid; u < nS; u += C.G) { if (l == 0) scan_unit<3, true>(C, tid, PX, US, DEC, a.in[8], l, u & 31, sc0 + (u >> 5)); else scan_unit<3, false>(C, tid, PX, US, DEC, a.in[8], l, u & 31, sc0 + (u >> 5)); ++nscan; }
            const int extra = nS % C.G;
            const int nsmall = nB + nC;
            int first, stride;
            if (extra > 0 && extra < C.G) { if (C.bid < extra) { first = nsmall; stride = 1; } else { first = C.bid - extra; stride = C.G - extra; } }
            else { first = C.bid; stride = C.G; }
            for (int v = first; v < nsmall; v += stride) {
                if (v < nC) conv_unit(C, tid, PX, ABF, a.in[14] + (size_t)l * 31 * 256, a.in[15] + l * 256, a.in[16] + l * 256, a.in[17] + l * 256, (const bf16_t*)(wt + WT_PW), a.in[19] + l * 256, ct0 + v);
                else { const int w = v - nC; gmlp_unit(C, tid, PX, ABF, a.in[12] + (size_t)l * 4 * 128 * 128, a.in[13] + l * 512, a.in[10] + l * 256, a.in[11] + l * 256, cb0 + (w >> 2), w & 3); }
            }
            (void)nscan;
        }
        GRID_BAR();
        TS(5);
        DBG_AT(3, PX, (size_t)MT * INC, US, 0)
        DBG_AT(4, ABF, (size_t)MT * DM, US, 0)
        phase_xa(C, PX, ABF, a.in[9] + l * 512, (l == 0) ? 0 : MC);
        GRID_BAR();
        TS(6);
        DBG_AT(5, ABF, (size_t)MT * DM, US, 0)
        { pg8::Gemm g{ABF, (const bf16_t*)(wt + WT_OUT)}; pg8::StaticOrder S; S.init(ML / 256, DM / 256, C.G, C.bid, 4);
          pg8::EpiResNorm E{srcl, a.out, mod_l + 2 * 1024, a.in[21] + l * DM, mod_l + 3 * 1024, mod_l + 4 * 1024, ABF,
                            (float*)(a.ws + WS_XB) + (size_t)(l * 2 + 0) * ML * 4, (unsigned*)(a.ws + WS_CNT) + (size_t)(l * 2 + 0) * 64 * 64};
          pg8::gemm_phase<DM, DM, false>(C.lds, g, S, E);
          if (l == 0) { pg8::SliceOrder SS; SS.init(4, C.G, C.bid);
              pg8::EpiPartial EA{US, US, 4}; pg8::gemm_phase<DM, 256, false>(C.lds, g, SS, EA); } }
        GRID_BAR();
        TS(7);
        DBG_AT(6, PX, 0, a.out, (size_t)ML * DM)
        DBG_AT(11, ABF, (size_t)MC * DM, XC, (size_t)MC * DM)
        if (l == 0) {
            { CtxFix fx{US, US, 4, 4, mod_l + (size_t)4 * 6144 + 2 * 1024, XC};
              phase_norm(C, XC, a.out, a.in[21] + l * DM, mod_l, 3, 4, ABF, 0, MC, fx); }
            GRID_BAR();
        }
        TS(1);
        DBG_AT(7, ABF, (size_t)MT * DM, US, 0)
        { const int pm0 = (l == 0) ? 0 : 4;
          pg8::Gemm g{ABF, (const bf16_t*)(wt + WT_13)}; pg8::StaticOrder S; S.init(MT / 256 - pm0, 2 * DFF / 256, C.G, C.bid, pm0);
          pg8::EpiSwiglu E{PX, DFF}; pg8::gemm_phase<DM, DM, true>(C.lds, g, S, E); }
        GRID_BAR();
        TS(8);
        DBG_AT(8, PX, (size_t)MT * DFF, US, 0)
        { pg8::Gemm g{PX, (const bf16_t*)(wt + WT_2)}; pg8::StaticOrder S; S.init(ML / 256, DM / 256, C.G, C.bid, 4);
          const float* mod_n = MOD + (size_t)1 * 5 * 6144;
          pg8::EpiResNorm E{a.out, a.out, mod_l + 5 * 1024, (l == 0) ? a.in[6] + DM : a.in[24], (l == 0) ? mod_n : nullptr, (l == 0) ? mod_n + 1024 : nullptr, (l == 0) ? ABF : nullptr,
                            (float*)(a.ws + WS_XB) + (size_t)(l * 2 + 1) * ML * 4, (unsigned*)(a.ws + WS_CNT) + (size_t)(l * 2 + 1) * 64 * 64};
          pg8::gemm_phase<DFF, DFF, false>(C.lds, g, S, E);
          if (l == 0) { pg8::SliceOrder SS; SS.init(11, C.G, C.bid);
              pg8::EpiPartial EA{PTAIL, US, 6}; pg8::gemm_phase<DFF, 256, false>(C.lds, g, SS, EA); } }
        if (l == 0) GRID_BAR();
        TS(9);
        DBG_AT(10, PX, 0, a.out, (size_t)ML * DM)
    }
    { const int l = DBG_L; DBG_AT(9, PX, 0, a.out, (size_t)ML * DM) }
#ifdef DBG_TIME
    TS(10);
    __syncthreads();
    if (C.bid == 0) {
        unsigned long long ta = 0, tb = 0;
#pragma unroll
        for (int c = 0; c < 12; ++c) { if ((DBG_SEL_A >> c) & 1) ta += t_cat[c]; if ((DBG_SEL_B >> c) & 1) tb += t_cat[c]; }
        const float fa = (float)ta * 0.01f, fb = (float)tb * 0.01f;
        for (int i = threadIdx.x; i <= 1000; i += NTHR) a.out[i] = (i == 0) ? fa * 0.25f : fb * 0.01f;
    }
#endif
}

extern "C" void kernel_launch(void* const* d_in, const int* in_sizes, int n_in, void* d_out, int out_size, void* d_ws, size_t ws_size, hipStream_t stream) {
    static int grid = 0;
    if (grid == 0) {
        int dev = 0, cus = 0, per_cu = 0;
        hipGetDevice(&dev);
        hipDeviceGetAttribute(&cus, hipDeviceAttributeMultiprocessorCount, dev);
        hipFuncSetAttribute((const void*)fwd_megakernel, hipFuncAttributeMaxDynamicSharedMemorySize, LDS_BYTES);
        hipOccupancyMaxActiveBlocksPerMultiprocessor(&per_cu, (const void*)fwd_megakernel, NTHR, LDS_BYTES);
        if (per_cu < 1) per_cu = 1;
        grid = cus;
        if (ws_size < WS_END) fprintf(stderr, "kernel_launch: workspace too small: %zu < %zu\n", ws_size, (size_t)WS_END);
        (void)hipGetLastError();
    }
    hipMemsetAsync((char*)d_ws + WS_CTL, 0, CTL_BYTES, stream);
    Args a{};
    for (int i = 0; i < 25; ++i) a.in[i] = (const float*)d_in[i];
    a.out = (float*)d_out; a.ws = (unsigned char*)d_ws;
    void* args[] = {&a};
    hipError_t e = hipLaunchCooperativeKernel((const void*)fwd_megakernel, dim3(grid), dim3(NTHR), args, LDS_BYTES, stream);
    if (e != hipSuccess) fprintf(stderr, "cooperative launch failed: %s (grid %d)\n", hipGetErrorString(e), grid);
}
```

```cpp
#include <hip/hip_runtime.h>
#include <hip/hip_cooperative_groups.h>
#include <cstdio>
namespace cg = cooperative_groups;
#define USE_XCD_BAR 1
#ifndef USE_XCD_BAR
#define GRID_BAR() grid.sync()
#else
#define GRID_BAR() xcd_barrier(bar)
#endif

#define LAS __attribute__((address_space(3)))
typedef unsigned short bf16_t;
typedef short bf16x8 __attribute__((ext_vector_type(8)));
typedef float f32x4 __attribute__((ext_vector_type(4)));
typedef float f32x2 __attribute__((ext_vector_type(2)));
typedef unsigned u32x4 __attribute__((ext_vector_type(4)));
typedef unsigned u32x2 __attribute__((ext_vector_type(2)));

constexpr int DM = 1024, NBATCH = 4, SEQ = 4096, CTXL = 256;
constexpr int MC = NBATCH * CTXL;
constexpr int ML = NBATCH * SEQ;
constexpr int MT = MC + ML;
constexpr int INC = 3584, DFF = 2816;
constexpr float EPS = 1e-6f;
constexpr int NTHR = 512;
constexpr int LDS_BYTES = 163840;
constexpr int LDS_BARW = LDS_BYTES - 64;

constexpr size_t WS_CTL = 0;
constexpr size_t CTL_BYTES = 131072;
constexpr size_t WS_CNT = 16384;
constexpr size_t WS_XB = 131072;
constexpr size_t WS_MOD = WS_XB + 1048576;
constexpr size_t WS_DEC = WS_MOD + 262144;
constexpr size_t WS_WT = WS_DEC + 524288;
constexpr size_t WT_IN = 0, WT_OUT = WT_IN + (size_t)INC * DM * 2, WT_13 = WT_OUT + (size_t)DM * DM * 2,
                 WT_2 = WT_13 + (size_t)2 * DFF * DM * 2, WT_PW = WT_2 + (size_t)DM * DFF * 2, WT_LAYER = WT_PW + (size_t)256 * 256 * 2;
constexpr size_t WS_XC = WS_WT + 2 * WT_LAYER;
constexpr size_t WS_ABF = WS_XC + (size_t)MC * DM * 4;
constexpr size_t WS_PX = WS_ABF + (size_t)MT * DM * 2;
constexpr size_t WS_US = WS_PX + (size_t)MT * INC * 2;
constexpr size_t WS_END = WS_US + (size_t)32 * 16 * 128 * 128 * 4;

__device__ __forceinline__ float bf2f(bf16_t v) { return __uint_as_float(((unsigned)v) << 16); }
__device__ __forceinline__ float bflo(unsigned w) { return __uint_as_float(w << 16); }
__device__ __forceinline__ float bfhi(unsigned w) { return __uint_as_float(w & 0xffff0000u); }
typedef __bf16 bf16x2_t __attribute__((ext_vector_type(2)));
__device__ __forceinline__ unsigned pk2(float lo, float hi) { const f32x2 v = {lo, hi}; const bf16x2_t b = __builtin_convertvector(v, bf16x2_t); return __builtin_bit_cast(unsigned, b); }
__device__ __forceinline__ bf16_t f2bf(float v) { return (bf16_t)(pk2(v, 0.f) & 0xffffu); }
__device__ __forceinline__ float sigmoidf_(float x) { return __builtin_amdgcn_rcpf(1.0f + __expf(-x)); }
__device__ __forceinline__ float siluf_(float x) { return x * sigmoidf_(x); }
__device__ __forceinline__ float gelu_tanh(float x) { const float y = 0.7978845608028654f * (x + 0.044715f * x * x * x); return x * sigmoidf_(2.0f * y); }
__device__ __forceinline__ void logsig2(float zl, float& ls, float& ln) {
    const float e = __builtin_amdgcn_exp2f(-fabsf(zl));
    const float L2 = __builtin_amdgcn_logf(1.0f + e);
    ls = fminf(zl, 0.f) - L2; ln = ls - zl;
}
constexpr float LOG2E = 1.4426950408889634f;
__device__ __forceinline__ float wave_sum(float v) {
#pragma unroll
    for (int o = 1; o < 64; o <<= 1) v += __shfl_xor(v, o);
    return v;
}
__device__ __forceinline__ f32x4 mfma16(bf16x8 a, bf16x8 b, f32x4 c) { return __builtin_amdgcn_mfma_f32_16x16x32_bf16(a, b, c, 0, 0, 0); }
#define LDS_WAIT() asm volatile("s_waitcnt lgkmcnt(0)" ::: "memory")
#define LBAR() do { asm volatile("s_waitcnt lgkmcnt(0)" ::: "memory"); __builtin_amdgcn_s_barrier(); asm volatile("" ::: "memory"); } while (0)
__device__ __forceinline__ int fresh_tid() { int t = threadIdx.x; asm volatile("" : "+v"(t)); return t; }
#define PHASE_IDS() const int tid = fresh_tid(), lane = tid & 63, wid = __builtin_amdgcn_readfirstlane(tid >> 6); (void)lane; (void)wid

#define XB_TMO      128
#define XB_XCNT(j)  (256  + 64 * (j))
#define XB_XSUB(j)  (1280 + 64 * (j))
#define XB_XGEN(j)  (2304 + 64 * (j))
#define XB_TOP      3328
#define XB_TOPGEN   3392
#define XCD_BAR_WORDS 3456
#define XB_SPIN_CAP (1u << 20)
__device__ __forceinline__ unsigned xb_ld(unsigned* p)              { return __hip_atomic_load(p, __ATOMIC_RELAXED, __HIP_MEMORY_SCOPE_AGENT); }
__device__ __forceinline__ unsigned xb_add(unsigned* p, unsigned v) { return __hip_atomic_fetch_add(p, v, __ATOMIC_RELAXED, __HIP_MEMORY_SCOPE_AGENT); }
__device__ __forceinline__ unsigned xb_xcc_id() { return (unsigned)__builtin_amdgcn_s_getreg((3 << 11) | 20) & 0xFu; }
#define XB_SPIN(cond, bar) do { unsigned _sp = 0; while (cond) { __builtin_amdgcn_s_sleep(1); \
    if ((++_sp & 255u) == 0u) { if (xb_ld(&(bar)[XB_TMO])) break; if (_sp > XB_SPIN_CAP) { atomicAdd(&(bar)[XB_TMO], 1u); break; } } } } while (0)
struct XcdBarrier { unsigned* bar; unsigned x; volatile LAS unsigned* st; };
__device__ __forceinline__ XcdBarrier xcd_barrier_post(unsigned* bar, volatile LAS unsigned* st) {
    XcdBarrier b; b.bar = bar; b.x = xb_xcc_id(); b.st = st;
    if (threadIdx.x == 0) (void)xb_add(&bar[XB_XCNT(b.x)], 1u);
    return b;
}
__device__ __forceinline__ void xcd_barrier_complete(unsigned* bar, unsigned x, unsigned& nloc, unsigned& nx) {
    const unsigned G = gridDim.x * gridDim.y * gridDim.z;
    unsigned sum, cnt, mine, sp = 0u;
    for (;;) {
        sum = 0u; cnt = 0u; mine = 0u;
#pragma unroll
        for (unsigned j = 0; j < 16; ++j) { const unsigned c = xb_ld(&bar[XB_XCNT(j)]); sum += c; cnt += (c > 0u) ? 1u : 0u; mine = (j == x) ? c : mine; }
        if (sum == G) break;
        __builtin_amdgcn_s_sleep(1);
        if ((++sp & 255u) == 0u) { if (xb_ld(&bar[XB_TMO])) break; if (sp > XB_SPIN_CAP) { atomicAdd(&bar[XB_TMO], 1u); break; } }
    }
    nloc = mine > 0u ? mine : 1u; nx = cnt > 0u ? cnt : 1u;
}
__device__ __forceinline__ void xcd_barrier(const XcdBarrier& b) {
    asm volatile("s_waitcnt vmcnt(0)" ::: "memory");
    __syncthreads();
    if (threadIdx.x == 0) {
        unsigned* bar = b.bar;
        __builtin_amdgcn_s_waitcnt(0);
        unsigned nloc = b.st[0], nx = b.st[1];
        if (nloc == 0u) { xcd_barrier_complete(bar, b.x, nloc, nx); b.st[0] = nloc; b.st[1] = nx; }
        const unsigned old = xb_add(&bar[XB_XSUB(b.x)], 1u);
        const unsigned gen = old / nloc;
        if (old + 1u == (gen + 1u) * nloc) {
            __builtin_amdgcn_fence(__ATOMIC_RELEASE, "agent");
            asm volatile("s_waitcnt vmcnt(0)" ::: "memory");
            const unsigned og = xb_add(&bar[XB_TOP], 1u);
            const unsigned tg = og / nx;
            if (og + 1u == (tg + 1u) * nx) xb_add(&bar[XB_TOPGEN], 1u);
            else XB_SPIN(xb_ld(&bar[XB_TOPGEN]) == tg, bar);
            __builtin_amdgcn_fence(__ATOMIC_ACQUIRE, "agent");
            xb_add(&bar[XB_XGEN(b.x)], 1u);
            asm volatile("s_waitcnt vmcnt(0)" ::: "memory");
        } else {
            XB_SPIN(xb_ld(&bar[XB_XGEN(b.x)]) == gen, bar);
            __builtin_amdgcn_fence(__ATOMIC_ACQUIRE, "agent");
            asm volatile("s_waitcnt vmcnt(0)" ::: "memory");
        }
    }
    __syncthreads();
}

namespace pg8 {
constexpr int BM = 256, BK = 64, HALF = 128, HTB = HALF * BK * 2, STAGE_BYTES = 8 * HTB, NXCD = 8, WGM = 4;
__device__ __forceinline__ int lds_byte(int r, int c) { const int st = (r >> 4) * 2 + (c >> 5), rr = r & 15, cc = c & 31, ob = rr * 64 + cc * 2; return st * 1024 + (ob ^ (((ob >> 9) & 1) << 5)); }
__device__ __forceinline__ void stage_rc(int b, int& R, int& C) { const int st = b / 1024, sb = b % 1024, swz = sb ^ (((sb >> 9) & 1) << 5); R = (st >> 1) * 16 + swz / 64; C = (st & 1) * 32 + (swz % 64) / 2; }
__device__ __forceinline__ int perm32(int rho) { const int n = rho >> 4, i = rho & 15; return 8 * (i >> 2) + 4 * n + (i & 3); }
struct Unit { int pm, pn, k0; };
struct Gemm { const bf16_t* A; const bf16_t* Bt; };
struct StaticOrder {
    int nM, nN, nwg, G, c, pm0;
    __device__ void init(int nM_, int nN_, int G_, int c_, int pm0_) { nM = nM_; nN = nN_; nwg = nM * nN; G = G_; c = c_; pm0 = pm0_; }
    __device__ bool next(int i, Unit& u) const {
        const long L = (long)i * G + c; if (L >= nwg) return false;
        int wgid = (int)L; { const int q = nwg / NXCD, r = nwg % NXCD, xcd = wgid % NXCD, off = wgid / NXCD; wgid = (xcd < r ? xcd * (q + 1) : r * (q + 1) + (xcd - r) * q) + off; }
        const int nig = WGM * nN, gid = wgid / nig, fm = gid * WGM, gsz = (nM - fm) < WGM ? (nM - fm) : WGM;
        u.pm = pm0 + fm + ((wgid % nig) % gsz); u.pn = (wgid % nig) / gsz; u.k0 = 0; return true;
    }
};

struct EpiBf16 {
    static constexpr bool PERM = true, AFTER_DRAIN = false;
    bf16_t* O; int ldc;
    __device__ __forceinline__ void operator()(const f32x4 (&acc)[2][2][4][2], const Unit& u, int wr, int wc, int fr, int fq) const {
        const int row0 = u.pm * BM + wr * 64 + fr; const int col0 = u.pn * BM + wc * 32 + 8 * fq;
#pragma unroll
        for (int ai = 0; ai < 2; ++ai)
#pragma unroll
            for (int m = 0; m < 4; ++m) { bf16_t* rowp = O + (size_t)(row0 + ai * HALF + m * 16) * ldc + col0;
#pragma unroll
                for (int bj = 0; bj < 2; ++bj) { const f32x4 v0 = acc[ai][bj][m][0], v1 = acc[ai][bj][m][1];
                    u32x4 w; w.x = pk2(v0[0], v0[1]); w.y = pk2(v0[2], v0[3]); w.z = pk2(v1[0], v1[1]); w.w = pk2(v1[2], v1[3]);
                    *(u32x4*)(rowp + bj * HALF) = w; } }
    }
};
struct EpiSwiglu {
    static constexpr bool PERM = true, AFTER_DRAIN = false;
    bf16_t* O; int ldc;
    __device__ __forceinline__ void operator()(const f32x4 (&acc)[2][2][4][2], const Unit& u, int wr, int wc, int fr, int fq) const {
        const int row0 = u.pm * BM + wr * 64 + fr; const int col0 = u.pn * HALF + wc * 32 + 8 * fq;
#pragma unroll
        for (int ai = 0; ai < 2; ++ai)
#pragma unroll
            for (int m = 0; m < 4; ++m) { bf16_t* rowp = O + (size_t)(row0 + ai * HALF + m * 16) * ldc + col0;
                float o[8];
#pragma unroll
                for (int n = 0; n < 2; ++n)
#pragma unroll
                    for (int j = 0; j < 4; ++j) { const float a = acc[ai][0][m][n][j], b = acc[ai][1][m][n][j]; o[n * 4 + j] = siluf_(a) * b; }
                u32x4 w; w.x = pk2(o[0], o[1]); w.y = pk2(o[2], o[3]); w.z = pk2(o[4], o[5]); w.w = pk2(o[6], o[7]);
                *(u32x4*)rowp = w; }
    }
};
struct EpiRes {
    static constexpr bool PERM = false, AFTER_DRAIN = false;
    const float* base_c; const float* base_l; float* out_c; float* out_l; const float* gate;
    __device__ __forceinline__ void operator()(const f32x4 (&acc)[2][2][4][2], const Unit& u, int wr, int wc, int fr, int fq) const {
        const int bi = (u.pm < 4) ? 4 : ((u.pm - 4) >> 4);
        const float* base = (u.pm < 4) ? base_c + (size_t)u.pm * BM * DM : base_l + (size_t)(u.pm - 4) * BM * DM;
        float* out = (u.pm < 4) ? out_c + (size_t)u.pm * BM * DM : out_l + (size_t)(u.pm - 4) * BM * DM;
        const int row0 = wr * 64 + fr, col0 = u.pn * BM + wc * 32 + 4 * fq;
        f32x4 gv[2][2];
#pragma unroll
        for (int bj = 0; bj < 2; ++bj)
#pragma unroll
            for (int n = 0; n < 2; ++n) gv[bj][n] = *(const f32x4*)(gate + (size_t)bi * 6144 + col0 + bj * HALF + n * 16);
#pragma unroll
        for (int ai = 0; ai < 2; ++ai)
#pragma unroll
            for (int mh = 0; mh < 2; ++mh) {
                f32x4 bs[2][2][2];
#pragma unroll
                for (int m2 = 0; m2 < 2; ++m2) { const size_t off = (size_t)(row0 + ai * HALF + (mh * 2 + m2) * 16) * DM + col0;
#pragma unroll
                    for (int bj = 0; bj < 2; ++bj)
#pragma unroll
                        for (int n = 0; n < 2; ++n) bs[m2][bj][n] = *(const f32x4*)(base + off + bj * HALF + n * 16); }
#pragma unroll
                for (int m2 = 0; m2 < 2; ++m2) { const size_t off = (size_t)(row0 + ai * HALF + (mh * 2 + m2) * 16) * DM + col0;
#pragma unroll
                    for (int bj = 0; bj < 2; ++bj)
#pragma unroll
                        for (int n = 0; n < 2; ++n) *(f32x4*)(out + off + bj * HALF + n * 16) = bs[m2][bj][n] + gv[bj][n] * acc[ai][bj][mh * 2 + m2][n]; }
            }
    }
};

struct EpiResNorm {
    static constexpr bool PERM = false, AFTER_DRAIN = true;
    const float* base_l; float* out_l; const float* gate;
    const float* ng; const float* nsh; const float* nsc;
    bf16_t* hn; float* xbuf; unsigned* cnt;
    __device__ __forceinline__ void fused(f32x4 (&acc)[2][2][4][2], const Unit& u, int wr, int wc, int fr, int fq, LAS unsigned char* lds, int wid, int lane) const {
        const int pl = u.pm - 4, bi = pl >> 4;
        const float* base = base_l + (size_t)pl * BM * DM; float* out = out_l + (size_t)pl * BM * DM;
        const int row0 = wr * 64 + fr, col0 = u.pn * BM + wc * 32 + 4 * fq;
        LAS float* P = (LAS float*)lds;
        LAS float* S = (LAS float*)(lds + 4096);
        f32x4 gv[2][2];
#pragma unroll
        for (int bj = 0; bj < 2; ++bj)
#pragma unroll
            for (int n = 0; n < 2; ++n) gv[bj][n] = *(const f32x4*)(gate + (size_t)bi * 6144 + col0 + bj * HALF + n * 16);
#pragma unroll
        for (int ai = 0; ai < 2; ++ai)
#pragma unroll
            for (int mh = 0; mh < 2; ++mh) {
                f32x4 bs[2][2][2];
#pragma unroll
                for (int m2 = 0; m2 < 2; ++m2) { const size_t off = (size_t)(row0 + ai * HALF + (mh * 2 + m2) * 16) * DM + col0;
#pragma unroll
                    for (int bj = 0; bj < 2; ++bj)
#pragma unroll
                        for (int n = 0; n < 2; ++n) bs[m2][bj][n] = *(const f32x4*)(base + off + bj * HALF + n * 16); }
#pragma unroll
                for (int m2 = 0; m2 < 2; ++m2) { const int m = mh * 2 + m2; const size_t off = (size_t)(row0 + ai * HALF + m * 16) * DM + col0;
                    float sq = 0.f;
#pragma unroll
                    for (int bj = 0; bj < 2; ++bj)
#pragma unroll
                        for (int n = 0; n < 2; ++n) { const f32x4 x = bs[m2][bj][n] + gv[bj][n] * acc[ai][bj][m][n]; acc[ai][bj][m][n] = x;
                            if (hn) *(f32x4*)(out + off + bj * HALF + n * 16) = x;
                            sq += (x[0] * x[0] + x[1] * x[1]) + (x[2] * x[2] + x[3] * x[3]); }
                    sq += __shfl_xor(sq, 16); sq += __shfl_xor(sq, 32);
                    if (fq == 0) P[(ai * HALF + wr * 64 + m * 16 + fr) * 4 + wc] = sq; }
            }
        f32x4 ngv[2][2], shv[2][2];
#pragma unroll
        for (int bj = 0; bj < 2; ++bj)
#pragma unroll
            for (int n = 0; n < 2; ++n) { const int c = col0 + bj * HALF + n * 16; ngv[bj][n] = *(const f32x4*)(ng + c);
                if (nsh) { shv[bj][n] = *(const f32x4*)(nsh + (size_t)bi * 6144 + c); ngv[bj][n] = ngv[bj][n] * (*(const f32x4*)(nsc + (size_t)bi * 6144 + c) + 1.0f); }
                else shv[bj][n] = (f32x4){0.f, 0.f, 0.f, 0.f}; }
        asm volatile("s_waitcnt lgkmcnt(0)" ::: "memory"); __builtin_amdgcn_s_barrier(); asm volatile("" ::: "memory");
        const int row = wid * 32 + (lane & 31);
        if (lane < 32) { const float t = (P[row * 4 + 0] + P[row * 4 + 1]) + (P[row * 4 + 2] + P[row * 4 + 3]);
            __hip_atomic_store(xbuf + ((size_t)(pl * BM + row) * 4 + u.pn), t, __ATOMIC_RELAXED, __HIP_MEMORY_SCOPE_AGENT); }
        asm volatile("s_waitcnt vmcnt(0)" ::: "memory");
        if (lane == 0) __hip_atomic_fetch_add(cnt + 64 * pl, 1u, __ATOMIC_RELAXED, __HIP_MEMORY_SCOPE_AGENT);
        if (wid == 0) {
            unsigned sp = 0;
            while ((unsigned)__builtin_amdgcn_readfirstlane(__hip_atomic_load(cnt + 64 * pl, __ATOMIC_RELAXED, __HIP_MEMORY_SCOPE_AGENT)) < 32u) { __builtin_amdgcn_s_sleep(2); if (++sp > (1u << 22)) break; }
            __builtin_amdgcn_fence(__ATOMIC_ACQUIRE, "agent");
        }
        asm volatile("s_waitcnt vmcnt(0) lgkmcnt(0)" ::: "memory"); __builtin_amdgcn_s_barrier(); asm volatile("" ::: "memory");
        if (lane < 32) { const float* sl = xbuf + (size_t)(pl * BM + row) * 4; float ss = 0.f;
#pragma unroll
            for (int t = 0; t < 4; ++t) ss += __hip_atomic_load(sl + t, __ATOMIC_RELAXED, __HIP_MEMORY_SCOPE_AGENT);
            S[row] = rsqrtf(ss * (1.0f / DM) + EPS); }
        asm volatile("s_waitcnt lgkmcnt(0)" ::: "memory"); __builtin_amdgcn_s_barrier(); asm volatile("" ::: "memory");
#pragma unroll
        for (int ai = 0; ai < 2; ++ai)
#pragma unroll
            for (int m = 0; m < 4; ++m) { const int r = ai * HALF + wr * 64 + m * 16 + fr; const float rs = S[r];
#pragma unroll
                for (int bj = 0; bj < 2; ++bj)
#pragma unroll
                    for (int n = 0; n < 2; ++n) { const f32x4 y = acc[ai][bj][m][n] * rs * ngv[bj][n] + shv[bj][n]; const int c = col0 + bj * HALF + n * 16;
                        if (hn) { u32x2 w; w.x = pk2(y[0], y[1]); w.y = pk2(y[2], y[3]); *(u32x2*)(hn + (size_t)(u.pm * BM + r) * DM + c) = w; }
                        else *(f32x4*)(out + (size_t)r * DM + c) = y; } }
        asm volatile("s_waitcnt lgkmcnt(0)" ::: "memory"); __builtin_amdgcn_s_barrier(); asm volatile("" ::: "memory");
    }
};
struct SliceOrder {
    int ns, nu, G, c;
    __device__ void init(int ns_, int G_, int c_) { ns = ns_; nu = 16 * ns_; G = G_; c = G_ - 1 - c_; }
    __device__ bool next(int i, Unit& u) const {
        const int L = i * G + c; if (L >= nu) return false;
        const int t = L / ns, sl = L % ns; u.pm = t >> 2; u.pn = t & 3; u.k0 = sl * 256; return true;
    }
};
struct EpiPartial {
    static constexpr bool PERM = false, AFTER_DRAIN = false;
    float* p0; float* p1; int split;
    __device__ __forceinline__ void operator()(const f32x4 (&acc)[2][2][4][2], const Unit& u, int wr, int wc, int fr, int fq) const {
        const int sl = u.k0 >> 8;
        float* out = ((sl < split) ? p0 + (size_t)sl * MC * DM : p1 + (size_t)(sl - split) * MC * DM) + (size_t)u.pm * BM * DM;
        const int row0 = wr * 64 + fr, col0 = u.pn * BM + wc * 32 + 4 * fq;
#pragma unroll
        for (int ai = 0; ai < 2; ++ai)
#pragma unroll
            for (int m = 0; m < 4; ++m) { const size_t off = (size_t)(row0 + ai * HALF + m * 16) * DM + col0;
#pragma unroll
                for (int bj = 0; bj < 2; ++bj)
#pragma unroll
                    for (int n = 0; n < 2; ++n) *(f32x4*)(out + off + bj * HALF + n * 16) = acc[ai][bj][m][n]; }
    }
};

template <int LD, int KLEN, bool ALIGN_EPI, class Epi, class Sched>
__device__ __forceinline__ void gemm_phase(LAS unsigned char* lds, const Gemm g, const Sched& S, const Epi& E) {
    const int tid = fresh_tid(), wid = __builtin_amdgcn_readfirstlane(tid >> 6), lane = tid & 63, wr = wid >> 2, wc = wid & 3, fr = lane & 15, fq = lane >> 4;
    constexpr int nt = KLEN / BK;
    unsigned voffA[2], voffB[2];
#pragma unroll
    for (int i = 0; i < 2; ++i) { int R, C; stage_rc(tid * 16 + i * 8192, R, C); const int Rb = Epi::PERM ? ((R & ~31) + perm32(R & 31)) : R;
        voffA[i] = (unsigned)(R * LD + C) * 2u; voffB[i] = (unsigned)(Rb * LD + C) * 2u; }
    const size_t kstep = (size_t)(BK * 2);
    constexpr size_t hstepA = (size_t)HALF * LD * 2, hstepB = hstepA;
    constexpr size_t tstepA = 2 * hstepA, tstepB = tstepA;
    const unsigned ldsw = (unsigned)wid * 1024u;
    const int aoff = lds_byte(wr * 64 + fr, fq * 8), boff = lds_byte(wc * 32 + fr, fq * 8);
#define PG8_SA(b, h) (((b) * 2 + (h)) * HTB)
#define PG8_SB(b, h) ((4 + (b) * 2 + (h)) * HTB)
#define PG8_STAGE(bufoff, gbase, voff) do { _Pragma("unroll") for (int _i = 0; _i < 2; ++_i) \
        __builtin_amdgcn_global_load_lds((const unsigned*)((const char*)(gbase) + (voff)[_i]), (LAS unsigned*)(lds + (bufoff) + ldsw + _i * 8192), 16, 0, 0); } while (0)
#define PG8_LDA(dst, b, h) do { _Pragma("unroll") for (int m = 0; m < 4; ++m) _Pragma("unroll") for (int k = 0; k < 2; ++k) dst[m][k] = *(const LAS bf16x8*)(lds + PG8_SA(b, h) + aoff + m * 2048 + k * 1024); } while (0)
#define PG8_LDB(dst, b, h) do { _Pragma("unroll") for (int n = 0; n < 2; ++n) _Pragma("unroll") for (int k = 0; k < 2; ++k) dst[n][k] = *(const LAS bf16x8*)(lds + PG8_SB(b, h) + boff + n * 2048 + k * 1024); } while (0)
#define PG8_MMA(ai, bj, At, Bt) do { __builtin_amdgcn_s_setprio(1); _Pragma("unroll") for (int m = 0; m < 4; ++m) _Pragma("unroll") for (int n = 0; n < 2; ++n) _Pragma("unroll") for (int k = 0; k < 2; ++k) \
        acc[ai][bj][m][n] = __builtin_amdgcn_mfma_f32_16x16x32_bf16(Bt[n][k], At[m][k], acc[ai][bj][m][n], 0, 0, 0); __builtin_amdgcn_s_setprio(0); } while (0)
#define PG8_WAIT_V(n) asm volatile("s_waitcnt vmcnt(" #n ")" ::: "memory")
#define PG8_WAIT_L(n) asm volatile("s_waitcnt lgkmcnt(" #n ")" ::: "memory")
#define PG8_BAR __builtin_amdgcn_s_barrier()
#define PG8_SCHED __builtin_amdgcn_sched_barrier(0)
    Unit cur, nxt; int ui = 0;
    if (!S.next(0, cur)) return;
    f32x4 acc[2][2][4][2];
#pragma unroll
    for (int a = 0; a < 2; ++a)
#pragma unroll
        for (int b = 0; b < 2; ++b)
#pragma unroll
            for (int m = 0; m < 4; ++m)
#pragma unroll
                for (int n = 0; n < 2; ++n) acc[a][b][m][n] = (f32x4){0.f, 0.f, 0.f, 0.f};
    bf16x8 At[4][2], B0[2][2], B1[2][2];
    const char* cA = (const char*)g.A + (size_t)cur.pm * tstepA + (size_t)cur.k0 * 2; const char* cB = (const char*)g.Bt + (size_t)cur.pn * tstepB + (size_t)cur.k0 * 2;
    PG8_STAGE(PG8_SB(0, 0), cB, voffB); PG8_STAGE(PG8_SB(0, 1), cB + hstepB, voffB); PG8_STAGE(PG8_SA(0, 0), cA, voffA); PG8_STAGE(PG8_SA(0, 1), cA + hstepA, voffA);
    if (wr == 1) PG8_BAR;
    PG8_WAIT_V(2); PG8_BAR;
    PG8_STAGE(PG8_SB(1, 0), cB + kstep, voffB); PG8_STAGE(PG8_SA(1, 0), cA + kstep, voffA); PG8_STAGE(PG8_SB(1, 1), cB + hstepB + kstep, voffB);
    PG8_WAIT_V(6); PG8_BAR;
    for (;;) {
        const bool has_next = S.next(ui + 1, nxt);
        const char* nA = has_next ? (const char*)g.A + (size_t)nxt.pm * tstepA + (size_t)nxt.k0 * 2 : cA; const char* nB = has_next ? (const char*)g.Bt + (size_t)nxt.pn * tstepB + (size_t)nxt.k0 * 2 : cB;
#pragma unroll 1
        for (int t = 0; t < nt; t += 2) {
            const bool last = (t == nt - 2);
            const char* a1 = cA + (size_t)(t + 1) * kstep;
            const char* a2 = last ? nA : cA + (size_t)(t + 2) * kstep; const char* b2 = last ? nB : cB + (size_t)(t + 2) * kstep;
            const char* a3 = a2 + kstep; const char* b3 = b2 + kstep;
            PG8_LDB(B0, 0, 0); PG8_LDB(B1, 0, 1); PG8_SCHED; PG8_LDA(At, 0, 0); PG8_STAGE(PG8_SA(1, 1), a1 + hstepA, voffA);
            PG8_WAIT_V(8); PG8_WAIT_L(0); PG8_BAR; PG8_MMA(0, 0, At, B0); PG8_MMA(0, 1, At, B1); PG8_BAR; PG8_SCHED;
            PG8_LDA(At, 0, 1); PG8_STAGE(PG8_SB(0, 0), b2, voffB); PG8_STAGE(PG8_SB(0, 1), b2 + hstepB, voffB); PG8_STAGE(PG8_SA(0, 0), a2, voffA);
            PG8_WAIT_V(8); PG8_WAIT_L(0); PG8_BAR; PG8_MMA(1, 0, At, B0); PG8_MMA(1, 1, At, B1); PG8_BAR; PG8_SCHED;
            PG8_LDB(B0, 1, 0); PG8_LDB(B1, 1, 1); PG8_SCHED; PG8_LDA(At, 1, 0); PG8_STAGE(PG8_SA(0, 1), a2 + hstepA, voffA);
            PG8_WAIT_V(8); PG8_WAIT_L(0); PG8_BAR; PG8_MMA(0, 0, At, B0); PG8_MMA(0, 1, At, B1); PG8_BAR; PG8_SCHED;
            PG8_LDA(At, 1, 1); PG8_STAGE(PG8_SB(1, 0), b3, voffB); PG8_STAGE(PG8_SB(1, 1), b3 + hstepB, voffB); PG8_STAGE(PG8_SA(1, 0), a3, voffA);
            PG8_WAIT_V(8); PG8_WAIT_L(0); PG8_BAR; PG8_MMA(1, 0, At, B0); PG8_MMA(1, 1, At, B1); PG8_BAR; PG8_SCHED;
        }
        if constexpr (ALIGN_EPI) { if (wr == 0) PG8_BAR; }
        if constexpr (!Epi::AFTER_DRAIN) E(acc, cur, wr, wc, fr, fq);
        if (!has_next) break;
#pragma unroll
        for (int a = 0; a < 2; ++a)
#pragma unroll
            for (int b = 0; b < 2; ++b)
#pragma unroll
                for (int m = 0; m < 4; ++m)
#pragma unroll
                    for (int n = 0; n < 2; ++n) acc[a][b][m][n] = (f32x4){0.f, 0.f, 0.f, 0.f};
        cur = nxt; cA = nA; cB = nB; ++ui;
        if constexpr (ALIGN_EPI) { if (wr == 1) PG8_BAR; }
    }
    PG8_WAIT_V(0);
    if constexpr (!ALIGN_EPI) { if (wr == 0) PG8_BAR; }
    PG8_BAR;
    if constexpr (Epi::AFTER_DRAIN) E.fused(acc, cur, wr, wc, fr, fq, lds, wid, lane);
#undef PG8_SA
#undef PG8_SB
#undef PG8_STAGE
#undef PG8_LDA
#undef PG8_LDB
#undef PG8_MMA
#undef PG8_WAIT_V
#undef PG8_WAIT_L
#undef PG8_BAR
#undef PG8_SCHED
}
}

struct Args {
    const float* in[25];
    float* out;
    unsigned char* ws;
};

struct Ctx {
    LAS unsigned char* lds;
    int G, bid;
};


__device__ __forceinline__ void transpose_item(const float* W, int K, int N, int k0, int nsrc0, bf16_t* WT, int ndst0, LAS float* scr, int lane) {
#pragma unroll
    for (int i = 0; i < 32; ++i) { const int kk = 2 * i + (lane >> 5); scr[kk * 33 + (lane & 31)] = W[(size_t)(k0 + kk) * N + nsrc0 + (lane & 31)]; }
    LDS_WAIT();
    const int c = lane & 7;
#pragma unroll
    for (int j = 0; j < 4; ++j) { const int n = (lane >> 3) + 8 * j; const LAS float* s = scr + (8 * c) * 33 + n;
        u32x4 o; o.x = pk2(s[0 * 33], s[1 * 33]); o.y = pk2(s[2 * 33], s[3 * 33]); o.z = pk2(s[4 * 33], s[5 * 33]); o.w = pk2(s[6 * 33], s[7 * 33]);
        *(u32x4*)(WT + (size_t)(ndst0 + n) * K + k0 + 8 * c) = o; }
    LDS_WAIT();
}

__device__ __forceinline__ void phase_p0(const Ctx& C, const Args& a) {
    PHASE_IDS();
    {
        LAS float* sc = (LAS float*)(C.lds);
        LAS float* red = (LAS float*)(C.lds + 20480);
        float* MOD = (float*)(a.ws + WS_MOD);
        for (int idx = tid; idx < 5 * 1024; idx += NTHR) { const int bi = idx >> 10, k = idx & 1023; const float v = bi < 4 ? a.in[1][bi * 1024 + k] : a.in[3][k]; sc[idx] = siluf_(v); }
        __syncthreads();
        for (int u = C.bid; u < 192; u += C.G) {
            const int l = u / 96, cb = u % 96, col = cb * 64 + lane;
            const float* W = a.in[4] + ((size_t)l * 1024 + wid * 128) * 6144 + col;
            float acc[5] = {0.f, 0.f, 0.f, 0.f, 0.f};
#pragma unroll 32
            for (int kk = 0; kk < 128; ++kk) { const float w = W[(size_t)kk * 6144]; const int k = wid * 128 + kk;
#pragma unroll
                for (int bi = 0; bi < 5; ++bi) acc[bi] += sc[bi * 1024 + k] * w; }
#pragma unroll
            for (int bi = 0; bi < 5; ++bi) red[(wid * 5 + bi) * 64 + lane] = acc[bi];
            __syncthreads();
            if (tid < 320) { const int bi = tid >> 6, ln = tid & 63; float s = a.in[5][l * 6144 + cb * 64 + ln];
#pragma unroll
                for (int w = 0; w < 8; ++w) s += red[(w * 5 + bi) * 64 + ln];
                MOD[((size_t)l * 5 + bi) * 6144 + cb * 64 + ln] = s; }
            __syncthreads();
        }
    }
    {
        LAS float* scr = (LAS float*)(C.lds + wid * 8448);
        const int gw = C.bid * 8 + wid, NGW = C.G * 8;
        constexpr int I_IN = 16 * 112, I_OUT = 16 * 32, I_13 = 16 * 176, I_2 = 44 * 32, I_PW = 4 * 8, I_L = I_IN + I_OUT + I_13 + I_2 + I_PW;
        for (int it = gw; it < 2 * I_L; it += NGW) {
            const int l = it / I_L; int r = it % I_L;
            unsigned char* wt = a.ws + WS_WT + (size_t)l * WT_LAYER;
            if (r < I_IN) { const int kb = r / 112, nb = r % 112; transpose_item(a.in[7] + (size_t)l * DM * INC, DM, INC, kb * 64, nb * 32, (bf16_t*)(wt + WT_IN), nb * 32, scr, lane); continue; } r -= I_IN;
            if (r < I_OUT) { const int kb = r / 32, nb = r % 32; transpose_item(a.in[20] + (size_t)l * DM * DM, DM, DM, kb * 64, nb * 32, (bf16_t*)(wt + WT_OUT), nb * 32, scr, lane); continue; } r -= I_OUT;
            if (r < I_13) { const int kb = r / 176, nb = r % 176; const int nd = nb * 32, pn = nd >> 8, bj = (nd >> 7) & 1, j = nd & 127;
                transpose_item(a.in[22] + (size_t)l * DM * 2 * DFF, DM, 2 * DFF, kb * 64, bj * DFF + pn * 128 + j, (bf16_t*)(wt + WT_13), nd, scr, lane); continue; } r -= I_13;
            if (r < I_2) { const int kb = r / 32, nb = r % 32; transpose_item(a.in[23] + (size_t)l * DFF * DM, DFF, DM, kb * 64, nb * 32, (bf16_t*)(wt + WT_2), nb * 32, scr, lane); continue; } r -= I_2;
            { const int kb = r / 8, nb = r % 8; transpose_item(a.in[18] + (size_t)l * 256 * 256, 256, 256, kb * 64, nb * 32, (bf16_t*)(wt + WT_PW), nb * 32, scr, lane); }
        }
    }
}

__device__ __forceinline__ void norm_row_load(const float* srcc, const float* srcl, const float* mod_l, int shift_idx, int scale_idx, int r, int lane, f32x4 (&v)[4], f32x4 (&shv)[4], f32x4 (&scv)[4]) {
    const float* xr = (r < MC) ? srcc + (size_t)r * DM : srcl + (size_t)(r - MC) * DM;
    const int bi = (r < MC) ? 4 : ((r - MC) >> 12);
    const float* sh = mod_l + (size_t)bi * 6144 + shift_idx * 1024; const float* sc = mod_l + (size_t)bi * 6144 + scale_idx * 1024;
#pragma unroll
    for (int j = 0; j < 4; ++j) { v[j] = *(const f32x4*)(xr + 4 * lane + 256 * j); shv[j] = *(const f32x4*)(sh + 4 * lane + 256 * j); scv[j] = *(const f32x4*)(sc + 4 * lane + 256 * j); }
}
__device__ __forceinline__ void norm_row_store(bf16_t* dst, int r, int lane, const f32x4 (&v)[4], const f32x4 (&shv)[4], const f32x4 (&scv)[4], const f32x4 (&gv)[4], float rs) {
#pragma unroll
    for (int j = 0; j < 4; ++j) { const f32x4 y = v[j] * rs * gv[j] * (scv[j] + 1.0f) + shv[j];
        u32x2 w; w.x = pk2(y[0], y[1]); w.y = pk2(y[2], y[3]);
        *(u32x2*)(dst + (size_t)r * DM + 4 * lane + 256 * j) = w; }
}
__device__ __forceinline__ float sumsq4(const f32x4 (&v)[4]) { float s = 0.f;
#pragma unroll
    for (int j = 0; j < 4; ++j) s += (v[j][0] * v[j][0] + v[j][1] * v[j][1]) + (v[j][2] * v[j][2] + v[j][3] * v[j][3]);
    return s; }
struct CtxFix { const float* p0; const float* p1; int split, ns; const float* gate; float* xc_out; };
__device__ __forceinline__ void phase_norm(const Ctx& C, const float* srcc, const float* srcl, const float* g, const float* mod_l  , int shift_idx, int scale_idx, bf16_t* dst, int r_lo, int r_hi, const CtxFix fx) {
    PHASE_IDS();
    const int gw = C.bid * 8 + wid, NGW = C.G * 8;
    f32x4 gv[4];
#pragma unroll
    for (int j = 0; j < 4; ++j) gv[j] = *(const f32x4*)(g + 4 * lane + 256 * j);
    for (int r = r_lo + gw; r < r_hi; r += 2 * NGW) {
        const int r2 = r + NGW; const bool two = r2 < r_hi;
        f32x4 v0[4], sh0[4], sc0[4], v1[4], sh1[4], sc1[4];
        norm_row_load(srcc, srcl, mod_l, shift_idx, scale_idx, r, lane, v0, sh0, sc0);
        if (two) norm_row_load(srcc, srcl, mod_l, shift_idx, scale_idx, r2, lane, v1, sh1, sc1);
        if (r < MC && fx.ns > 0) {
            f32x4 ps[4];
#pragma unroll
            for (int j = 0; j < 4; ++j) ps[j] = (f32x4){0.f, 0.f, 0.f, 0.f};
            for (int s0 = 0; s0 < fx.ns; s0 += 4) {
                f32x4 pl[4][4];
#pragma unroll
                for (int q = 0; q < 4; ++q) { const int sl = (s0 + q < fx.ns) ? s0 + q : s0;
                    const float* pr = ((sl < fx.split) ? fx.p0 + (size_t)sl * MC * DM : fx.p1 + (size_t)(sl - fx.split) * MC * DM) + (size_t)r * DM;
#pragma unroll
                    for (int j = 0; j < 4; ++j) pl[q][j] = *(const f32x4*)(pr + 4 * lane + 256 * j); }
#pragma unroll
                for (int q = 0; q < 4; ++q) if (s0 + q < fx.ns) {
#pragma unroll
                    for (int j = 0; j < 4; ++j) ps[j] += pl[q][j]; }
            }
#pragma unroll
            for (int j = 0; j < 4; ++j) { v0[j] += *(const f32x4*)(fx.gate + 4 * lane + 256 * j) * ps[j];
                if (fx.xc_out) *(f32x4*)(fx.xc_out + (size_t)r * DM + 4 * lane + 256 * j) = v0[j]; }
        }
        float s0 = sumsq4(v0), s1 = two ? sumsq4(v1) : 0.f;
#pragma unroll
        for (int o = 1; o < 64; o <<= 1) { s0 += __shfl_xor(s0, o); s1 += __shfl_xor(s1, o); }
        norm_row_store(dst, r, lane, v0, sh0, sc0, gv, rsqrtf(s0 * (1.0f / DM) + EPS));
        if (two) norm_row_store(dst, r2, lane, v1, sh1, sc1, gv, rsqrtf(s1 * (1.0f / DM) + EPS));
    }
}
__device__ __forceinline__ void phase_final(const Ctx& C, float* out, const float* g) {
    PHASE_IDS();
    const int gw = C.bid * 8 + wid, NGW = C.G * 8;
    f32x4 gv[4];
#pragma unroll
    for (int j = 0; j < 4; ++j) gv[j] = *(const f32x4*)(g + 4 * lane + 256 * j);
    for (int r = gw; r < ML; r += 2 * NGW) {
        float* x0 = out + (size_t)r * DM; float* x1 = out + (size_t)(r + NGW) * DM;
        f32x4 v0[4], v1[4];
#pragma unroll
        for (int j = 0; j < 4; ++j) { v0[j] = *(const f32x4*)(x0 + 4 * lane + 256 * j); v1[j] = *(const f32x4*)(x1 + 4 * lane + 256 * j); }
        float s0 = sumsq4(v0), s1 = sumsq4(v1);
#pragma unroll
        for (int o = 1; o < 64; o <<= 1) { s0 += __shfl_xor(s0, o); s1 += __shfl_xor(s1, o); }
        const float r0s = rsqrtf(s0 * (1.0f / DM) + EPS), r1s = rsqrtf(s1 * (1.0f / DM) + EPS);
#pragma unroll
        for (int j = 0; j < 4; ++j) { *(f32x4*)(x0 + 4 * lane + 256 * j) = v0[j] * r0s * gv[j]; *(f32x4*)(x1 + 4 * lane + 256 * j) = v1[j] * r1s * gv[j]; }
    }
}

constexpr int SC_QT = 0, SC_QS = 17408, SC_KT = 34816, SC_KDT = 52224, SC_VT = 70656, SC_ST = 89088, SC_P = 123904, SC_SEG = 133120, SC_DK = 135168;
template <int PASS, bool L0>
__device__ __forceinline__ void scan_unit(const Ctx& C, int tid, bf16_t* px, float* US, float* DEC, const float* lbl, int layer, int seq, int sc) {
    const int dir = seq & 1, h = (seq >> 1) & 3, b = seq >> 3;
    const int lane = tid & 63, wid = __builtin_amdgcn_readfirstlane(tid >> 6), fr = lane & 15, fq = lane >> 4;
    LAS bf16_t* QT = (LAS bf16_t*)(C.lds + SC_QT);
    LAS bf16_t* QS = (LAS bf16_t*)(C.lds + SC_QS);
    LAS bf16_t* KT = (LAS bf16_t*)(C.lds + SC_KT);
    LAS bf16_t* KDT = (LAS bf16_t*)(C.lds + SC_KDT);
    LAS bf16_t* VT = (LAS bf16_t*)(C.lds + SC_VT);
    LAS bf16_t* ST = (LAS bf16_t*)(C.lds + SC_ST);
    LAS bf16_t* P = (LAS bf16_t*)(C.lds + SC_P);
    LAS float* SEG = (LAS float*)(C.lds + SC_SEG);
    LAS float* DK = (LAS float*)(C.lds + SC_DK);
    const int k = tid & 127, sg = tid >> 7;
    float lb = 0.f;
    if (!L0) { const float l0 = lbl[(0 * 2 + dir) * 512 + h * 128 + k], l1 = lbl[(1 * 2 + dir) * 512 + h * 128 + k]; lb = sigmoidf_(l1 - l0); }
    const float omlb = 1.0f - lb;
    const int zcol = (dir ? 1024 : 512) + h * 128;
    const unsigned zo = (unsigned)(zcol - h * 128);

    unsigned pz[16], pq[16], pv[16];
    {
        const int p00 = sc * 256;
        const int rb0 = (p00 < 256) ? (b * 256 + (dir ? 255 - p00 : p00)) : (MC + b * 4096 + (dir ? 4095 - (p00 - 256) : (p00 - 256)));
        const int rs0 = dir ? -1 : 1;
#pragma unroll
        for (int i = 0; i < 16; ++i) { const unsigned idx = (unsigned)((rb0 + rs0 * (sg * 16 + i)) * INC + h * 128 + k);
            pz[i] = px[idx + zo]; pq[i] = px[idx]; pv[i] = px[idx + 1536]; }
    }
    f32x4 accS[8];
    if (PASS == 1 || sc == 0) {
#pragma unroll
        for (int vb = 0; vb < 8; ++vb) accS[vb] = (f32x4){0.f, 0.f, 0.f, 0.f};
    } else {
        const float* S0 = US + ((size_t)(seq * 16 + sc - 1) * 128) * 128;
#pragma unroll
        for (int vb = 0; vb < 8; ++vb)
#pragma unroll
            for (int j = 0; j < 4; ++j) accS[vb][j] = S0[(size_t)(wid * 16 + 4 * fq + j) * 128 + vb * 16 + fr];
    }
    if (PASS == 3) {
#pragma unroll
        for (int vb = 0; vb < 8; ++vb) { u32x2 w; w.x = pk2(accS[vb][0], accS[vb][1]); w.y = pk2(accS[vb][2], accS[vb][3]);
            *(LAS u32x2*)(ST + (vb * 16 + fr) * 136 + wid * 16 + 4 * fq) = w; }
    }
    float dtot[4] = {1.f, 1.f, 1.f, 1.f};

    for (int c = 0; c < 4; ++c) {
        const int p0 = sc * 256 + c * 64;
        const int rbase = (p0 < 256) ? (b * 256 + (dir ? 255 - p0 : p0)) : (MC + b * 4096 + (dir ? 4095 - (p0 - 256) : (p0 - 256)));
        const int rstep = dir ? -1 : 1;
        float cq[16], ck[16], cb[16]; bf16_t vv[16];
        float run = 0.f;
#pragma unroll
        for (int i = 0; i < 16; ++i) {
            const float zl = __uint_as_float(pz[i] << 16) * LOG2E;
            if (PASS == 3) cq[i] = __uint_as_float(pq[i] << 16);
            vv[i] = (bf16_t)pv[i];
            if (L0) { float ls, ln; logsig2(zl, ls, ln); ck[i] = ln; run += ls; }
            else {
                const float e = __builtin_amdgcn_exp2f(-fabsf(zl)); const float inv = __builtin_amdgcn_rcpf(1.0f + e); const float big = inv, small = e * inv;
                const float sig = zl >= 0.f ? big : small, nsig = zl >= 0.f ? small : big;
                ck[i] = omlb * nsig;
                run += __builtin_amdgcn_logf(fmaxf(lb + omlb * sig, 1e-30f));
            }
            cb[i] = run;
        }
        SEG[sg * 128 + k] = run;
        LBAR();
        const float s0 = SEG[k], s1 = SEG[128 + k], s2 = SEG[256 + k], s3 = SEG[384 + k];
        const float off = (sg > 0 ? s0 : 0.f) + (sg > 1 ? s1 : 0.f) + (sg > 2 ? s2 : 0.f);
        const float blast = (s0 + s1) + (s2 + s3), rr = 0.5f * blast, er = __builtin_amdgcn_exp2f(rr);
        if (sg == 0) DK[k] = er * er;
        unsigned kdp[8], vvp[8];
#pragma unroll
        for (int i = 0; i < 16; i += 2) {
            float kd2[2];
#pragma unroll
            for (int e = 0; e < 2; ++e) {
                const int ii = i + e; const int tau = sg * 16 + ii;
                const float d = rr - (off + cb[ii]);
                const float kt = L0 ? __builtin_amdgcn_exp2f(ck[ii] + d) : ck[ii] * __builtin_amdgcn_exp2f(d);
                kd2[e] = kt * er;
                if (PASS == 3) { const float qt = cq[ii] * __builtin_amdgcn_exp2f(-d); QT[tau * 136 + k] = f2bf(qt); QS[tau * 136 + k] = f2bf(qt * er); KT[tau * 136 + k] = f2bf(kt); }
            }
            kdp[i >> 1] = pk2(kd2[0], kd2[1]);
            vvp[i >> 1] = (unsigned)vv[i] | ((unsigned)vv[i + 1] << 16);
        }
        *(LAS u32x4*)(KDT + k * 72 + sg * 16) = (u32x4){kdp[0], kdp[1], kdp[2], kdp[3]};
        *(LAS u32x4*)(KDT + k * 72 + sg * 16 + 8) = (u32x4){kdp[4], kdp[5], kdp[6], kdp[7]};
        *(LAS u32x4*)(VT + k * 72 + sg * 16) = (u32x4){vvp[0], vvp[1], vvp[2], vvp[3]};
        *(LAS u32x4*)(VT + k * 72 + sg * 16 + 8) = (u32x4){vvp[4], vvp[5], vvp[6], vvp[7]};
        LBAR();
        if (c < 3) {
            const int rb2 = rbase + rstep * 64;
#pragma unroll
            for (int i = 0; i < 16; ++i) { const unsigned idx = (unsigned)((rb2 + rstep * (sg * 16 + i)) * INC + h * 128 + k);
                pz[i] = px[idx + zo]; pq[i] = px[idx]; pv[i] = px[idx + 1536]; }
        }

        if (PASS == 3) {
            f32x4 oacc[4];
#pragma unroll
            for (int tb = 0; tb < 4; ++tb) oacc[tb] = (f32x4){0.f, 0.f, 0.f, 0.f};
#pragma unroll
            for (int kp = 0; kp < 2; ++kp) {
                bf16x8 av[2], bq[2][4];
#pragma unroll
                for (int k2 = 0; k2 < 2; ++k2) { const int ks = kp * 2 + k2; av[k2] = *(const LAS bf16x8*)(ST + (wid * 16 + fr) * 136 + ks * 32 + fq * 8);
#pragma unroll
                    for (int tb = 0; tb < 4; ++tb) bq[k2][tb] = *(const LAS bf16x8*)(QS + (tb * 16 + fr) * 136 + ks * 32 + fq * 8); }
                asm volatile("" ::: "memory");
#pragma unroll
                for (int k2 = 0; k2 < 2; ++k2)
#pragma unroll
                    for (int tb = 0; tb < 4; ++tb) oacc[tb] = mfma16(av[k2], bq[k2][tb], oacc[tb]);
            }
#pragma unroll
            for (int e = 0; e < 2; ++e) { const int id = 2 * wid + e, sb = id >> 2, tb = id & 3;
                f32x4 sacc = (f32x4){0.f, 0.f, 0.f, 0.f};
                if (sb <= tb) {
                    bf16x8 av[4], bq[4];
#pragma unroll
                    for (int ks = 0; ks < 4; ++ks) { av[ks] = *(const LAS bf16x8*)(KT + (sb * 16 + fr) * 136 + ks * 32 + fq * 8); bq[ks] = *(const LAS bf16x8*)(QT + (tb * 16 + fr) * 136 + ks * 32 + fq * 8); }
                    asm volatile("" ::: "memory");
#pragma unroll
                    for (int ks = 0; ks < 4; ++ks) sacc = mfma16(av[ks], bq[ks], sacc); }
                const int t = tb * 16 + fr, s = sb * 16 + 4 * fq;
                float m[4];
#pragma unroll
                for (int j = 0; j < 4; ++j) m[j] = (s + j <= t) ? sacc[j] : 0.f;
                u32x2 w; w.x = pk2(m[0], m[1]); w.y = pk2(m[2], m[3]);
                *(LAS u32x2*)(P + t * 72 + s) = w; }
            LBAR();
            {
                bf16x8 av[2], bq[2][4];
#pragma unroll
                for (int ks = 0; ks < 2; ++ks) { av[ks] = *(const LAS bf16x8*)(VT + (wid * 16 + fr) * 72 + ks * 32 + fq * 8);
#pragma unroll
                    for (int tb = 0; tb < 4; ++tb) bq[ks][tb] = *(const LAS bf16x8*)(P + (tb * 16 + fr) * 72 + ks * 32 + fq * 8); }
                asm volatile("" ::: "memory");
#pragma unroll
                for (int ks = 0; ks < 2; ++ks)
#pragma unroll
                    for (int tb = 0; tb < 4; ++tb) oacc[tb] = mfma16(av[ks], bq[ks][tb], oacc[tb]);
            }
#pragma unroll
            for (int tb = 0; tb < 4; ++tb) { const int r = rbase + rstep * (tb * 16 + fr);
                u32x2 w; w.x = pk2(oacc[tb][0], oacc[tb][1]); w.y = pk2(oacc[tb][2], oacc[tb][3]);
                *(u32x2*)(px + (size_t)r * INC + zcol + wid * 16 + 4 * fq) = w; }
        }
        {
            float dk[4];
#pragma unroll
            for (int j = 0; j < 4; ++j) { dk[j] = DK[wid * 16 + 4 * fq + j]; dtot[j] *= dk[j]; }
#pragma unroll
            for (int vb = 0; vb < 8; ++vb)
#pragma unroll
                for (int j = 0; j < 4; ++j) accS[vb][j] *= dk[j];
#pragma unroll
            for (int ks = 0; ks < 2; ++ks) {
                bf16x8 bq[8]; const bf16x8 av = *(const LAS bf16x8*)(KDT + (wid * 16 + fr) * 72 + ks * 32 + fq * 8);
#pragma unroll
                for (int vb = 0; vb < 8; ++vb) bq[vb] = *(const LAS bf16x8*)(VT + (vb * 16 + fr) * 72 + ks * 32 + fq * 8);
                asm volatile("" ::: "memory");
#pragma unroll
                for (int vb = 0; vb < 8; ++vb) accS[vb] = mfma16(av, bq[vb], accS[vb]);
            }
            if (PASS == 3 && c < 3) {
#pragma unroll
                for (int vb = 0; vb < 8; ++vb) { u32x2 w; w.x = pk2(accS[vb][0], accS[vb][1]); w.y = pk2(accS[vb][2], accS[vb][3]);
                    *(LAS u32x2*)(ST + (vb * 16 + fr) * 136 + wid * 16 + 4 * fq) = w; }
            }
        }
        LBAR();
    }
    if (PASS == 1) {
        float* S1 = US + ((size_t)(seq * 16 + sc) * 128) * 128;
#pragma unroll
        for (int vb = 0; vb < 8; ++vb)
#pragma unroll
            for (int j = 0; j < 4; ++j) S1[(size_t)(wid * 16 + 4 * fq + j) * 128 + vb * 16 + fr] = accS[vb][j];
        if (fr == 0) {
#pragma unroll
            for (int j = 0; j < 4; ++j) DEC[(size_t)(seq * 17 + sc) * 128 + wid * 16 + 4 * fq + j] = dtot[j];
        }
    }
}

template <bool L0>
__device__ __forceinline__ void scan_pass1_unit(const Ctx& C, int tid, const bf16_t* px, float* US, float* DEC, const float* lbl, int layer, int seq, int sc) {
    const int dir = seq & 1, h = (seq >> 1) & 3, b = seq >> 3;
    const int lane = tid & 63, wid = __builtin_amdgcn_readfirstlane(tid >> 6), fr = lane & 15, fq = lane >> 4;
    LAS bf16_t* KDT = (LAS bf16_t*)(C.lds);
    LAS bf16_t* VT = (LAS bf16_t*)(C.lds + 67584);
    LAS float* DKc = (LAS float*)(C.lds + 135168);
    const int k = tid & 127, c = tid >> 7;
    float lb = 0.f;
    if (!L0) { const float l0 = lbl[(0 * 2 + dir) * 512 + h * 128 + k], l1 = lbl[(1 * 2 + dir) * 512 + h * 128 + k]; lb = sigmoidf_(l1 - l0); }
    const float omlb = 1.0f - lb;
    const int zcol = (dir ? 1024 : 512) + h * 128;
    const unsigned zo = (unsigned)(zcol - h * 128);
    const int p0 = sc * 256 + c * 64;
    const int rbase = (p0 < 256) ? (b * 256 + (dir ? 255 - p0 : p0)) : (MC + b * 4096 + (dir ? 4095 - (p0 - 256) : (p0 - 256)));
    const int rstep = dir ? -1 : 1;
    float R = 0.f;
    unsigned rz[16], rv[16];
#pragma unroll
    for (int i = 0; i < 16; ++i) { const unsigned idx = (unsigned)((rbase + rstep * (48 + i)) * INC + h * 128 + k); rz[i] = px[idx + zo]; rv[i] = px[idx + 1536]; }
#pragma unroll
    for (int p = 3; p >= 0; --p) {
        unsigned nz[16], nv[16];
        if (p > 0) {
#pragma unroll
            for (int i = 0; i < 16; ++i) { const unsigned idx = (unsigned)((rbase + rstep * ((p - 1) * 16 + i)) * INC + h * 128 + k); nz[i] = px[idx + zo]; nv[i] = px[idx + 1536]; }
        }
#pragma unroll
        for (int gh = 1; gh >= 0; --gh) {
            const int g = 2 * p + gh;
            float kd[8];
#pragma unroll
            for (int i = 7; i >= 0; --i) {
                const float zl = __uint_as_float(rz[gh * 8 + i] << 16) * LOG2E;
                if (L0) { float ls, ln; logsig2(zl, ls, ln); kd[i] = __builtin_amdgcn_exp2f(R + ln); R += ls; }
                else {
                    const float e = __builtin_amdgcn_exp2f(-fabsf(zl)); const float inv = __builtin_amdgcn_rcpf(1.0f + e); const float big = inv, small = e * inv;
                    const float sig = zl >= 0.f ? big : small, nsig = zl >= 0.f ? small : big;
                    kd[i] = omlb * nsig * __builtin_amdgcn_exp2f(R);
                    R += __builtin_amdgcn_logf(fmaxf(lb + omlb * sig, 1e-30f));
                }
            }
            *(LAS u32x4*)(KDT + k * 264 + c * 64 + g * 8) = (u32x4){pk2(kd[0], kd[1]), pk2(kd[2], kd[3]), pk2(kd[4], kd[5]), pk2(kd[6], kd[7])};
            const unsigned* v8 = rv + gh * 8;
            *(LAS u32x4*)(VT + k * 264 + c * 64 + g * 8) = (u32x4){v8[0] | (v8[1] << 16), v8[2] | (v8[3] << 16), v8[4] | (v8[5] << 16), v8[6] | (v8[7] << 16)};
        }
        if (p > 0) {
#pragma unroll
            for (int i = 0; i < 16; ++i) { rz[i] = nz[i]; rv[i] = nv[i]; }
        }
    }
    DKc[c * 128 + k] = __builtin_amdgcn_exp2f(R);
    __syncthreads();
    f32x4 accS[8];
#pragma unroll
    for (int vb = 0; vb < 8; ++vb) accS[vb] = (f32x4){0.f, 0.f, 0.f, 0.f};
    float dtot[4] = {1.f, 1.f, 1.f, 1.f};
#pragma unroll
    for (int cc = 0; cc < 4; ++cc) {
        float dk[4];
#pragma unroll
        for (int j = 0; j < 4; ++j) { dk[j] = DKc[cc * 128 + wid * 16 + 4 * fq + j]; dtot[j] *= dk[j]; }
        if (cc > 0) {
#pragma unroll
            for (int vb = 0; vb < 8; ++vb)
#pragma unroll
                for (int j = 0; j < 4; ++j) accS[vb][j] *= dk[j];
        }
#pragma unroll
        for (int ks = 0; ks < 2; ++ks) {
            bf16x8 bq[8]; const bf16x8 av = *(const LAS bf16x8*)(KDT + (wid * 16 + fr) * 264 + cc * 64 + ks * 32 + fq * 8);
#pragma unroll
            for (int vb = 0; vb < 8; ++vb) bq[vb] = *(const LAS bf16x8*)(VT + (vb * 16 + fr) * 264 + cc * 64 + ks * 32 + fq * 8);
            asm volatile("" ::: "memory");
#pragma unroll
            for (int vb = 0; vb < 8; ++vb) accS[vb] = mfma16(av, bq[vb], accS[vb]);
        }
    }
    float* S1 = US + ((size_t)(seq * 16 + sc) * 128) * 128;
#pragma unroll
    for (int vb = 0; vb < 8; ++vb)
#pragma unroll
        for (int j = 0; j < 4; ++j) S1[(size_t)(wid * 16 + 4 * fq + j) * 128 + vb * 16 + fr] = accS[vb][j];
    if (fr == 0) {
#pragma unroll
        for (int j = 0; j < 4; ++j) DEC[(size_t)(seq * 17 + sc) * 128 + wid * 16 + 4 * fq + j] = dtot[j];
    }
    __syncthreads();
}

__device__ __forceinline__ void phase_s2(const Ctx& C, float* US, const float* DEC) {
    PHASE_IDS();
    for (int idx = C.bid * NTHR + tid; idx < 32 * 4096; idx += C.G * NTHR) {
        const int seq = idx >> 12, kk = (idx & 4095) >> 5, v4 = idx & 31;
        float* p = US + ((size_t)(seq * 16) * 128 + kk) * 128 + v4 * 4;
        const float* dp = DEC + (size_t)(seq * 17) * 128 + kk;
        f32x4 U[16]; float d[16];
#pragma unroll
        for (int sc = 0; sc < 16; ++sc) { U[sc] = *(const f32x4*)(p + (size_t)sc * 16384); d[sc] = dp[sc * 128]; }
        f32x4 S = (f32x4){0.f, 0.f, 0.f, 0.f};
#pragma unroll
        for (int sc = 0; sc < 16; ++sc) { S = S * d[sc] + U[sc]; *(f32x4*)(p + (size_t)sc * 16384) = S; }
    }
}

__device__ __forceinline__ void gmlp_unit(const Ctx& C, int tid, const bf16_t* px, bf16_t* ycat, const float* w_s  , const float* b_s  , const float* ln_g, const float* ln_b, int cidx, int g) {
    LAS bf16_t* Wl = (LAS bf16_t*)(C.lds);
    LAS bf16_t* VnT = (LAS bf16_t*)(C.lds + 34816);
    const int r0 = cidx * 128, lane = tid & 63, wid = __builtin_amdgcn_readfirstlane(tid >> 6), fr = lane & 15, fq = lane >> 4;
    const float* W = w_s + (size_t)g * 128 * 128;
#pragma unroll
    for (int i = 0; i < 8; ++i) { const int f4 = tid + NTHR * i, t = f4 >> 5, s4 = (f4 & 31) * 4; const f32x4 v = *(const f32x4*)(W + t * 128 + s4);
        u32x2 w; w.x = pk2(v[0], v[1]); w.y = pk2(v[2], v[3]); *(LAS u32x2*)(Wl + t * 136 + s4) = w; }
    {
        const int s = tid >> 2, part = tid & 3, d0 = part * 16;
        const bf16_t* src = px + (size_t)(r0 + s) * INC + 2816 + g * 64 + d0;
        const u32x4 w0 = *(const u32x4*)src, w1 = *(const u32x4*)(src + 8);
        float x[16];
        x[0] = bflo(w0.x); x[1] = bfhi(w0.x); x[2] = bflo(w0.y); x[3] = bfhi(w0.y); x[4] = bflo(w0.z); x[5] = bfhi(w0.z); x[6] = bflo(w0.w); x[7] = bfhi(w0.w);
        x[8] = bflo(w1.x); x[9] = bfhi(w1.x); x[10] = bflo(w1.y); x[11] = bfhi(w1.y); x[12] = bflo(w1.z); x[13] = bfhi(w1.z); x[14] = bflo(w1.w); x[15] = bfhi(w1.w);
        float sm = 0.f;
#pragma unroll
        for (int i = 0; i < 16; ++i) { x[i] = gelu_tanh(x[i]); sm += x[i]; }
        sm += __shfl_xor(sm, 1); sm += __shfl_xor(sm, 2);
        const float mu = sm * (1.0f / 64.0f); float q = 0.f;
#pragma unroll
        for (int i = 0; i < 16; ++i) { x[i] -= mu; q += x[i] * x[i]; }
        q += __shfl_xor(q, 1); q += __shfl_xor(q, 2);
        const float rs = rsqrtf(q * (1.0f / 64.0f) + EPS);
#pragma unroll
        for (int i = 0; i < 16; ++i) { const int d = d0 + i; const float y = x[i] * rs * ln_g[g * 64 + d] + ln_b[g * 64 + d]; VnT[d * 136 + s] = f2bf(y); }
    }
    __syncthreads();
    f32x4 acc[4];
#pragma unroll
    for (int db = 0; db < 4; ++db) acc[db] = (f32x4){0.f, 0.f, 0.f, 0.f};
#pragma unroll
    for (int ks = 0; ks < 4; ++ks) { const bf16x8 bw = *(const LAS bf16x8*)(Wl + (wid * 16 + fr) * 136 + ks * 32 + fq * 8);
#pragma unroll
        for (int db = 0; db < 4; ++db) { const bf16x8 av = *(const LAS bf16x8*)(VnT + (db * 16 + fr) * 136 + ks * 32 + fq * 8); acc[db] = mfma16(av, bw, acc[db]); } }
    {
        const int t = wid * 16 + fr, r = r0 + t; const float bias = b_s[g * 128 + t];
        u32x2 uw[4];
#pragma unroll
        for (int db = 0; db < 4; ++db) uw[db] = *(const u32x2*)(px + (size_t)r * INC + 2560 + g * 64 + db * 16 + 4 * fq);
#pragma unroll
        for (int db = 0; db < 4; ++db) { const int col = g * 64 + db * 16 + 4 * fq;
            const float u0 = gelu_tanh(bflo(uw[db].x)), u1 = gelu_tanh(bfhi(uw[db].x)), u2 = gelu_tanh(bflo(uw[db].y)), u3 = gelu_tanh(bfhi(uw[db].y));
            u32x2 w; w.x = pk2(u0 * (acc[db][0] + bias), u1 * (acc[db][1] + bias)); w.y = pk2(u2 * (acc[db][2] + bias), u3 * (acc[db][3] + bias));
            *(u32x2*)(ycat + (size_t)r * DM + 512 + col) = w; }
    }
    __syncthreads();
}

__device__ __forceinline__ void conv_unit(const Ctx& C, int tid, const bf16_t* px, bf16_t* ycat, const float* dw_w  , const float* dw_b, const float* ln_g, const float* ln_b, const bf16_t* pwt  , const float* pw_b, int tix) {
    LAS float* Z = (LAS float*)(C.lds);
    LAS bf16_t* Hn = (LAS bf16_t*)(C.lds + 96256);
    LAS float* Wd = (LAS float*)(C.lds + 130048);
    const int r0 = tix * 64, lane = tid & 63, wid = __builtin_amdgcn_readfirstlane(tid >> 6), fr = lane & 15, fq = lane >> 4;
    const int seg_lo = (r0 < MC) ? (r0 & ~255) : r0, seg_hi = seg_lo + ((r0 < MC) ? 256 : 64);
    {
        f32x4 wv[4]; u32x4 aw[6], gw[6]; bool zin[6];
#pragma unroll
        for (int q = 0; q < 4; ++q) { const int it = tid + q * NTHR; wv[q] = (it < 31 * 64) ? *(const f32x4*)(dw_w + it * 4) : (f32x4){0.f, 0.f, 0.f, 0.f}; }
#pragma unroll
        for (int q = 0; q < 6; ++q) { const int it = tid + q * NTHR, zr = it >> 5, c8 = (it & 31) * 8, r = r0 - 15 + zr;
            zin[q] = (it < 94 * 32) && r >= seg_lo && r < seg_hi;
            const size_t ro = (size_t)(zin[q] ? r : r0) * INC;
            aw[q] = *(const u32x4*)(px + ro + 3072 + c8); gw[q] = *(const u32x4*)(px + ro + 3328 + c8); }
#pragma unroll
        for (int q = 0; q < 4; ++q) { const int it = tid + q * NTHR; if (it < 31 * 64) *(LAS f32x4*)(Wd + it * 4) = wv[q]; }
#pragma unroll
        for (int q = 0; q < 6; ++q) { const int it = tid + q * NTHR, zr = it >> 5, c8 = (it & 31) * 8;
            if (it < 94 * 32) {
                f32x4 z0 = (f32x4){0.f, 0.f, 0.f, 0.f}, z1 = z0;
                if (zin[q]) {
                    z0[0] = bflo(aw[q].x) * sigmoidf_(bflo(gw[q].x)); z0[1] = bfhi(aw[q].x) * sigmoidf_(bfhi(gw[q].x)); z0[2] = bflo(aw[q].y) * sigmoidf_(bflo(gw[q].y)); z0[3] = bfhi(aw[q].y) * sigmoidf_(bfhi(gw[q].y));
                    z1[0] = bflo(aw[q].z) * sigmoidf_(bflo(gw[q].z)); z1[1] = bfhi(aw[q].z) * sigmoidf_(bfhi(gw[q].z)); z1[2] = bflo(aw[q].w) * sigmoidf_(bflo(gw[q].w)); z1[3] = bfhi(aw[q].w) * sigmoidf_(bfhi(gw[q].w));
                }
                *(LAS f32x4*)(Z + zr * 256 + c8) = z0; *(LAS f32x4*)(Z + zr * 256 + c8 + 4) = z1;
            }
        }
    }
    __syncthreads();
    {
        const int t0 = wid * 8, c4 = lane * 4;
        f32x4 acc[8], win[8];
#pragma unroll
        for (int t = 0; t < 8; ++t) acc[t] = (f32x4){0.f, 0.f, 0.f, 0.f};
#pragma unroll
        for (int t = 0; t < 7; ++t) win[t] = *(const LAS f32x4*)(Z + (t0 + t) * 256 + c4);
#pragma unroll 1
        for (int j0 = 0; j0 < 32; j0 += 8) {
#pragma unroll
            for (int jj = 0; jj < 8; ++jj) {
                const int j = j0 + jj;
                if (j < 31) {
                    win[(jj + 7) & 7] = *(const LAS f32x4*)(Z + (t0 + j + 7) * 256 + c4);
                    const f32x4 wj = *(const LAS f32x4*)(Wd + j * 256 + c4);
#pragma unroll
                    for (int t = 0; t < 8; ++t) acc[t] += win[(t + jj) & 7] * wj;
                }
            }
        }
        const f32x4 bv = *(const f32x4*)(dw_b + c4), gv = *(const f32x4*)(ln_g + c4), bb = *(const f32x4*)(ln_b + c4);
#pragma unroll
        for (int t = 0; t < 8; ++t) {
            f32x4 x = acc[t] + bv;
            float sm = (x[0] + x[1]) + (x[2] + x[3]);
            sm += __shfl_xor(sm, 1); sm += __shfl_xor(sm, 2); sm += __shfl_xor(sm, 4); sm += __shfl_xor(sm, 8);
            const float mu = sm * (1.0f / 64.0f);
            x = x - mu;
            float q = (x[0] * x[0] + x[1] * x[1]) + (x[2] * x[2] + x[3] * x[3]);
            q += __shfl_xor(q, 1); q += __shfl_xor(q, 2); q += __shfl_xor(q, 4); q += __shfl_xor(q, 8);
            const float rs = rsqrtf(q * (1.0f / 64.0f) + EPS);
            const f32x4 y = x * rs * gv + bb;
            u32x2 w; w.x = pk2(siluf_(y[0]), siluf_(y[1])); w.y = pk2(siluf_(y[2]), siluf_(y[3]));
            *(LAS u32x2*)(Hn + (t0 + t) * 264 + c4) = w;
        }
    }
    __syncthreads();
    {
        f32x4 acc[2][4];
#pragma unroll
        for (int e = 0; e < 2; ++e)
#pragma unroll
            for (int tb = 0; tb < 4; ++tb) acc[e][tb] = (f32x4){0.f, 0.f, 0.f, 0.f};
#pragma unroll
        for (int ks = 0; ks < 8; ++ks) {
            bf16x8 bh[4];
#pragma unroll
            for (int tb = 0; tb < 4; ++tb) bh[tb] = *(const LAS bf16x8*)(Hn + (tb * 16 + fr) * 264 + ks * 32 + fq * 8);
#pragma unroll
            for (int e = 0; e < 2; ++e) { const bf16x8 aw = *(const bf16x8*)(pwt + (size_t)((2 * wid + e) * 16 + fr) * 256 + ks * 32 + fq * 8);
#pragma unroll
                for (int tb = 0; tb < 4; ++tb) acc[e][tb] = mfma16(aw, bh[tb], acc[e][tb]); }
        }
#pragma unroll
        for (int e = 0; e < 2; ++e) { const int o = (2 * wid + e) * 16 + 4 * fq; const f32x4 pb = *(const f32x4*)(pw_b + o);
#pragma unroll
            for (int tb = 0; tb < 4; ++tb) { const int r = r0 + tb * 16 + fr; const f32x4 y = acc[e][tb] + pb;
                u32x2 w; w.x = pk2(y[0], y[1]); w.y = pk2(y[2], y[3]);
                *(u32x2*)(ycat + (size_t)r * DM + 768 + o) = w; } }
    }
    __syncthreads();
}

__device__ __forceinline__ void phase_xa(const Ctx& C, const bf16_t* px, bf16_t* ycat, const float* onorm_g, int r_lo) {
    PHASE_IDS();
    const int gw = C.bid * 8 + wid, NGW = C.G * 8;
    const int col = 8 * lane;
    const f32x4 gn0 = *(const f32x4*)(onorm_g + col), gn1 = *(const f32x4*)(onorm_g + col + 4);
    for (int r = r_lo + gw; r < MT; r += 4 * NGW) {
        u32x4 wf[4], wb[4], wg[4]; bool ok[4];
#pragma unroll
        for (int q = 0; q < 4; ++q) { const int rq = r + q * NGW; ok[q] = rq < MT; const bf16_t* pr = px + (size_t)(ok[q] ? rq : r) * INC;
            wf[q] = *(const u32x4*)(pr + 512 + col); wb[q] = *(const u32x4*)(pr + 1024 + col); wg[q] = *(const u32x4*)(pr + 2048 + col); }
#pragma unroll
        for (int q = 0; q < 4; ++q) {
            float o[8];
            o[0] = bflo(wf[q].x) + bflo(wb[q].x); o[1] = bfhi(wf[q].x) + bfhi(wb[q].x); o[2] = bflo(wf[q].y) + bflo(wb[q].y); o[3] = bfhi(wf[q].y) + bfhi(wb[q].y);
            o[4] = bflo(wf[q].z) + bflo(wb[q].z); o[5] = bfhi(wf[q].z) + bfhi(wb[q].z); o[6] = bflo(wf[q].w) + bflo(wb[q].w); o[7] = bfhi(wf[q].w) + bfhi(wb[q].w);
            float ss = 0.f;
#pragma unroll
            for (int i = 0; i < 8; ++i) ss += o[i] * o[i];
            ss += __shfl_xor(ss, 1); ss += __shfl_xor(ss, 2); ss += __shfl_xor(ss, 4); ss += __shfl_xor(ss, 8);
            const float rs = rsqrtf(ss * (1.0f / 128.0f) + EPS);
            const float g0 = siluf_(bflo(wg[q].x)), g1 = siluf_(bfhi(wg[q].x)), g2 = siluf_(bflo(wg[q].y)), g3 = siluf_(bfhi(wg[q].y));
            const float g4 = siluf_(bflo(wg[q].z)), g5 = siluf_(bfhi(wg[q].z)), g6 = siluf_(bflo(wg[q].w)), g7 = siluf_(bfhi(wg[q].w));
            u32x4 w;
            w.x = pk2(o[0] * rs * gn0[0] * g0, o[1] * rs * gn0[1] * g1); w.y = pk2(o[2] * rs * gn0[2] * g2, o[3] * rs * gn0[3] * g3);
            w.z = pk2(o[4] * rs * gn1[0] * g4, o[5] * rs * gn1[1] * g5); w.w = pk2(o[6] * rs * gn1[2] * g6, o[7] * rs * gn1[3] * g7);
            if (ok[q]) *(u32x4*)(ycat + (size_t)(r + q * NGW) * DM + col) = w;
        }
    }
}

#ifdef DBG_STOP
__device__ __forceinline__ void dbg_digest(const Ctx& C, const XcdBarrier& bar, float* out, const bf16_t* pb, size_t nb, const float* pf, size_t nf) {
    xcd_barrier(bar);
    const size_t NO = (size_t)ML * DM;
    for (size_t i = (size_t)C.bid * NTHR + threadIdx.x; i < NO; i += (size_t)C.G * NTHR) {
        float s = 0.f;
        for (size_t j = i; j < nb; j += NO) s += bf2f(pb[j]);
        for (size_t j = i; j < nf; j += NO) s += pf[j];
        if (!(fabsf(s) < 1e30f)) s = 7777.0f;
        out[i] = s;
    }
}
#define DBG_AT(n, pb, nb, pf, nf) if (DBG_STOP == (n) && l == DBG_L) { dbg_digest(C, bar, a.out, (pb), (nb), (pf), (nf)); return; }
#else
#define DBG_AT(n, pb, nb, pf, nf)
#define DBG_L 0
#endif
__global__ void __launch_bounds__(NTHR, 2) fwd_megakernel(Args a) {
    extern __shared__ __attribute__((aligned(16))) unsigned char lds_raw[];
    cg::grid_group grid = cg::this_grid();
    Ctx C;
    C.lds = (LAS unsigned char*)lds_raw;
    C.G = gridDim.x; C.bid = blockIdx.x;
    volatile LAS unsigned* barw = (volatile LAS unsigned*)(C.lds + LDS_BARW);
    if (threadIdx.x < 4) barw[threadIdx.x] = 0u;
    for (int i = C.bid * NTHR + threadIdx.x; i < (int)(CTL_BYTES / 16); i += C.G * NTHR) ((u32x4*)(a.ws + WS_CTL))[i] = (u32x4){0u, 0u, 0u, 0u};
    __syncthreads();

    float* MOD = (float*)(a.ws + WS_MOD);
    float* DEC = (float*)(a.ws + WS_DEC);
    float* XC = (float*)(a.ws + WS_XC);
    bf16_t* ABF = (bf16_t*)(a.ws + WS_ABF);
    bf16_t* PX = (bf16_t*)(a.ws + WS_PX);
    float* US = (float*)(a.ws + WS_US);
    float* PTAIL = (float*)(a.ws + WS_PX + (size_t)MT * DFF * 2);

#ifdef DBG_TIME
    unsigned long long t_last = __builtin_amdgcn_s_memrealtime(); unsigned long long t_cat[12] = {0,0,0,0,0,0,0,0,0,0,0,0};
#define TS(c) do { const unsigned long long _n = __builtin_amdgcn_s_memrealtime(); t_cat[c] += _n - t_last; t_last = _n; } while (0)
#else
#define TS(c)
#endif
    phase_p0(C, a);
    grid.sync();
    XcdBarrier bar = xcd_barrier_post((unsigned*)(a.ws + WS_CTL), barw);
    TS(0);

    const int dbgl = (a.in[0] == nullptr) ? 1 : 0; (void)dbgl;
    for (int l = 0; l < 2; ++l) {
        unsigned char* wt = a.ws + WS_WT + (size_t)l * WT_LAYER;
        const float* mod_l = MOD + (size_t)l * 5 * 6144;
        const float* srcc = (l == 0) ? a.in[2] : XC;
        const float* srcl = (l == 0) ? a.in[0] : a.out;
        DBG_AT(17, PX, 0, a.out, (size_t)ML * DM)
        { CtxFix fx{PTAIL, US, 6, (l == 0) ? 0 : 11, MOD + (size_t)4 * 6144 + 5 * 1024, nullptr};
          phase_norm(C, srcc, srcl, a.in[6] + l * DM, mod_l, 0, 1, ABF, 0, (l == 0) ? MT : MC, fx); }
        if (l == 0) { for (int i = C.bid * NTHR + threadIdx.x; i < MC * DM / 4; i += C.G * NTHR) ((f32x4*)XC)[i] = ((const f32x4*)a.in[2])[i]; }
        GRID_BAR();
        TS(1);

#if defined(DBG_STOP) && DBG_STOP == 14
        if (l == 1) {
            xcd_barrier(bar);
            const bf16_t* w1 = (const bf16_t*)(a.ws + WS_WT + WT_LAYER + WT_IN);
            for (size_t i = (size_t)C.bid * NTHR + threadIdx.x; i < (size_t)ML * DM; i += (size_t)C.G * NTHR) {
                float v = 0.f;
                #define BADF(x) (!(fabsf(x) < 1e30f))
                if (BADF(bf2f(ABF[i])) || (i + (size_t)ML * DM < (size_t)MT * DM && BADF(bf2f(ABF[i + (size_t)ML * DM])))) v = 500.f;
                if (i < (size_t)MC * DM && BADF(XC[i])) v = 1000.f;
                if (BADF(a.out[i])) v = 2000.f;
                if (i < 61440 && BADF(MOD[i])) v = 3000.f;
                if (i < (size_t)INC * DM && BADF(bf2f(w1[i]))) v = 4000.f;
                a.out[i] = v;
            }
            return;
        }
#endif
        DBG_AT(15, PX, 0, a.out, (size_t)ML * DM)
        DBG_AT(16, ABF, (size_t)MT * DM, XC, (size_t)MC * DM)
        { pg8::Gemm g{ABF, (const bf16_t*)(wt + WT_IN)}; pg8::StaticOrder S; S.init(MT / 256, INC / 256, C.G, C.bid, 0);
          pg8::EpiBf16 E{PX, INC}; pg8::gemm_phase<DM, DM, true>(C.lds, g, S, E); }
        GRID_BAR();
        TS(2);
        DBG_AT(1, PX, (size_t)MT * INC, MOD, (size_t)2 * 5 * 6144)
        { const int tid = fresh_tid(); for (int u = C.bid; u < 32 * 16; u += C.G) { if (l == 0) scan_pass1_unit<true>(C, tid, PX, US, DEC, a.in[8], l, u & 31, u >> 5); else scan_pass1_unit<false>(C, tid, PX, US, DEC, a.in[8], l, u & 31, u >> 5); } }
        GRID_BAR();
        TS(3);
        phase_s2(C, US, DEC);
        GRID_BAR();
        TS(4);
        DBG_AT(2, PX, 0, US, (size_t)32 * 16 * 128 * 128)
        {
            const int tid = fresh_tid();
            const int sc0 = (l == 0) ? 0 : 1, nS = 32 * (17 - sc0);
            const int cb0 = (l == 0) ? 0 : 8, nB = (136 - cb0) * 4, ct0 = (l == 0) ? 0 : 16, nC = 272 - ct0;
            int nscan = 0;
            for (int u = C.bid; u < nS; u += C.G) { if (l == 0) scan_unit<3, true>(C, tid, PX, US, DEC, a.in[8], l, u & 31, sc0 + (u >> 5)); else scan_unit<3, false>(C, tid, PX, US, DEC, a.in[8], l, u & 31, sc0 + (u >> 5)); ++nscan; }
            const int extra = nS % C.G;
            const int nsmall = nB + nC;
            int first, stride;
            if (extra > 0 && extra < C.G) { if (C.bid < extra) { first = nsmall; stride = 1; } else { first = C.bid - extra; stride = C.G - extra; } }
            else { first = C.bid; stride = C.G; }
            for (int v = first; v < nsmall; v += stride) {
                if (v < nC) conv_unit(C, tid, PX, ABF, a.in[14] + (size_t)l * 31 * 256, a.in[15] + l * 256, a.in[16] + l * 256, a.in[17] + l * 256, (const bf16_t*)(wt + WT_PW), a.in[19] + l * 256, ct0 + v);
                else { const int w = v - nC; gmlp_unit(C, tid, PX, ABF, a.in[12] + (size_t)l * 4 * 128 * 128, a.in[13] + l * 512, a.in[10] + l * 256, a.in[11] + l * 256, cb0 + (w >> 2), w & 3); }
            }
            (void)nscan;
        }
        GRID_BAR();
        TS(5);
        DBG_AT(3, PX, (size_t)MT * INC, US, 0)
        DBG_AT(4, ABF, (size_t)MT * DM, US, 0)
        phase_xa(C, PX, ABF, a.in[9] + l * 512, (l == 0) ? 0 : MC);
        GRID_BAR();
        TS(6);
        DBG_AT(5, ABF, (size_t)MT * DM, US, 0)
        { pg8::Gemm g{ABF, (const bf16_t*)(wt + WT_OUT)}; pg8::StaticOrder S; S.init(ML / 256, DM / 256, C.G, C.bid, 4);
          pg8::EpiResNorm E{srcl, a.out, mod_l + 2 * 1024, a.in[21] + l * DM, mod_l + 3 * 1024, mod_l + 4 * 1024, ABF,
                            (float*)(a.ws + WS_XB) + (size_t)(l * 2 + 0) * ML * 4, (unsigned*)(a.ws + WS_CNT) + (size_t)(l * 2 + 0) * 64 * 64};
          pg8::gemm_phase<DM, DM, false>(C.lds, g, S, E);
          if (l == 0) { pg8::SliceOrder SS; SS.init(4, C.G, C.bid);
              pg8::EpiPartial EA{US, US, 4}; pg8::gemm_phase<DM, 256, false>(C.lds, g, SS, EA); } }
        GRID_BAR();
        TS(7);
        DBG_AT(6, PX, 0, a.out, (size_t)ML * DM)
        DBG_AT(11, ABF, (size_t)MC * DM, XC, (size_t)MC * DM)
        if (l == 0) {
            { CtxFix fx{US, US, 4, 4, mod_l + (size_t)4 * 6144 + 2 * 1024, XC};
              phase_norm(C, XC, a.out, a.in[21] + l * DM, mod_l, 3, 4, ABF, 0, MC, fx); }
            GRID_BAR();
        }
        TS(1);
        DBG_AT(7, ABF, (size_t)MT * DM, US, 0)
        { const int pm0 = (l == 0) ? 0 : 4;
          pg8::Gemm g{ABF, (const bf16_t*)(wt + WT_13)}; pg8::StaticOrder S; S.init(MT / 256 - pm0, 2 * DFF / 256, C.G, C.bid, pm0);
          pg8::EpiSwiglu E{PX, DFF}; pg8::gemm_phase<DM, DM, true>(C.lds, g, S, E); }
        GRID_BAR();
        TS(8);
        DBG_AT(8, PX, (size_t)MT * DFF, US, 0)
        { pg8::Gemm g{PX, (const bf16_t*)(wt + WT_2)}; pg8::StaticOrder S; S.init(ML / 256, DM / 256, C.G, C.bid, 4);
          const float* mod_n = MOD + (size_t)1 * 5 * 6144;
          pg8::EpiResNorm E{a.out, a.out, mod_l + 5 * 1024, (l == 0) ? a.in[6] + DM : a.in[24], (l == 0) ? mod_n : nullptr, (l == 0) ? mod_n + 1024 : nullptr, (l == 0) ? ABF : nullptr,
                            (float*)(a.ws + WS_XB) + (size_t)(l * 2 + 1) * ML * 4, (unsigned*)(a.ws + WS_CNT) + (size_t)(l * 2 + 1) * 64 * 64};
          pg8::gemm_phase<DFF, DFF, false>(C.lds, g, S, E);
          if (l == 0) { pg8::SliceOrder SS; SS.init(11, C.G, C.bid);
              pg8::EpiPartial EA{PTAIL, US, 6}; pg8::gemm_phase<DFF, 256, false>(C.lds, g, SS, EA); } }
        if (l == 0) GRID_BAR();
        TS(9);
        DBG_AT(10, PX, 0, a.out, (size_t)ML * DM)
    }
    { const int l = DBG_L; DBG_AT(9, PX, 0, a.out, (size_t)ML * DM) }
#ifdef DBG_TIME
    TS(10);
    __syncthreads();
    if (C.bid == 0) {
        unsigned long long ta = 0, tb = 0;
#pragma unroll
        for (int c = 0; c < 12; ++c) { if ((DBG_SEL_A >> c) & 1) ta += t_cat[c]; if ((DBG_SEL_B >> c) & 1) tb += t_cat[c]; }
        const float fa = (float)ta * 0.01f, fb = (float)tb * 0.01f;
        for (int i = threadIdx.x; i <= 1000; i += NTHR) a.out[i] = (i == 0) ? fa * 0.25f : fb * 0.01f;
    }
#endif
}

extern "C" void kernel_launch(void* const* d_in, const int* in_sizes, int n_in, void* d_out, int out_size, void* d_ws, size_t ws_size, hipStream_t stream) {
    static int grid = 0;
    if (grid == 0) {
        int dev = 0, cus = 0, per_cu = 0;
        hipGetDevice(&dev);
        hipDeviceGetAttribute(&cus, hipDeviceAttributeMultiprocessorCount, dev);
        hipFuncSetAttribute((const void*)fwd_megakernel, hipFuncAttributeMaxDynamicSharedMemorySize, LDS_BYTES);
        hipOccupancyMaxActiveBlocksPerMultiprocessor(&per_cu, (const void*)fwd_megakernel, NTHR, LDS_BYTES);
        if (per_cu < 1) per_cu = 1;
        grid = cus;
        if (ws_size < WS_END) fprintf(stderr, "kernel_launch: workspace too small: %zu < %zu\n", ws_size, (size_t)WS_END);
        (void)hipGetLastError();
    }
    Args a{};
    for (int i = 0; i < 25; ++i) a.in[i] = (const float*)d_in[i];
    a.out = (float*)d_out; a.ws = (unsigned char*)d_ws;
    void* args[] = {&a};
    hipError_t e = hipLaunchCooperativeKernel((const void*)fwd_megakernel, dim3(grid), dim3(NTHR), args, LDS_BYTES, stream);
    if (e != hipSuccess) fprintf(stderr, "cooperative launch failed: %s (grid %d)\n", hipGetErrorString(e), grid);
}
```

```cpp
#include <hip/hip_runtime.h>
#include <hip/hip_cooperative_groups.h>
#include <cstdio>
namespace cg = cooperative_groups;
#define USE_XCD_BAR 1
#ifndef USE_XCD_BAR
#define GRID_BAR() grid.sync()
#else
#define GRID_BAR() xcd_barrier(bar)
#endif

#define LAS __attribute__((address_space(3)))
typedef unsigned short bf16_t;
typedef short bf16x8 __attribute__((ext_vector_type(8)));
typedef float f32x4 __attribute__((ext_vector_type(4)));
typedef float f32x2 __attribute__((ext_vector_type(2)));
typedef unsigned u32x4 __attribute__((ext_vector_type(4)));
typedef unsigned u32x2 __attribute__((ext_vector_type(2)));

constexpr int DM = 1024, NBATCH = 4, SEQ = 4096, CTXL = 256;
constexpr int MC = NBATCH * CTXL;
constexpr int ML = NBATCH * SEQ;
constexpr int MT = MC + ML;
constexpr int INC = 3584, DFF = 2816;
constexpr float EPS = 1e-6f;
constexpr int NTHR = 512;
constexpr int LDS_BYTES = 163840;
constexpr int LDS_BARW = LDS_BYTES - 64;

constexpr size_t WS_CTL = 0;
constexpr size_t CTL_BYTES = 131072;
constexpr size_t WS_CNT = 16384;
constexpr size_t WS_XB = 131072;
constexpr size_t WS_MOD = WS_XB + 1048576;
constexpr size_t WS_DEC = WS_MOD + 262144;
constexpr size_t WS_WT = WS_DEC + 524288;
constexpr size_t WT_IN = 0, WT_OUT = WT_IN + (size_t)INC * DM * 2, WT_13 = WT_OUT + (size_t)DM * DM * 2,
                 WT_2 = WT_13 + (size_t)2 * DFF * DM * 2, WT_PW = WT_2 + (size_t)DM * DFF * 2, WT_LAYER = WT_PW + (size_t)256 * 256 * 2;
constexpr size_t WS_XC = WS_WT + 2 * WT_LAYER;
constexpr size_t WS_ABF = WS_XC + (size_t)MC * DM * 4;
constexpr size_t WS_PX = WS_ABF + (size_t)MT * DM * 2;
constexpr size_t WS_US = WS_PX + (size_t)MT * INC * 2;
constexpr size_t WS_END = WS_US + (size_t)32 * 16 * 128 * 128 * 4;

__device__ __forceinline__ float bf2f(bf16_t v) { return __uint_as_float(((unsigned)v) << 16); }
__device__ __forceinline__ float bflo(unsigned w) { return __uint_as_float(w << 16); }
__device__ __forceinline__ float bfhi(unsigned w) { return __uint_as_float(w & 0xffff0000u); }
typedef __bf16 bf16x2_t __attribute__((ext_vector_type(2)));
__device__ __forceinline__ unsigned pk2(float lo, float hi) { const f32x2 v = {lo, hi}; const bf16x2_t b = __builtin_convertvector(v, bf16x2_t); return __builtin_bit_cast(unsigned, b); }
__device__ __forceinline__ bf16_t f2bf(float v) { return (bf16_t)(pk2(v, 0.f) & 0xffffu); }
__device__ __forceinline__ float sigmoidf_(float x) { return __builtin_amdgcn_rcpf(1.0f + __expf(-x)); }
__device__ __forceinline__ float siluf_(float x) { return x * sigmoidf_(x); }
__device__ __forceinline__ float gelu_tanh(float x) { const float y = 0.7978845608028654f * (x + 0.044715f * x * x * x); return x * sigmoidf_(2.0f * y); }
__device__ __forceinline__ void logsig2(float zl, float& ls, float& ln) {
    const float e = __builtin_amdgcn_exp2f(-fabsf(zl));
    const float L2 = __builtin_amdgcn_logf(1.0f + e);
    ls = fminf(zl, 0.f) - L2; ln = ls - zl;
}
constexpr float LOG2E = 1.4426950408889634f;
__device__ __forceinline__ float wave_sum(float v) {
#pragma unroll
    for (int o = 1; o < 64; o <<= 1) v += __shfl_xor(v, o);
    return v;
}
__device__ __forceinline__ f32x4 mfma16(bf16x8 a, bf16x8 b, f32x4 c) { return __builtin_amdgcn_mfma_f32_16x16x32_bf16(a, b, c, 0, 0, 0); }
#define LDS_WAIT() asm volatile("s_waitcnt lgkmcnt(0)" ::: "memory")
#define LBAR() do { asm volatile("s_waitcnt lgkmcnt(0)" ::: "memory"); __builtin_amdgcn_s_barrier(); asm volatile("" ::: "memory"); } while (0)
__device__ __forceinline__ int fresh_tid() { int t = threadIdx.x; asm volatile("" : "+v"(t)); return t; }
#define PHASE_IDS() const int tid = fresh_tid(), lane = tid & 63, wid = __builtin_amdgcn_readfirstlane(tid >> 6); (void)lane; (void)wid

#define XB_TMO      128
#define XB_XCNT(j)  (256  + 64 * (j))
#define XB_XSUB(j)  (1280 + 64 * (j))
#define XB_XGEN(j)  (2304 + 64 * (j))
#define XB_TOP      3328
#define XB_TOPGEN   3392
#define XCD_BAR_WORDS 3456
#define XB_SPIN_CAP (1u << 20)
__device__ __forceinline__ unsigned xb_ld(unsigned* p)              { return __hip_atomic_load(p, __ATOMIC_RELAXED, __HIP_MEMORY_SCOPE_AGENT); }
__device__ __forceinline__ unsigned xb_add(unsigned* p, unsigned v) { return __hip_atomic_fetch_add(p, v, __ATOMIC_RELAXED, __HIP_MEMORY_SCOPE_AGENT); }
__device__ __forceinline__ unsigned xb_xcc_id() { return (unsigned)__builtin_amdgcn_s_getreg((3 << 11) | 20) & 0xFu; }
#define XB_SPIN(cond, bar) do { unsigned _sp = 0; while (cond) { __builtin_amdgcn_s_sleep(1); \
    if ((++_sp & 255u) == 0u) { if (xb_ld(&(bar)[XB_TMO])) break; if (_sp > XB_SPIN_CAP) { atomicAdd(&(bar)[XB_TMO], 1u); break; } } } } while (0)
struct XcdBarrier { unsigned* bar; unsigned x; volatile LAS unsigned* st; };
__device__ __forceinline__ XcdBarrier xcd_barrier_post(unsigned* bar, volatile LAS unsigned* st) {
    XcdBarrier b; b.bar = bar; b.x = xb_xcc_id(); b.st = st;
    if (threadIdx.x == 0) (void)xb_add(&bar[XB_XCNT(b.x)], 1u);
    return b;
}
__device__ __forceinline__ void xcd_barrier_complete(unsigned* bar, unsigned x, unsigned& nloc, unsigned& nx) {
    const unsigned G = gridDim.x * gridDim.y * gridDim.z;
    unsigned sum, cnt, mine, sp = 0u;
    for (;;) {
        sum = 0u; cnt = 0u; mine = 0u;
#pragma unroll
        for (unsigned j = 0; j < 16; ++j) { const unsigned c = xb_ld(&bar[XB_XCNT(j)]); sum += c; cnt += (c > 0u) ? 1u : 0u; mine = (j == x) ? c : mine; }
        if (sum == G) break;
        __builtin_amdgcn_s_sleep(1);
        if ((++sp & 255u) == 0u) { if (xb_ld(&bar[XB_TMO])) break; if (sp > XB_SPIN_CAP) { atomicAdd(&bar[XB_TMO], 1u); break; } }
    }
    nloc = mine > 0u ? mine : 1u; nx = cnt > 0u ? cnt : 1u;
}
__device__ __forceinline__ void xcd_barrier(const XcdBarrier& b) {
    asm volatile("s_waitcnt vmcnt(0)" ::: "memory");
    __syncthreads();
    if (threadIdx.x == 0) {
        unsigned* bar = b.bar;
        __builtin_amdgcn_s_waitcnt(0);
        unsigned nloc = b.st[0], nx = b.st[1];
        if (nloc == 0u) { xcd_barrier_complete(bar, b.x, nloc, nx); b.st[0] = nloc; b.st[1] = nx; }
        const unsigned old = xb_add(&bar[XB_XSUB(b.x)], 1u);
        const unsigned gen = old / nloc;
        if (old + 1u == (gen + 1u) * nloc) {
            __builtin_amdgcn_fence(__ATOMIC_RELEASE, "agent");
            asm volatile("s_waitcnt vmcnt(0)" ::: "memory");
            const unsigned og = xb_add(&bar[XB_TOP], 1u);
            const unsigned tg = og / nx;
            if (og + 1u == (tg + 1u) * nx) xb_add(&bar[XB_TOPGEN], 1u);
            else XB_SPIN(xb_ld(&bar[XB_TOPGEN]) == tg, bar);
            __builtin_amdgcn_fence(__ATOMIC_ACQUIRE, "agent");
            xb_add(&bar[XB_XGEN(b.x)], 1u);
            asm volatile("s_waitcnt vmcnt(0)" ::: "memory");
        } else {
            XB_SPIN(xb_ld(&bar[XB_XGEN(b.x)]) == gen, bar);
            __builtin_amdgcn_fence(__ATOMIC_ACQUIRE, "agent");
            asm volatile("s_waitcnt vmcnt(0)" ::: "memory");
        }
    }
    __syncthreads();
}

namespace pg8 {
constexpr int BM = 256, BK = 64, HALF = 128, HTB = HALF * BK * 2, STAGE_BYTES = 8 * HTB, NXCD = 8, WGM = 4;
__device__ __forceinline__ int lds_byte(int r, int c) { const int st = (r >> 4) * 2 + (c >> 5), rr = r & 15, cc = c & 31, ob = rr * 64 + cc * 2; return st * 1024 + (ob ^ (((ob >> 9) & 1) << 5)); }
__device__ __forceinline__ void stage_rc(int b, int& R, int& C) { const int st = b / 1024, sb = b % 1024, swz = sb ^ (((sb >> 9) & 1) << 5); R = (st >> 1) * 16 + swz / 64; C = (st & 1) * 32 + (swz % 64) / 2; }
__device__ __forceinline__ int perm32(int rho) { const int n = rho >> 4, i = rho & 15; return 8 * (i >> 2) + 4 * n + (i & 3); }
struct Unit { int pm, pn, k0; };
struct Gemm { const bf16_t* A; const bf16_t* Bt; };
struct StaticOrder {
    int nM, nN, nwg, G, c, pm0;
    __device__ void init(int nM_, int nN_, int G_, int c_, int pm0_) { nM = nM_; nN = nN_; nwg = nM * nN; G = G_; c = c_; pm0 = pm0_; }
    __device__ bool next(int i, Unit& u) const {
        const long L = (long)i * G + c; if (L >= nwg) return false;
        int wgid = (int)L; { const int q = nwg / NXCD, r = nwg % NXCD, xcd = wgid % NXCD, off = wgid / NXCD; wgid = (xcd < r ? xcd * (q + 1) : r * (q + 1) + (xcd - r) * q) + off; }
        const int nig = WGM * nN, gid = wgid / nig, fm = gid * WGM, gsz = (nM - fm) < WGM ? (nM - fm) : WGM;
        u.pm = pm0 + fm + ((wgid % nig) % gsz); u.pn = (wgid % nig) / gsz; u.k0 = 0; return true;
    }
};

struct EpiBf16 {
    static constexpr bool PERM = true, AFTER_DRAIN = false;
    bf16_t* O; int ldc;
    __device__ __forceinline__ void operator()(const f32x4 (&acc)[2][2][4][2], const Unit& u, int wr, int wc, int fr, int fq) const {
        const int row0 = u.pm * BM + wr * 64 + fr; const int col0 = u.pn * BM + wc * 32 + 8 * fq;
#pragma unroll
        for (int ai = 0; ai < 2; ++ai)
#pragma unroll
            for (int m = 0; m < 4; ++m) { bf16_t* rowp = O + (size_t)(row0 + ai * HALF + m * 16) * ldc + col0;
#pragma unroll
                for (int bj = 0; bj < 2; ++bj) { const f32x4 v0 = acc[ai][bj][m][0], v1 = acc[ai][bj][m][1];
                    u32x4 w; w.x = pk2(v0[0], v0[1]); w.y = pk2(v0[2], v0[3]); w.z = pk2(v1[0], v1[1]); w.w = pk2(v1[2], v1[3]);
                    *(u32x4*)(rowp + bj * HALF) = w; } }
    }
};
struct EpiSwiglu {
    static constexpr bool PERM = true, AFTER_DRAIN = false;
    bf16_t* O; int ldc;
    __device__ __forceinline__ void operator()(const f32x4 (&acc)[2][2][4][2], const Unit& u, int wr, int wc, int fr, int fq) const {
        const int row0 = u.pm * BM + wr * 64 + fr; const int col0 = u.pn * HALF + wc * 32 + 8 * fq;
#pragma unroll
        for (int ai = 0; ai < 2; ++ai)
#pragma unroll
            for (int m = 0; m < 4; ++m) { bf16_t* rowp = O + (size_t)(row0 + ai * HALF + m * 16) * ldc + col0;
                float o[8];
#pragma unroll
                for (int n = 0; n < 2; ++n)
#pragma unroll
                    for (int j = 0; j < 4; ++j) { const float a = acc[ai][0][m][n][j], b = acc[ai][1][m][n][j]; o[n * 4 + j] = siluf_(a) * b; }
                u32x4 w; w.x = pk2(o[0], o[1]); w.y = pk2(o[2], o[3]); w.z = pk2(o[4], o[5]); w.w = pk2(o[6], o[7]);
                *(u32x4*)rowp = w; }
    }
};
struct EpiRes {
    static constexpr bool PERM = false, AFTER_DRAIN = false;
    const float* base_c; const float* base_l; float* out_c; float* out_l; const float* gate;
    __device__ __forceinline__ void operator()(const f32x4 (&acc)[2][2][4][2], const Unit& u, int wr, int wc, int fr, int fq) const {
        const int bi = (u.pm < 4) ? 4 : ((u.pm - 4) >> 4);
        const float* base = (u.pm < 4) ? base_c + (size_t)u.pm * BM * DM : base_l + (size_t)(u.pm - 4) * BM * DM;
        float* out = (u.pm < 4) ? out_c + (size_t)u.pm * BM * DM : out_l + (size_t)(u.pm - 4) * BM * DM;
        const int row0 = wr * 64 + fr, col0 = u.pn * BM + wc * 32 + 4 * fq;
        f32x4 gv[2][2];
#pragma unroll
        for (int bj = 0; bj < 2; ++bj)
#pragma unroll
            for (int n = 0; n < 2; ++n) gv[bj][n] = *(const f32x4*)(gate + (size_t)bi * 6144 + col0 + bj * HALF + n * 16);
#pragma unroll
        for (int ai = 0; ai < 2; ++ai)
#pragma unroll
            for (int mh = 0; mh < 2; ++mh) {
                f32x4 bs[2][2][2];
#pragma unroll
                for (int m2 = 0; m2 < 2; ++m2) { const size_t off = (size_t)(row0 + ai * HALF + (mh * 2 + m2) * 16) * DM + col0;
#pragma unroll
                    for (int bj = 0; bj < 2; ++bj)
#pragma unroll
                        for (int n = 0; n < 2; ++n) bs[m2][bj][n] = *(const f32x4*)(base + off + bj * HALF + n * 16); }
#pragma unroll
                for (int m2 = 0; m2 < 2; ++m2) { const size_t off = (size_t)(row0 + ai * HALF + (mh * 2 + m2) * 16) * DM + col0;
#pragma unroll
                    for (int bj = 0; bj < 2; ++bj)
#pragma unroll
                        for (int n = 0; n < 2; ++n) *(f32x4*)(out + off + bj * HALF + n * 16) = bs[m2][bj][n] + gv[bj][n] * acc[ai][bj][mh * 2 + m2][n]; }
            }
    }
};

template <bool BASE16>
struct EpiResNorm {
    static constexpr bool PERM = false, AFTER_DRAIN = true;
    const void* base_l; void* out_l; const float* gate;
    const float* ng; const float* nsh; const float* nsc;
    bf16_t* hn; float* xbuf; unsigned* cnt;
    __device__ __forceinline__ void fused(f32x4 (&acc)[2][2][4][2], const Unit& u, int wr, int wc, int fr, int fq, LAS unsigned char* lds, int wid, int lane) const {
        const int pl = u.pm - 4, bi = pl >> 4;
        const float* base = (const float*)base_l + (size_t)pl * BM * DM; const bf16_t* base16 = (const bf16_t*)base_l + (size_t)pl * BM * DM;
        float* out = (float*)out_l + (size_t)pl * BM * DM; bf16_t* out16 = (bf16_t*)out_l + (size_t)pl * BM * DM;
        const int row0 = wr * 64 + fr, col0 = u.pn * BM + wc * 32 + 4 * fq;
        LAS float* P = (LAS float*)lds;
        LAS float* S = (LAS float*)(lds + 4096);
        f32x4 gv[2][2];
#pragma unroll
        for (int bj = 0; bj < 2; ++bj)
#pragma unroll
            for (int n = 0; n < 2; ++n) gv[bj][n] = *(const f32x4*)(gate + (size_t)bi * 6144 + col0 + bj * HALF + n * 16);
#pragma unroll
        for (int ai = 0; ai < 2; ++ai)
#pragma unroll
            for (int mh = 0; mh < 2; ++mh) {
                f32x4 bs[2][2][2];
#pragma unroll
                for (int m2 = 0; m2 < 2; ++m2) { const size_t off = (size_t)(row0 + ai * HALF + (mh * 2 + m2) * 16) * DM + col0;
#pragma unroll
                    for (int bj = 0; bj < 2; ++bj)
#pragma unroll
                        for (int n = 0; n < 2; ++n) {
                            if (BASE16) { const u32x2 w = *(const u32x2*)(base16 + off + bj * HALF + n * 16); bs[m2][bj][n] = (f32x4){bflo(w.x), bfhi(w.x), bflo(w.y), bfhi(w.y)}; }
                            else bs[m2][bj][n] = *(const f32x4*)(base + off + bj * HALF + n * 16); } }
#pragma unroll
                for (int m2 = 0; m2 < 2; ++m2) { const int m = mh * 2 + m2; const size_t off = (size_t)(row0 + ai * HALF + m * 16) * DM + col0;
                    float sq = 0.f;
#pragma unroll
                    for (int bj = 0; bj < 2; ++bj)
#pragma unroll
                        for (int n = 0; n < 2; ++n) { const f32x4 x = bs[m2][bj][n] + gv[bj][n] * acc[ai][bj][m][n]; acc[ai][bj][m][n] = x;
                            if (hn) { u32x2 w; w.x = pk2(x[0], x[1]); w.y = pk2(x[2], x[3]); *(u32x2*)(out16 + off + bj * HALF + n * 16) = w; }
                            sq += (x[0] * x[0] + x[1] * x[1]) + (x[2] * x[2] + x[3] * x[3]); }
                    sq += __shfl_xor(sq, 16); sq += __shfl_xor(sq, 32);
                    if (fq == 0) P[(ai * HALF + wr * 64 + m * 16 + fr) * 4 + wc] = sq; }
            }
        f32x4 ngv[2][2], shv[2][2];
#pragma unroll
        for (int bj = 0; bj < 2; ++bj)
#pragma unroll
            for (int n = 0; n < 2; ++n) { const int c = col0 + bj * HALF + n * 16; ngv[bj][n] = *(const f32x4*)(ng + c);
                if (nsh) { shv[bj][n] = *(const f32x4*)(nsh + (size_t)bi * 6144 + c); ngv[bj][n] = ngv[bj][n] * (*(const f32x4*)(nsc + (size_t)bi * 6144 + c) + 1.0f); }
                else shv[bj][n] = (f32x4){0.f, 0.f, 0.f, 0.f}; }
        asm volatile("s_waitcnt lgkmcnt(0)" ::: "memory"); __builtin_amdgcn_s_barrier(); asm volatile("" ::: "memory");
        const int row = wid * 32 + (lane & 31);
        if (lane < 32) { const float t = (P[row * 4 + 0] + P[row * 4 + 1]) + (P[row * 4 + 2] + P[row * 4 + 3]);
            __hip_atomic_store(xbuf + ((size_t)(pl * BM + row) * 4 + u.pn), t, __ATOMIC_RELAXED, __HIP_MEMORY_SCOPE_AGENT); }
        asm volatile("s_waitcnt vmcnt(0)" ::: "memory");
        if (lane == 0) __hip_atomic_fetch_add(cnt + 64 * pl, 1u, __ATOMIC_RELAXED, __HIP_MEMORY_SCOPE_AGENT);
        if (wid == 0) {
            unsigned sp = 0;
            while ((unsigned)__builtin_amdgcn_readfirstlane(__hip_atomic_load(cnt + 64 * pl, __ATOMIC_RELAXED, __HIP_MEMORY_SCOPE_AGENT)) < 32u) { __builtin_amdgcn_s_sleep(2); if (++sp > (1u << 22)) break; }
            __builtin_amdgcn_fence(__ATOMIC_ACQUIRE, "agent");
        }
        asm volatile("s_waitcnt vmcnt(0) lgkmcnt(0)" ::: "memory"); __builtin_amdgcn_s_barrier(); asm volatile("" ::: "memory");
        if (lane < 32) { const float* sl = xbuf + (size_t)(pl * BM + row) * 4; float ss = 0.f;
#pragma unroll
            for (int t = 0; t < 4; ++t) ss += __hip_atomic_load(sl + t, __ATOMIC_RELAXED, __HIP_MEMORY_SCOPE_AGENT);
            S[row] = rsqrtf(ss * (1.0f / DM) + EPS); }
        asm volatile("s_waitcnt lgkmcnt(0)" ::: "memory"); __builtin_amdgcn_s_barrier(); asm volatile("" ::: "memory");
#pragma unroll
        for (int ai = 0; ai < 2; ++ai)
#pragma unroll
            for (int m = 0; m < 4; ++m) { const int r = ai * HALF + wr * 64 + m * 16 + fr; const float rs = S[r];
#pragma unroll
                for (int bj = 0; bj < 2; ++bj)
#pragma unroll
                    for (int n = 0; n < 2; ++n) { const f32x4 y = acc[ai][bj][m][n] * rs * ngv[bj][n] + shv[bj][n]; const int c = col0 + bj * HALF + n * 16;
                        if (hn) { u32x2 w; w.x = pk2(y[0], y[1]); w.y = pk2(y[2], y[3]); *(u32x2*)(hn + (size_t)(u.pm * BM + r) * DM + c) = w; }
                        else *(f32x4*)(out + (size_t)r * DM + c) = y; } }
        asm volatile("s_waitcnt lgkmcnt(0)" ::: "memory"); __builtin_amdgcn_s_barrier(); asm volatile("" ::: "memory");
    }
};
struct SliceOrder {
    int ns, nu, G, c;
    __device__ void init(int ns_, int G_, int c_) { ns = ns_; nu = 16 * ns_; G = G_; c = G_ - 1 - c_; }
    __device__ bool next(int i, Unit& u) const {
        const int L = i * G + c; if (L >= nu) return false;
        const int t = L / ns, sl = L % ns; u.pm = t >> 2; u.pn = t & 3; u.k0 = sl * 256; return true;
    }
};
struct EpiPartial {
    static constexpr bool PERM = false, AFTER_DRAIN = false;
    float* p0; float* p1; int split;
    __device__ __forceinline__ void operator()(const f32x4 (&acc)[2][2][4][2], const Unit& u, int wr, int wc, int fr, int fq) const {
        const int sl = u.k0 >> 8;
        float* out = ((sl < split) ? p0 + (size_t)sl * MC * DM : p1 + (size_t)(sl - split) * MC * DM) + (size_t)u.pm * BM * DM;
        const int row0 = wr * 64 + fr, col0 = u.pn * BM + wc * 32 + 4 * fq;
#pragma unroll
        for (int ai = 0; ai < 2; ++ai)
#pragma unroll
            for (int m = 0; m < 4; ++m) { const size_t off = (size_t)(row0 + ai * HALF + m * 16) * DM + col0;
#pragma unroll
                for (int bj = 0; bj < 2; ++bj)
#pragma unroll
                    for (int n = 0; n < 2; ++n) *(f32x4*)(out + off + bj * HALF + n * 16) = acc[ai][bj][m][n]; }
    }
};

template <int LD, int KLEN, bool ALIGN_EPI, class Epi, class Sched>
__device__ __forceinline__ void gemm_phase(LAS unsigned char* lds, const Gemm g, const Sched& S, const Epi& E) {
    const int tid = fresh_tid(), wid = __builtin_amdgcn_readfirstlane(tid >> 6), lane = tid & 63, wr = wid >> 2, wc = wid & 3, fr = lane & 15, fq = lane >> 4;
    constexpr int nt = KLEN / BK;
    unsigned voffA[2], voffB[2];
#pragma unroll
    for (int i = 0; i < 2; ++i) { int R, C; stage_rc(tid * 16 + i * 8192, R, C); const int Rb = Epi::PERM ? ((R & ~31) + perm32(R & 31)) : R;
        voffA[i] = (unsigned)(R * LD + C) * 2u; voffB[i] = (unsigned)(Rb * LD + C) * 2u; }
    const size_t kstep = (size_t)(BK * 2);
    constexpr size_t hstepA = (size_t)HALF * LD * 2, hstepB = hstepA;
    constexpr size_t tstepA = 2 * hstepA, tstepB = tstepA;
    const unsigned ldsw = (unsigned)wid * 1024u;
    const int aoff = lds_byte(wr * 64 + fr, fq * 8), boff = lds_byte(wc * 32 + fr, fq * 8);
#define PG8_SA(b, h) (((b) * 2 + (h)) * HTB)
#define PG8_SB(b, h) ((4 + (b) * 2 + (h)) * HTB)
#define PG8_STAGE(bufoff, gbase, voff) do { _Pragma("unroll") for (int _i = 0; _i < 2; ++_i) \
        __builtin_amdgcn_global_load_lds((const unsigned*)((const char*)(gbase) + (voff)[_i]), (LAS unsigned*)(lds + (bufoff) + ldsw + _i * 8192), 16, 0, 0); } while (0)
#define PG8_LDA(dst, b, h) do { _Pragma("unroll") for (int m = 0; m < 4; ++m) _Pragma("unroll") for (int k = 0; k < 2; ++k) dst[m][k] = *(const LAS bf16x8*)(lds + PG8_SA(b, h) + aoff + m * 2048 + k * 1024); } while (0)
#define PG8_LDB(dst, b, h) do { _Pragma("unroll") for (int n = 0; n < 2; ++n) _Pragma("unroll") for (int k = 0; k < 2; ++k) dst[n][k] = *(const LAS bf16x8*)(lds + PG8_SB(b, h) + boff + n * 2048 + k * 1024); } while (0)
#define PG8_MMA(ai, bj, At, Bt) do { __builtin_amdgcn_s_setprio(1); _Pragma("unroll") for (int m = 0; m < 4; ++m) _Pragma("unroll") for (int n = 0; n < 2; ++n) _Pragma("unroll") for (int k = 0; k < 2; ++k) \
        acc[ai][bj][m][n] = __builtin_amdgcn_mfma_f32_16x16x32_bf16(Bt[n][k], At[m][k], acc[ai][bj][m][n], 0, 0, 0); __builtin_amdgcn_s_setprio(0); } while (0)
#define PG8_WAIT_V(n) asm volatile("s_waitcnt vmcnt(" #n ")" ::: "memory")
#define PG8_WAIT_L(n) asm volatile("s_waitcnt lgkmcnt(" #n ")" ::: "memory")
#define PG8_BAR __builtin_amdgcn_s_barrier()
#define PG8_SCHED __builtin_amdgcn_sched_barrier(0)
    Unit cur, nxt; int ui = 0;
    if (!S.next(0, cur)) return;
    f32x4 acc[2][2][4][2];
#pragma unroll
    for (int a = 0; a < 2; ++a)
#pragma unroll
        for (int b = 0; b < 2; ++b)
#pragma unroll
            for (int m = 0; m < 4; ++m)
#pragma unroll
                for (int n = 0; n < 2; ++n) acc[a][b][m][n] = (f32x4){0.f, 0.f, 0.f, 0.f};
    bf16x8 At[4][2], B0[2][2], B1[2][2];
    const char* cA = (const char*)g.A + (size_t)cur.pm * tstepA + (size_t)cur.k0 * 2; const char* cB = (const char*)g.Bt + (size_t)cur.pn * tstepB + (size_t)cur.k0 * 2;
    PG8_STAGE(PG8_SB(0, 0), cB, voffB); PG8_STAGE(PG8_SB(0, 1), cB + hstepB, voffB); PG8_STAGE(PG8_SA(0, 0), cA, voffA); PG8_STAGE(PG8_SA(0, 1), cA + hstepA, voffA);
    if (wr == 1) PG8_BAR;
    PG8_WAIT_V(2); PG8_BAR;
    PG8_STAGE(PG8_SB(1, 0), cB + kstep, voffB); PG8_STAGE(PG8_SA(1, 0), cA + kstep, voffA); PG8_STAGE(PG8_SB(1, 1), cB + hstepB + kstep, voffB);
    PG8_WAIT_V(6); PG8_BAR;
    for (;;) {
        const bool has_next = S.next(ui + 1, nxt);
        const char* nA = has_next ? (const char*)g.A + (size_t)nxt.pm * tstepA + (size_t)nxt.k0 * 2 : cA; const char* nB = has_next ? (const char*)g.Bt + (size_t)nxt.pn * tstepB + (size_t)nxt.k0 * 2 : cB;
#pragma unroll 1
        for (int t = 0; t < nt; t += 2) {
            const bool last = (t == nt - 2);
            const char* a1 = cA + (size_t)(t + 1) * kstep;
            const char* a2 = last ? nA : cA + (size_t)(t + 2) * kstep; const char* b2 = last ? nB : cB + (size_t)(t + 2) * kstep;
            const char* a3 = a2 + kstep; const char* b3 = b2 + kstep;
            PG8_LDB(B0, 0, 0); PG8_LDB(B1, 0, 1); PG8_SCHED; PG8_LDA(At, 0, 0); PG8_STAGE(PG8_SA(1, 1), a1 + hstepA, voffA);
            PG8_WAIT_V(8); PG8_WAIT_L(0); PG8_BAR; PG8_MMA(0, 0, At, B0); PG8_MMA(0, 1, At, B1); PG8_BAR; PG8_SCHED;
            PG8_LDA(At, 0, 1); PG8_STAGE(PG8_SB(0, 0), b2, voffB); PG8_STAGE(PG8_SB(0, 1), b2 + hstepB, voffB); PG8_STAGE(PG8_SA(0, 0), a2, voffA);
            PG8_WAIT_V(8); PG8_WAIT_L(0); PG8_BAR; PG8_MMA(1, 0, At, B0); PG8_MMA(1, 1, At, B1); PG8_BAR; PG8_SCHED;
            PG8_LDB(B0, 1, 0); PG8_LDB(B1, 1, 1); PG8_SCHED; PG8_LDA(At, 1, 0); PG8_STAGE(PG8_SA(0, 1), a2 + hstepA, voffA);
            PG8_WAIT_V(8); PG8_WAIT_L(0); PG8_BAR; PG8_MMA(0, 0, At, B0); PG8_MMA(0, 1, At, B1); PG8_BAR; PG8_SCHED;
            PG8_LDA(At, 1, 1); PG8_STAGE(PG8_SB(1, 0), b3, voffB); PG8_STAGE(PG8_SB(1, 1), b3 + hstepB, voffB); PG8_STAGE(PG8_SA(1, 0), a3, voffA);
            PG8_WAIT_V(8); PG8_WAIT_L(0); PG8_BAR; PG8_MMA(1, 0, At, B0); PG8_MMA(1, 1, At, B1); PG8_BAR; PG8_SCHED;
        }
        if constexpr (ALIGN_EPI) { if (wr == 0) PG8_BAR; }
        if constexpr (!Epi::AFTER_DRAIN) E(acc, cur, wr, wc, fr, fq);
        if (!has_next) break;
#pragma unroll
        for (int a = 0; a < 2; ++a)
#pragma unroll
            for (int b = 0; b < 2; ++b)
#pragma unroll
                for (int m = 0; m < 4; ++m)
#pragma unroll
                    for (int n = 0; n < 2; ++n) acc[a][b][m][n] = (f32x4){0.f, 0.f, 0.f, 0.f};
        cur = nxt; cA = nA; cB = nB; ++ui;
        if constexpr (ALIGN_EPI) { if (wr == 1) PG8_BAR; }
    }
    PG8_WAIT_V(0);
    if constexpr (!ALIGN_EPI) { if (wr == 0) PG8_BAR; }
    PG8_BAR;
    if constexpr (Epi::AFTER_DRAIN) E.fused(acc, cur, wr, wc, fr, fq, lds, wid, lane);
#undef PG8_SA
#undef PG8_SB
#undef PG8_STAGE
#undef PG8_LDA
#undef PG8_LDB
#undef PG8_MMA
#undef PG8_WAIT_V
#undef PG8_WAIT_L
#undef PG8_BAR
#undef PG8_SCHED
}
}

struct Args {
    const float* in[25];
    float* out;
    unsigned char* ws;
};

struct Ctx {
    LAS unsigned char* lds;
    int G, bid;
};


__device__ __forceinline__ void transpose_item(const float* W, int K, int N, int k0, int nsrc0, bf16_t* WT, int ndst0, LAS float* scr, int lane) {
#pragma unroll
    for (int i = 0; i < 32; ++i) { const int kk = 2 * i + (lane >> 5); scr[kk * 33 + (lane & 31)] = W[(size_t)(k0 + kk) * N + nsrc0 + (lane & 31)]; }
    LDS_WAIT();
    const int c = lane & 7;
#pragma unroll
    for (int j = 0; j < 4; ++j) { const int n = (lane >> 3) + 8 * j; const LAS float* s = scr + (8 * c) * 33 + n;
        u32x4 o; o.x = pk2(s[0 * 33], s[1 * 33]); o.y = pk2(s[2 * 33], s[3 * 33]); o.z = pk2(s[4 * 33], s[5 * 33]); o.w = pk2(s[6 * 33], s[7 * 33]);
        *(u32x4*)(WT + (size_t)(ndst0 + n) * K + k0 + 8 * c) = o; }
    LDS_WAIT();
}

__device__ __forceinline__ void phase_p0(const Ctx& C, const Args& a) {
    PHASE_IDS();
    {
        LAS float* sc = (LAS float*)(C.lds);
        LAS float* red = (LAS float*)(C.lds + 20480);
        float* MOD = (float*)(a.ws + WS_MOD);
        for (int idx = tid; idx < 5 * 1024; idx += NTHR) { const int bi = idx >> 10, k = idx & 1023; const float v = bi < 4 ? a.in[1][bi * 1024 + k] : a.in[3][k]; sc[idx] = siluf_(v); }
        __syncthreads();
        for (int u = C.bid; u < 192; u += C.G) {
            const int l = u / 96, cb = u % 96, col = cb * 64 + lane;
            const float* W = a.in[4] + ((size_t)l * 1024 + wid * 128) * 6144 + col;
            float acc[5] = {0.f, 0.f, 0.f, 0.f, 0.f};
#pragma unroll 32
            for (int kk = 0; kk < 128; ++kk) { const float w = W[(size_t)kk * 6144]; const int k = wid * 128 + kk;
#pragma unroll
                for (int bi = 0; bi < 5; ++bi) acc[bi] += sc[bi * 1024 + k] * w; }
#pragma unroll
            for (int bi = 0; bi < 5; ++bi) red[(wid * 5 + bi) * 64 + lane] = acc[bi];
            __syncthreads();
            if (tid < 320) { const int bi = tid >> 6, ln = tid & 63; float s = a.in[5][l * 6144 + cb * 64 + ln];
#pragma unroll
                for (int w = 0; w < 8; ++w) s += red[(w * 5 + bi) * 64 + ln];
                MOD[((size_t)l * 5 + bi) * 6144 + cb * 64 + ln] = s; }
            __syncthreads();
        }
    }
    {
        LAS float* scr = (LAS float*)(C.lds + wid * 8448);
        const int gw = C.bid * 8 + wid, NGW = C.G * 8;
        constexpr int I_IN = 16 * 112, I_OUT = 16 * 32, I_13 = 16 * 176, I_2 = 44 * 32, I_PW = 4 * 8, I_L = I_IN + I_OUT + I_13 + I_2 + I_PW;
        for (int it = gw; it < 2 * I_L; it += NGW) {
            const int l = it / I_L; int r = it % I_L;
            unsigned char* wt = a.ws + WS_WT + (size_t)l * WT_LAYER;
            if (r < I_IN) { const int kb = r / 112, nb = r % 112; transpose_item(a.in[7] + (size_t)l * DM * INC, DM, INC, kb * 64, nb * 32, (bf16_t*)(wt + WT_IN), nb * 32, scr, lane); continue; } r -= I_IN;
            if (r < I_OUT) { const int kb = r / 32, nb = r % 32; transpose_item(a.in[20] + (size_t)l * DM * DM, DM, DM, kb * 64, nb * 32, (bf16_t*)(wt + WT_OUT), nb * 32, scr, lane); continue; } r -= I_OUT;
            if (r < I_13) { const int kb = r / 176, nb = r % 176; const int nd = nb * 32, pn = nd >> 8, bj = (nd >> 7) & 1, j = nd & 127;
                transpose_item(a.in[22] + (size_t)l * DM * 2 * DFF, DM, 2 * DFF, kb * 64, bj * DFF + pn * 128 + j, (bf16_t*)(wt + WT_13), nd, scr, lane); continue; } r -= I_13;
            if (r < I_2) { const int kb = r / 32, nb = r % 32; transpose_item(a.in[23] + (size_t)l * DFF * DM, DFF, DM, kb * 64, nb * 32, (bf16_t*)(wt + WT_2), nb * 32, scr, lane); continue; } r -= I_2;
            { const int kb = r / 8, nb = r % 8; transpose_item(a.in[18] + (size_t)l * 256 * 256, 256, 256, kb * 64, nb * 32, (bf16_t*)(wt + WT_PW), nb * 32, scr, lane); }
        }
    }
}

__device__ __forceinline__ void norm_row_load(const float* srcc, const float* srcl, const float* mod_l, int shift_idx, int scale_idx, int r, int lane, f32x4 (&v)[4], f32x4 (&shv)[4], f32x4 (&scv)[4]) {
    const float* xr = (r < MC) ? srcc + (size_t)r * DM : srcl + (size_t)(r - MC) * DM;
    const int bi = (r < MC) ? 4 : ((r - MC) >> 12);
    const float* sh = mod_l + (size_t)bi * 6144 + shift_idx * 1024; const float* sc = mod_l + (size_t)bi * 6144 + scale_idx * 1024;
#pragma unroll
    for (int j = 0; j < 4; ++j) { v[j] = *(const f32x4*)(xr + 4 * lane + 256 * j); shv[j] = *(const f32x4*)(sh + 4 * lane + 256 * j); scv[j] = *(const f32x4*)(sc + 4 * lane + 256 * j); }
}
__device__ __forceinline__ void norm_row_store(bf16_t* dst, int r, int lane, const f32x4 (&v)[4], const f32x4 (&shv)[4], const f32x4 (&scv)[4], const f32x4 (&gv)[4], float rs) {
#pragma unroll
    for (int j = 0; j < 4; ++j) { const f32x4 y = v[j] * rs * gv[j] * (scv[j] + 1.0f) + shv[j];
        u32x2 w; w.x = pk2(y[0], y[1]); w.y = pk2(y[2], y[3]);
        *(u32x2*)(dst + (size_t)r * DM + 4 * lane + 256 * j) = w; }
}
__device__ __forceinline__ float sumsq4(const f32x4 (&v)[4]) { float s = 0.f;
#pragma unroll
    for (int j = 0; j < 4; ++j) s += (v[j][0] * v[j][0] + v[j][1] * v[j][1]) + (v[j][2] * v[j][2] + v[j][3] * v[j][3]);
    return s; }
struct CtxFix { const float* p0; const float* p1; int split, ns; const float* gate; float* xc_out; };
__device__ __forceinline__ void phase_norm(const Ctx& C, const float* srcc, const float* srcl, const float* g, const float* mod_l  , int shift_idx, int scale_idx, bf16_t* dst, int r_lo, int r_hi, const CtxFix fx) {
    PHASE_IDS();
    const int gw = C.bid * 8 + wid, NGW = C.G * 8;
    f32x4 gv[4];
#pragma unroll
    for (int j = 0; j < 4; ++j) gv[j] = *(const f32x4*)(g + 4 * lane + 256 * j);
    for (int r = r_lo + gw; r < r_hi; r += 2 * NGW) {
        const int r2 = r + NGW; const bool two = r2 < r_hi;
        f32x4 v0[4], sh0[4], sc0[4], v1[4], sh1[4], sc1[4];
        norm_row_load(srcc, srcl, mod_l, shift_idx, scale_idx, r, lane, v0, sh0, sc0);
        if (two) norm_row_load(srcc, srcl, mod_l, shift_idx, scale_idx, r2, lane, v1, sh1, sc1);
        if (r < MC && fx.ns > 0) {
            f32x4 ps[4];
#pragma unroll
            for (int j = 0; j < 4; ++j) ps[j] = (f32x4){0.f, 0.f, 0.f, 0.f};
            for (int s0 = 0; s0 < fx.ns; s0 += 4) {
                f32x4 pl[4][4];
#pragma unroll
                for (int q = 0; q < 4; ++q) { const int sl = (s0 + q < fx.ns) ? s0 + q : s0;
                    const float* pr = ((sl < fx.split) ? fx.p0 + (size_t)sl * MC * DM : fx.p1 + (size_t)(sl - fx.split) * MC * DM) + (size_t)r * DM;
#pragma unroll
                    for (int j = 0; j < 4; ++j) pl[q][j] = *(const f32x4*)(pr + 4 * lane + 256 * j); }
#pragma unroll
                for (int q = 0; q < 4; ++q) if (s0 + q < fx.ns) {
#pragma unroll
                    for (int j = 0; j < 4; ++j) ps[j] += pl[q][j]; }
            }
#pragma unroll
            for (int j = 0; j < 4; ++j) { v0[j] += *(const f32x4*)(fx.gate + 4 * lane + 256 * j) * ps[j];
                if (fx.xc_out) *(f32x4*)(fx.xc_out + (size_t)r * DM + 4 * lane + 256 * j) = v0[j]; }
        }
        float s0 = sumsq4(v0), s1 = two ? sumsq4(v1) : 0.f;
#pragma unroll
        for (int o = 1; o < 64; o <<= 1) { s0 += __shfl_xor(s0, o); s1 += __shfl_xor(s1, o); }
        norm_row_store(dst, r, lane, v0, sh0, sc0, gv, rsqrtf(s0 * (1.0f / DM) + EPS));
        if (two) norm_row_store(dst, r2, lane, v1, sh1, sc1, gv, rsqrtf(s1 * (1.0f / DM) + EPS));
    }
}
__device__ __forceinline__ void phase_final(const Ctx& C, float* out, const float* g) {
    PHASE_IDS();
    const int gw = C.bid * 8 + wid, NGW = C.G * 8;
    f32x4 gv[4];
#pragma unroll
    for (int j = 0; j < 4; ++j) gv[j] = *(const f32x4*)(g + 4 * lane + 256 * j);
    for (int r = gw; r < ML; r += 2 * NGW) {
        float* x0 = out + (size_t)r * DM; float* x1 = out + (size_t)(r + NGW) * DM;
        f32x4 v0[4], v1[4];
#pragma unroll
        for (int j = 0; j < 4; ++j) { v0[j] = *(const f32x4*)(x0 + 4 * lane + 256 * j); v1[j] = *(const f32x4*)(x1 + 4 * lane + 256 * j); }
        float s0 = sumsq4(v0), s1 = sumsq4(v1);
#pragma unroll
        for (int o = 1; o < 64; o <<= 1) { s0 += __shfl_xor(s0, o); s1 += __shfl_xor(s1, o); }
        const float r0s = rsqrtf(s0 * (1.0f / DM) + EPS), r1s = rsqrtf(s1 * (1.0f / DM) + EPS);
#pragma unroll
        for (int j = 0; j < 4; ++j) { *(f32x4*)(x0 + 4 * lane + 256 * j) = v0[j] * r0s * gv[j]; *(f32x4*)(x1 + 4 * lane + 256 * j) = v1[j] * r1s * gv[j]; }
    }
}

constexpr int SC_QT = 0, SC_QS = 17408, SC_KT = 34816, SC_KDT = 52224, SC_VT = 70656, SC_ST = 89088, SC_P = 123904, SC_SEG = 133120, SC_DK = 135168;
template <int PASS, bool L0>
__device__ __forceinline__ void scan_unit(const Ctx& C, int tid, bf16_t* px, float* US, float* DEC, const float* lbl, int layer, int seq, int sc) {
    const int dir = seq & 1, h = (seq >> 1) & 3, b = seq >> 3;
    const int lane = tid & 63, wid = __builtin_amdgcn_readfirstlane(tid >> 6), fr = lane & 15, fq = lane >> 4;
    LAS bf16_t* QT = (LAS bf16_t*)(C.lds + SC_QT);
    LAS bf16_t* QS = (LAS bf16_t*)(C.lds + SC_QS);
    LAS bf16_t* KT = (LAS bf16_t*)(C.lds + SC_KT);
    LAS bf16_t* KDT = (LAS bf16_t*)(C.lds + SC_KDT);
    LAS bf16_t* VT = (LAS bf16_t*)(C.lds + SC_VT);
    LAS bf16_t* ST = (LAS bf16_t*)(C.lds + SC_ST);
    LAS bf16_t* P = (LAS bf16_t*)(C.lds + SC_P);
    LAS float* SEG = (LAS float*)(C.lds + SC_SEG);
    LAS float* DK = (LAS float*)(C.lds + SC_DK);
    const int k = tid & 127, sg = tid >> 7;
    float lb = 0.f;
    if (!L0) { const float l0 = lbl[(0 * 2 + dir) * 512 + h * 128 + k], l1 = lbl[(1 * 2 + dir) * 512 + h * 128 + k]; lb = sigmoidf_(l1 - l0); }
    const float omlb = 1.0f - lb;
    const int zcol = (dir ? 1024 : 512) + h * 128;
    const unsigned zo = (unsigned)(zcol - h * 128);

    unsigned pz[16], pq[16], pv[16];
    {
        const int p00 = sc * 256;
        const int rb0 = (p00 < 256) ? (b * 256 + (dir ? 255 - p00 : p00)) : (MC + b * 4096 + (dir ? 4095 - (p00 - 256) : (p00 - 256)));
        const int rs0 = dir ? -1 : 1;
#pragma unroll
        for (int i = 0; i < 16; ++i) { const unsigned idx = (unsigned)((rb0 + rs0 * (sg * 16 + i)) * INC + h * 128 + k);
            pz[i] = px[idx + zo]; pq[i] = px[idx]; pv[i] = px[idx + 1536]; }
    }
    f32x4 accS[8];
    if (PASS == 1 || sc == 0) {
#pragma unroll
        for (int vb = 0; vb < 8; ++vb) accS[vb] = (f32x4){0.f, 0.f, 0.f, 0.f};
    } else {
        const float* S0 = US + ((size_t)(seq * 16 + sc - 1) * 128) * 128;
#pragma unroll
        for (int vb = 0; vb < 8; ++vb)
#pragma unroll
            for (int j = 0; j < 4; ++j) accS[vb][j] = S0[(size_t)(wid * 16 + 4 * fq + j) * 128 + vb * 16 + fr];
    }
    if (PASS == 3) {
#pragma unroll
        for (int vb = 0; vb < 8; ++vb) { u32x2 w; w.x = pk2(accS[vb][0], accS[vb][1]); w.y = pk2(accS[vb][2], accS[vb][3]);
            *(LAS u32x2*)(ST + (vb * 16 + fr) * 136 + wid * 16 + 4 * fq) = w; }
    }
    float dtot[4] = {1.f, 1.f, 1.f, 1.f};

    for (int c = 0; c < 4; ++c) {
        const int p0 = sc * 256 + c * 64;
        const int rbase = (p0 < 256) ? (b * 256 + (dir ? 255 - p0 : p0)) : (MC + b * 4096 + (dir ? 4095 - (p0 - 256) : (p0 - 256)));
        const int rstep = dir ? -1 : 1;
        float cq[16], ck[16], cb[16]; bf16_t vv[16];
        float run = 0.f;
#pragma unroll
        for (int i = 0; i < 16; ++i) {
            const float zl = __uint_as_float(pz[i] << 16) * LOG2E;
            if (PASS == 3) cq[i] = __uint_as_float(pq[i] << 16);
            vv[i] = (bf16_t)pv[i];
            if (L0) { float ls, ln; logsig2(zl, ls, ln); ck[i] = ln; run += ls; }
            else {
                const float e = __builtin_amdgcn_exp2f(-fabsf(zl)); const float inv = __builtin_amdgcn_rcpf(1.0f + e); const float big = inv, small = e * inv;
                const float sig = zl >= 0.f ? big : small, nsig = zl >= 0.f ? small : big;
                ck[i] = omlb * nsig;
                run += __builtin_amdgcn_logf(fmaxf(lb + omlb * sig, 1e-30f));
            }
            cb[i] = run;
        }
        SEG[sg * 128 + k] = run;
        LBAR();
        const float s0 = SEG[k], s1 = SEG[128 + k], s2 = SEG[256 + k], s3 = SEG[384 + k];
        const float off = (sg > 0 ? s0 : 0.f) + (sg > 1 ? s1 : 0.f) + (sg > 2 ? s2 : 0.f);
        const float blast = (s0 + s1) + (s2 + s3), rr = 0.5f * blast, er = __builtin_amdgcn_exp2f(rr);
        if (sg == 0) DK[k] = er * er;
        unsigned kdp[8], vvp[8];
#pragma unroll
        for (int i = 0; i < 16; i += 2) {
            float kd2[2];
#pragma unroll
            for (int e = 0; e < 2; ++e) {
                const int ii = i + e; const int tau = sg * 16 + ii;
                const float d = rr - (off + cb[ii]);
                const float kt = L0 ? __builtin_amdgcn_exp2f(ck[ii] + d) : ck[ii] * __builtin_amdgcn_exp2f(d);
                kd2[e] = kt * er;
                if (PASS == 3) { const float qt = cq[ii] * __builtin_amdgcn_exp2f(-d); QT[tau * 136 + k] = f2bf(qt); QS[tau * 136 + k] = f2bf(qt * er); KT[tau * 136 + k] = f2bf(kt); }
            }
            kdp[i >> 1] = pk2(kd2[0], kd2[1]);
            vvp[i >> 1] = (unsigned)vv[i] | ((unsigned)vv[i + 1] << 16);
        }
        *(LAS u32x4*)(KDT + k * 72 + sg * 16) = (u32x4){kdp[0], kdp[1], kdp[2], kdp[3]};
        *(LAS u32x4*)(KDT + k * 72 + sg * 16 + 8) = (u32x4){kdp[4], kdp[5], kdp[6], kdp[7]};
        *(LAS u32x4*)(VT + k * 72 + sg * 16) = (u32x4){vvp[0], vvp[1], vvp[2], vvp[3]};
        *(LAS u32x4*)(VT + k * 72 + sg * 16 + 8) = (u32x4){vvp[4], vvp[5], vvp[6], vvp[7]};
        LBAR();
        if (c < 3) {
            const int rb2 = rbase + rstep * 64;
#pragma unroll
            for (int i = 0; i < 16; ++i) { const unsigned idx = (unsigned)((rb2 + rstep * (sg * 16 + i)) * INC + h * 128 + k);
                pz[i] = px[idx + zo]; pq[i] = px[idx]; pv[i] = px[idx + 1536]; }
        }

        if (PASS == 3) {
            f32x4 oacc[4];
#pragma unroll
            for (int tb = 0; tb < 4; ++tb) oacc[tb] = (f32x4){0.f, 0.f, 0.f, 0.f};
#pragma unroll
            for (int kp = 0; kp < 2; ++kp) {
                bf16x8 av[2], bq[2][4];
#pragma unroll
                for (int k2 = 0; k2 < 2; ++k2) { const int ks = kp * 2 + k2; av[k2] = *(const LAS bf16x8*)(ST + (wid * 16 + fr) * 136 + ks * 32 + fq * 8);
#pragma unroll
                    for (int tb = 0; tb < 4; ++tb) bq[k2][tb] = *(const LAS bf16x8*)(QS + (tb * 16 + fr) * 136 + ks * 32 + fq * 8); }
                asm volatile("" ::: "memory");
#pragma unroll
                for (int k2 = 0; k2 < 2; ++k2)
#pragma unroll
                    for (int tb = 0; tb < 4; ++tb) oacc[tb] = mfma16(av[k2], bq[k2][tb], oacc[tb]);
            }
#pragma unroll
            for (int e = 0; e < 2; ++e) { const int id = 2 * wid + e, sb = id >> 2, tb = id & 3;
                f32x4 sacc = (f32x4){0.f, 0.f, 0.f, 0.f};
                if (sb <= tb) {
                    bf16x8 av[4], bq[4];
#pragma unroll
                    for (int ks = 0; ks < 4; ++ks) { av[ks] = *(const LAS bf16x8*)(KT + (sb * 16 + fr) * 136 + ks * 32 + fq * 8); bq[ks] = *(const LAS bf16x8*)(QT + (tb * 16 + fr) * 136 + ks * 32 + fq * 8); }
                    asm volatile("" ::: "memory");
#pragma unroll
                    for (int ks = 0; ks < 4; ++ks) sacc = mfma16(av[ks], bq[ks], sacc); }
                const int t = tb * 16 + fr, s = sb * 16 + 4 * fq;
                float m[4];
#pragma unroll
                for (int j = 0; j < 4; ++j) m[j] = (s + j <= t) ? sacc[j] : 0.f;
                u32x2 w; w.x = pk2(m[0], m[1]); w.y = pk2(m[2], m[3]);
                *(LAS u32x2*)(P + t * 72 + s) = w; }
            LBAR();
            {
                bf16x8 av[2], bq[2][4];
#pragma unroll
                for (int ks = 0; ks < 2; ++ks) { av[ks] = *(const LAS bf16x8*)(VT + (wid * 16 + fr) * 72 + ks * 32 + fq * 8);
#pragma unroll
                    for (int tb = 0; tb < 4; ++tb) bq[ks][tb] = *(const LAS bf16x8*)(P + (tb * 16 + fr) * 72 + ks * 32 + fq * 8); }
                asm volatile("" ::: "memory");
#pragma unroll
                for (int ks = 0; ks < 2; ++ks)
#pragma unroll
                    for (int tb = 0; tb < 4; ++tb) oacc[tb] = mfma16(av[ks], bq[ks][tb], oacc[tb]);
            }
#pragma unroll
            for (int tb = 0; tb < 4; ++tb) { const int r = rbase + rstep * (tb * 16 + fr);
                u32x2 w; w.x = pk2(oacc[tb][0], oacc[tb][1]); w.y = pk2(oacc[tb][2], oacc[tb][3]);
                *(u32x2*)(px + (size_t)r * INC + zcol + wid * 16 + 4 * fq) = w; }
        }
        {
            float dk[4];
#pragma unroll
            for (int j = 0; j < 4; ++j) { dk[j] = DK[wid * 16 + 4 * fq + j]; dtot[j] *= dk[j]; }
#pragma unroll
            for (int vb = 0; vb < 8; ++vb)
#pragma unroll
                for (int j = 0; j < 4; ++j) accS[vb][j] *= dk[j];
#pragma unroll
            for (int ks = 0; ks < 2; ++ks) {
                bf16x8 bq[8]; const bf16x8 av = *(const LAS bf16x8*)(KDT + (wid * 16 + fr) * 72 + ks * 32 + fq * 8);
#pragma unroll
                for (int vb = 0; vb < 8; ++vb) bq[vb] = *(const LAS bf16x8*)(VT + (vb * 16 + fr) * 72 + ks * 32 + fq * 8);
                asm volatile("" ::: "memory");
#pragma unroll
                for (int vb = 0; vb < 8; ++vb) accS[vb] = mfma16(av, bq[vb], accS[vb]);
            }
            if (PASS == 3 && c < 3) {
#pragma unroll
                for (int vb = 0; vb < 8; ++vb) { u32x2 w; w.x = pk2(accS[vb][0], accS[vb][1]); w.y = pk2(accS[vb][2], accS[vb][3]);
                    *(LAS u32x2*)(ST + (vb * 16 + fr) * 136 + wid * 16 + 4 * fq) = w; }
            }
        }
        LBAR();
    }
    if (PASS == 1) {
        float* S1 = US + ((size_t)(seq * 16 + sc) * 128) * 128;
#pragma unroll
        for (int vb = 0; vb < 8; ++vb)
#pragma unroll
            for (int j = 0; j < 4; ++j) S1[(size_t)(wid * 16 + 4 * fq + j) * 128 + vb * 16 + fr] = accS[vb][j];
        if (fr == 0) {
#pragma unroll
            for (int j = 0; j < 4; ++j) DEC[(size_t)(seq * 17 + sc) * 128 + wid * 16 + 4 * fq + j] = dtot[j];
        }
    }
}

template <bool L0>
__device__ __forceinline__ void scan_pass1_unit(const Ctx& C, int tid, const bf16_t* px, float* US, float* DEC, const float* lbl, int layer, int seq, int sc) {
    const int dir = seq & 1, h = (seq >> 1) & 3, b = seq >> 3;
    const int lane = tid & 63, wid = __builtin_amdgcn_readfirstlane(tid >> 6), fr = lane & 15, fq = lane >> 4;
    LAS bf16_t* KDT = (LAS bf16_t*)(C.lds);
    LAS bf16_t* VT = (LAS bf16_t*)(C.lds + 67584);
    LAS float* DKc = (LAS float*)(C.lds + 135168);
    const int k = tid & 127, c = tid >> 7;
    float lb = 0.f;
    if (!L0) { const float l0 = lbl[(0 * 2 + dir) * 512 + h * 128 + k], l1 = lbl[(1 * 2 + dir) * 512 + h * 128 + k]; lb = sigmoidf_(l1 - l0); }
    const float omlb = 1.0f - lb;
    const int zcol = (dir ? 1024 : 512) + h * 128;
    const unsigned zo = (unsigned)(zcol - h * 128);
    const int p0 = sc * 256 + c * 64;
    const int rbase = (p0 < 256) ? (b * 256 + (dir ? 255 - p0 : p0)) : (MC + b * 4096 + (dir ? 4095 - (p0 - 256) : (p0 - 256)));
    const int rstep = dir ? -1 : 1;
    float R = 0.f;
    unsigned rz[16], rv[16];
#pragma unroll
    for (int i = 0; i < 16; ++i) { const unsigned idx = (unsigned)((rbase + rstep * (48 + i)) * INC + h * 128 + k); rz[i] = px[idx + zo]; rv[i] = px[idx + 1536]; }
#pragma unroll
    for (int p = 3; p >= 0; --p) {
        unsigned nz[16], nv[16];
        if (p > 0) {
#pragma unroll
            for (int i = 0; i < 16; ++i) { const unsigned idx = (unsigned)((rbase + rstep * ((p - 1) * 16 + i)) * INC + h * 128 + k); nz[i] = px[idx + zo]; nv[i] = px[idx + 1536]; }
        }
#pragma unroll
        for (int gh = 1; gh >= 0; --gh) {
            const int g = 2 * p + gh;
            float kd[8];
#pragma unroll
            for (int i = 7; i >= 0; --i) {
                const float zl = __uint_as_float(rz[gh * 8 + i] << 16) * LOG2E;
                if (L0) { float ls, ln; logsig2(zl, ls, ln); kd[i] = __builtin_amdgcn_exp2f(R + ln); R += ls; }
                else {
                    const float e = __builtin_amdgcn_exp2f(-fabsf(zl)); const float inv = __builtin_amdgcn_rcpf(1.0f + e); const float big = inv, small = e * inv;
                    const float sig = zl >= 0.f ? big : small, nsig = zl >= 0.f ? small : big;
                    kd[i] = omlb * nsig * __builtin_amdgcn_exp2f(R);
                    R += __builtin_amdgcn_logf(fmaxf(lb + omlb * sig, 1e-30f));
                }
            }
            *(LAS u32x4*)(KDT + k * 264 + c * 64 + g * 8) = (u32x4){pk2(kd[0], kd[1]), pk2(kd[2], kd[3]), pk2(kd[4], kd[5]), pk2(kd[6], kd[7])};
            const unsigned* v8 = rv + gh * 8;
            *(LAS u32x4*)(VT + k * 264 + c * 64 + g * 8) = (u32x4){v8[0] | (v8[1] << 16), v8[2] | (v8[3] << 16), v8[4] | (v8[5] << 16), v8[6] | (v8[7] << 16)};
        }
        if (p > 0) {
#pragma unroll
            for (int i = 0; i < 16; ++i) { rz[i] = nz[i]; rv[i] = nv[i]; }
        }
    }
    DKc[c * 128 + k] = __builtin_amdgcn_exp2f(R);
    __syncthreads();
    f32x4 accS[8];
#pragma unroll
    for (int vb = 0; vb < 8; ++vb) accS[vb] = (f32x4){0.f, 0.f, 0.f, 0.f};
    float dtot[4] = {1.f, 1.f, 1.f, 1.f};
#pragma unroll
    for (int cc = 0; cc < 4; ++cc) {
        float dk[4];
#pragma unroll
        for (int j = 0; j < 4; ++j) { dk[j] = DKc[cc * 128 + wid * 16 + 4 * fq + j]; dtot[j] *= dk[j]; }
        if (cc > 0) {
#pragma unroll
            for (int vb = 0; vb < 8; ++vb)
#pragma unroll
                for (int j = 0; j < 4; ++j) accS[vb][j] *= dk[j];
        }
#pragma unroll
        for (int ks = 0; ks < 2; ++ks) {
            bf16x8 bq[8]; const bf16x8 av = *(const LAS bf16x8*)(KDT + (wid * 16 + fr) * 264 + cc * 64 + ks * 32 + fq * 8);
#pragma unroll
            for (int vb = 0; vb < 8; ++vb) bq[vb] = *(const LAS bf16x8*)(VT + (vb * 16 + fr) * 264 + cc * 64 + ks * 32 + fq * 8);
            asm volatile("" ::: "memory");
#pragma unroll
            for (int vb = 0; vb < 8; ++vb) accS[vb] = mfma16(av, bq[vb], accS[vb]);
        }
    }
    float* S1 = US + ((size_t)(seq * 16 + sc) * 128) * 128;
#pragma unroll
    for (int vb = 0; vb < 8; ++vb)
#pragma unroll
        for (int j = 0; j < 4; ++j) S1[(size_t)(wid * 16 + 4 * fq + j) * 128 + vb * 16 + fr] = accS[vb][j];
    if (fr == 0) {
#pragma unroll
        for (int j = 0; j < 4; ++j) DEC[(size_t)(seq * 17 + sc) * 128 + wid * 16 + 4 * fq + j] = dtot[j];
    }
    __syncthreads();
}

__device__ __forceinline__ void phase_s2(const Ctx& C, float* US, const float* DEC) {
    PHASE_IDS();
    for (int idx = C.bid * NTHR + tid; idx < 32 * 4096; idx += C.G * NTHR) {
        const int seq = idx >> 12, kk = (idx & 4095) >> 5, v4 = idx & 31;
        float* p = US + ((size_t)(seq * 16) * 128 + kk) * 128 + v4 * 4;
        const float* dp = DEC + (size_t)(seq * 17) * 128 + kk;
        f32x4 U[16]; float d[16];
#pragma unroll
        for (int sc = 0; sc < 16; ++sc) { U[sc] = *(const f32x4*)(p + (size_t)sc * 16384); d[sc] = dp[sc * 128]; }
        f32x4 S = (f32x4){0.f, 0.f, 0.f, 0.f};
#pragma unroll
        for (int sc = 0; sc < 16; ++sc) { S = S * d[sc] + U[sc]; *(f32x4*)(p + (size_t)sc * 16384) = S; }
    }
}

__device__ __forceinline__ void gmlp_unit(const Ctx& C, int tid, const bf16_t* px, bf16_t* ycat, const float* w_s  , const float* b_s  , const float* ln_g, const float* ln_b, int cidx, int g) {
    LAS bf16_t* Wl = (LAS bf16_t*)(C.lds);
    LAS bf16_t* VnT = (LAS bf16_t*)(C.lds + 34816);
    const int r0 = cidx * 128, lane = tid & 63, wid = __builtin_amdgcn_readfirstlane(tid >> 6), fr = lane & 15, fq = lane >> 4;
    const float* W = w_s + (size_t)g * 128 * 128;
#pragma unroll
    for (int i = 0; i < 8; ++i) { const int f4 = tid + NTHR * i, t = f4 >> 5, s4 = (f4 & 31) * 4; const f32x4 v = *(const f32x4*)(W + t * 128 + s4);
        u32x2 w; w.x = pk2(v[0], v[1]); w.y = pk2(v[2], v[3]); *(LAS u32x2*)(Wl + t * 136 + s4) = w; }
    {
        const int s = tid >> 2, part = tid & 3, d0 = part * 16;
        const bf16_t* src = px + (size_t)(r0 + s) * INC + 2816 + g * 64 + d0;
        const u32x4 w0 = *(const u32x4*)src, w1 = *(const u32x4*)(src + 8);
        float x[16];
        x[0] = bflo(w0.x); x[1] = bfhi(w0.x); x[2] = bflo(w0.y); x[3] = bfhi(w0.y); x[4] = bflo(w0.z); x[5] = bfhi(w0.z); x[6] = bflo(w0.w); x[7] = bfhi(w0.w);
        x[8] = bflo(w1.x); x[9] = bfhi(w1.x); x[10] = bflo(w1.y); x[11] = bfhi(w1.y); x[12] = bflo(w1.z); x[13] = bfhi(w1.z); x[14] = bflo(w1.w); x[15] = bfhi(w1.w);
        float sm = 0.f;
#pragma unroll
        for (int i = 0; i < 16; ++i) { x[i] = gelu_tanh(x[i]); sm += x[i]; }
        sm += __shfl_xor(sm, 1); sm += __shfl_xor(sm, 2);
        const float mu = sm * (1.0f / 64.0f); float q = 0.f;
#pragma unroll
        for (int i = 0; i < 16; ++i) { x[i] -= mu; q += x[i] * x[i]; }
        q += __shfl_xor(q, 1); q += __shfl_xor(q, 2);
        const float rs = rsqrtf(q * (1.0f / 64.0f) + EPS);
#pragma unroll
        for (int i = 0; i < 16; ++i) { const int d = d0 + i; const float y = x[i] * rs * ln_g[g * 64 + d] + ln_b[g * 64 + d]; VnT[d * 136 + s] = f2bf(y); }
    }
    __syncthreads();
    f32x4 acc[4];
#pragma unroll
    for (int db = 0; db < 4; ++db) acc[db] = (f32x4){0.f, 0.f, 0.f, 0.f};
#pragma unroll
    for (int ks = 0; ks < 4; ++ks) { const bf16x8 bw = *(const LAS bf16x8*)(Wl + (wid * 16 + fr) * 136 + ks * 32 + fq * 8);
#pragma unroll
        for (int db = 0; db < 4; ++db) { const bf16x8 av = *(const LAS bf16x8*)(VnT + (db * 16 + fr) * 136 + ks * 32 + fq * 8); acc[db] = mfma16(av, bw, acc[db]); } }
    {
        const int t = wid * 16 + fr, r = r0 + t; const float bias = b_s[g * 128 + t];
        u32x2 uw[4];
#pragma unroll
        for (int db = 0; db < 4; ++db) uw[db] = *(const u32x2*)(px + (size_t)r * INC + 2560 + g * 64 + db * 16 + 4 * fq);
#pragma unroll
        for (int db = 0; db < 4; ++db) { const int col = g * 64 + db * 16 + 4 * fq;
            const float u0 = gelu_tanh(bflo(uw[db].x)), u1 = gelu_tanh(bfhi(uw[db].x)), u2 = gelu_tanh(bflo(uw[db].y)), u3 = gelu_tanh(bfhi(uw[db].y));
            u32x2 w; w.x = pk2(u0 * (acc[db][0] + bias), u1 * (acc[db][1] + bias)); w.y = pk2(u2 * (acc[db][2] + bias), u3 * (acc[db][3] + bias));
            *(u32x2*)(ycat + (size_t)r * DM + 512 + col) = w; }
    }
    __syncthreads();
}

__device__ __forceinline__ void conv_unit(const Ctx& C, int tid, const bf16_t* px, bf16_t* ycat, const float* dw_w  , const float* dw_b, const float* ln_g, const float* ln_b, const bf16_t* pwt  , const float* pw_b, int tix) {
    LAS float* Z = (LAS float*)(C.lds);
    LAS bf16_t* Hn = (LAS bf16_t*)(C.lds + 96256);
    LAS float* Wd = (LAS float*)(C.lds + 130048);
    const int r0 = tix * 64, lane = tid & 63, wid = __builtin_amdgcn_readfirstlane(tid >> 6), fr = lane & 15, fq = lane >> 4;
    const int seg_lo = (r0 < MC) ? (r0 & ~255) : r0, seg_hi = seg_lo + ((r0 < MC) ? 256 : 64);
    {
        f32x4 wv[4]; u32x4 aw[6], gw[6]; bool zin[6];
#pragma unroll
        for (int q = 0; q < 4; ++q) { const int it = tid + q * NTHR; wv[q] = (it < 31 * 64) ? *(const f32x4*)(dw_w + it * 4) : (f32x4){0.f, 0.f, 0.f, 0.f}; }
#pragma unroll
        for (int q = 0; q < 6; ++q) { const int it = tid + q * NTHR, zr = it >> 5, c8 = (it & 31) * 8, r = r0 - 15 + zr;
            zin[q] = (it < 94 * 32) && r >= seg_lo && r < seg_hi;
            const size_t ro = (size_t)(zin[q] ? r : r0) * INC;
            aw[q] = *(const u32x4*)(px + ro + 3072 + c8); gw[q] = *(const u32x4*)(px + ro + 3328 + c8); }
#pragma unroll
        for (int q = 0; q < 4; ++q) { const int it = tid + q * NTHR; if (it < 31 * 64) *(LAS f32x4*)(Wd + it * 4) = wv[q]; }
#pragma unroll
        for (int q = 0; q < 6; ++q) { const int it = tid + q * NTHR, zr = it >> 5, c8 = (it & 31) * 8;
            if (it < 94 * 32) {
                f32x4 z0 = (f32x4){0.f, 0.f, 0.f, 0.f}, z1 = z0;
                if (zin[q]) {
                    z0[0] = bflo(aw[q].x) * sigmoidf_(bflo(gw[q].x)); z0[1] = bfhi(aw[q].x) * sigmoidf_(bfhi(gw[q].x)); z0[2] = bflo(aw[q].y) * sigmoidf_(bflo(gw[q].y)); z0[3] = bfhi(aw[q].y) * sigmoidf_(bfhi(gw[q].y));
                    z1[0] = bflo(aw[q].z) * sigmoidf_(bflo(gw[q].z)); z1[1] = bfhi(aw[q].z) * sigmoidf_(bfhi(gw[q].z)); z1[2] = bflo(aw[q].w) * sigmoidf_(bflo(gw[q].w)); z1[3] = bfhi(aw[q].w) * sigmoidf_(bfhi(gw[q].w));
                }
                *(LAS f32x4*)(Z + zr * 256 + c8) = z0; *(LAS f32x4*)(Z + zr * 256 + c8 + 4) = z1;
            }
        }
    }
    __syncthreads();
    {
        const int t0 = wid * 8, c4 = lane * 4;
        f32x4 acc[8], win[8];
#pragma unroll
        for (int t = 0; t < 8; ++t) acc[t] = (f32x4){0.f, 0.f, 0.f, 0.f};
#pragma unroll
        for (int t = 0; t < 7; ++t) win[t] = *(const LAS f32x4*)(Z + (t0 + t) * 256 + c4);
#pragma unroll 1
        for (int j0 = 0; j0 < 32; j0 += 8) {
#pragma unroll
            for (int jj = 0; jj < 8; ++jj) {
                const int j = j0 + jj;
                if (j < 31) {
                    win[(jj + 7) & 7] = *(const LAS f32x4*)(Z + (t0 + j + 7) * 256 + c4);
                    const f32x4 wj = *(const LAS f32x4*)(Wd + j * 256 + c4);
#pragma unroll
                    for (int t = 0; t < 8; ++t) acc[t] += win[(t + jj) & 7] * wj;
                }
            }
        }
        const f32x4 bv = *(const f32x4*)(dw_b + c4), gv = *(const f32x4*)(ln_g + c4), bb = *(const f32x4*)(ln_b + c4);
#pragma unroll
        for (int t = 0; t < 8; ++t) {
            f32x4 x = acc[t] + bv;
            float sm = (x[0] + x[1]) + (x[2] + x[3]);
            sm += __shfl_xor(sm, 1); sm += __shfl_xor(sm, 2); sm += __shfl_xor(sm, 4); sm += __shfl_xor(sm, 8);
            const float mu = sm * (1.0f / 64.0f);
            x = x - mu;
            float q = (x[0] * x[0] + x[1] * x[1]) + (x[2] * x[2] + x[3] * x[3]);
            q += __shfl_xor(q, 1); q += __shfl_xor(q, 2); q += __shfl_xor(q, 4); q += __shfl_xor(q, 8);
            const float rs = rsqrtf(q * (1.0f / 64.0f) + EPS);
            const f32x4 y = x * rs * gv + bb;
            u32x2 w; w.x = pk2(siluf_(y[0]), siluf_(y[1])); w.y = pk2(siluf_(y[2]), siluf_(y[3]));
            *(LAS u32x2*)(Hn + (t0 + t) * 264 + c4) = w;
        }
    }
    __syncthreads();
    {
        f32x4 acc[2][4];
#pragma unroll
        for (int e = 0; e < 2; ++e)
#pragma unroll
            for (int tb = 0; tb < 4; ++tb) acc[e][tb] = (f32x4){0.f, 0.f, 0.f, 0.f};
#pragma unroll
        for (int ks = 0; ks < 8; ++ks) {
            bf16x8 bh[4];
#pragma unroll
            for (int tb = 0; tb < 4; ++tb) bh[tb] = *(const LAS bf16x8*)(Hn + (tb * 16 + fr) * 264 + ks * 32 + fq * 8);
#pragma unroll
            for (int e = 0; e < 2; ++e) { const bf16x8 aw = *(const bf16x8*)(pwt + (size_t)((2 * wid + e) * 16 + fr) * 256 + ks * 32 + fq * 8);
#pragma unroll
                for (int tb = 0; tb < 4; ++tb) acc[e][tb] = mfma16(aw, bh[tb], acc[e][tb]); }
        }
#pragma unroll
        for (int e = 0; e < 2; ++e) { const int o = (2 * wid + e) * 16 + 4 * fq; const f32x4 pb = *(const f32x4*)(pw_b + o);
#pragma unroll
            for (int tb = 0; tb < 4; ++tb) { const int r = r0 + tb * 16 + fr; const f32x4 y = acc[e][tb] + pb;
                u32x2 w; w.x = pk2(y[0], y[1]); w.y = pk2(y[2], y[3]);
                *(u32x2*)(ycat + (size_t)r * DM + 768 + o) = w; } }
    }
    __syncthreads();
}

__device__ __forceinline__ void phase_xa(const Ctx& C, const bf16_t* px, bf16_t* ycat, const float* onorm_g, int r_lo) {
    PHASE_IDS();
    const int gw = C.bid * 8 + wid, NGW = C.G * 8;
    const int col = 8 * lane;
    const f32x4 gn0 = *(const f32x4*)(onorm_g + col), gn1 = *(const f32x4*)(onorm_g + col + 4);
    for (int r = r_lo + gw; r < MT; r += 4 * NGW) {
        u32x4 wf[4], wb[4], wg[4]; bool ok[4];
#pragma unroll
        for (int q = 0; q < 4; ++q) { const int rq = r + q * NGW; ok[q] = rq < MT; const bf16_t* pr = px + (size_t)(ok[q] ? rq : r) * INC;
            wf[q] = *(const u32x4*)(pr + 512 + col); wb[q] = *(const u32x4*)(pr + 1024 + col); wg[q] = *(const u32x4*)(pr + 2048 + col); }
#pragma unroll
        for (int q = 0; q < 4; ++q) {
            float o[8];
            o[0] = bflo(wf[q].x) + bflo(wb[q].x); o[1] = bfhi(wf[q].x) + bfhi(wb[q].x); o[2] = bflo(wf[q].y) + bflo(wb[q].y); o[3] = bfhi(wf[q].y) + bfhi(wb[q].y);
            o[4] = bflo(wf[q].z) + bflo(wb[q].z); o[5] = bfhi(wf[q].z) + bfhi(wb[q].z); o[6] = bflo(wf[q].w) + bflo(wb[q].w); o[7] = bfhi(wf[q].w) + bfhi(wb[q].w);
            float ss = 0.f;
#pragma unroll
            for (int i = 0; i < 8; ++i) ss += o[i] * o[i];
            ss += __shfl_xor(ss, 1); ss += __shfl_xor(ss, 2); ss += __shfl_xor(ss, 4); ss += __shfl_xor(ss, 8);
            const float rs = rsqrtf(ss * (1.0f / 128.0f) + EPS);
            const float g0 = siluf_(bflo(wg[q].x)), g1 = siluf_(bfhi(wg[q].x)), g2 = siluf_(bflo(wg[q].y)), g3 = siluf_(bfhi(wg[q].y));
            const float g4 = siluf_(bflo(wg[q].z)), g5 = siluf_(bfhi(wg[q].z)), g6 = siluf_(bflo(wg[q].w)), g7 = siluf_(bfhi(wg[q].w));
            u32x4 w;
            w.x = pk2(o[0] * rs * gn0[0] * g0, o[1] * rs * gn0[1] * g1); w.y = pk2(o[2] * rs * gn0[2] * g2, o[3] * rs * gn0[3] * g3);
            w.z = pk2(o[4] * rs * gn1[0] * g4, o[5] * rs * gn1[1] * g5); w.w = pk2(o[6] * rs * gn1[2] * g6, o[7] * rs * gn1[3] * g7);
            if (ok[q]) *(u32x4*)(ycat + (size_t)(r + q * NGW) * DM + col) = w;
        }
    }
}

#ifdef DBG_STOP
__device__ __forceinline__ void dbg_digest(const Ctx& C, const XcdBarrier& bar, float* out, const bf16_t* pb, size_t nb, const float* pf, size_t nf) {
    xcd_barrier(bar);
    const size_t NO = (size_t)ML * DM;
    for (size_t i = (size_t)C.bid * NTHR + threadIdx.x; i < NO; i += (size_t)C.G * NTHR) {
        float s = 0.f;
        for (size_t j = i; j < nb; j += NO) s += bf2f(pb[j]);
        for (size_t j = i; j < nf; j += NO) s += pf[j];
        if (!(fabsf(s) < 1e30f)) s = 7777.0f;
        out[i] = s;
    }
}
#define DBG_AT(n, pb, nb, pf, nf) if (DBG_STOP == (n) && l == DBG_L) { dbg_digest(C, bar, a.out, (pb), (nb), (pf), (nf)); return; }
#else
#define DBG_AT(n, pb, nb, pf, nf)
#define DBG_L 0
#endif
__global__ void __launch_bounds__(NTHR, 2) fwd_megakernel(Args a) {
    extern __shared__ __attribute__((aligned(16))) unsigned char lds_raw[];
    cg::grid_group grid = cg::this_grid();
    Ctx C;
    C.lds = (LAS unsigned char*)lds_raw;
    C.G = gridDim.x; C.bid = blockIdx.x;
    volatile LAS unsigned* barw = (volatile LAS unsigned*)(C.lds + LDS_BARW);
    if (threadIdx.x < 4) barw[threadIdx.x] = 0u;
    for (int i = C.bid * NTHR + threadIdx.x; i < (int)(CTL_BYTES / 16); i += C.G * NTHR) ((u32x4*)(a.ws + WS_CTL))[i] = (u32x4){0u, 0u, 0u, 0u};
    __syncthreads();

    float* MOD = (float*)(a.ws + WS_MOD);
    float* DEC = (float*)(a.ws + WS_DEC);
    float* XC = (float*)(a.ws + WS_XC);
    bf16_t* ABF = (bf16_t*)(a.ws + WS_ABF);
    bf16_t* PX = (bf16_t*)(a.ws + WS_PX);
    float* US = (float*)(a.ws + WS_US);
    float* PTAIL = (float*)(a.ws + WS_PX + (size_t)MT * DFF * 2);

#ifdef DBG_TIME
    unsigned long long t_last = __builtin_amdgcn_s_memrealtime(); unsigned long long t_cat[12] = {0,0,0,0,0,0,0,0,0,0,0,0};
#define TS(c) do { const unsigned long long _n = __builtin_amdgcn_s_memrealtime(); t_cat[c] += _n - t_last; t_last = _n; } while (0)
#else
#define TS(c)
#endif
    phase_p0(C, a);
    grid.sync();
    XcdBarrier bar = xcd_barrier_post((unsigned*)(a.ws + WS_CTL), barw);
    TS(0);

    const int dbgl = (a.in[0] == nullptr) ? 1 : 0; (void)dbgl;
    for (int l = 0; l < 2; ++l) {
        unsigned char* wt = a.ws + WS_WT + (size_t)l * WT_LAYER;
        const float* mod_l = MOD + (size_t)l * 5 * 6144;
        const float* srcc = (l == 0) ? a.in[2] : XC;
        const float* srcl = (l == 0) ? a.in[0] : a.out;
        DBG_AT(17, PX, 0, a.out, (size_t)ML * DM)
        { CtxFix fx{PTAIL, US, 6, (l == 0) ? 0 : 11, MOD + (size_t)4 * 6144 + 5 * 1024, nullptr};
          phase_norm(C, srcc, srcl, a.in[6] + l * DM, mod_l, 0, 1, ABF, 0, (l == 0) ? MT : MC, fx); }
        if (l == 0) { for (int i = C.bid * NTHR + threadIdx.x; i < MC * DM / 4; i += C.G * NTHR) ((f32x4*)XC)[i] = ((const f32x4*)a.in[2])[i]; }
        GRID_BAR();
        TS(1);

#if defined(DBG_STOP) && DBG_STOP == 14
        if (l == 1) {
            xcd_barrier(bar);
            const bf16_t* w1 = (const bf16_t*)(a.ws + WS_WT + WT_LAYER + WT_IN);
            for (size_t i = (size_t)C.bid * NTHR + threadIdx.x; i < (size_t)ML * DM; i += (size_t)C.G * NTHR) {
                float v = 0.f;
                #define BADF(x) (!(fabsf(x) < 1e30f))
                if (BADF(bf2f(ABF[i])) || (i + (size_t)ML * DM < (size_t)MT * DM && BADF(bf2f(ABF[i + (size_t)ML * DM])))) v = 500.f;
                if (i < (size_t)MC * DM && BADF(XC[i])) v = 1000.f;
                if (BADF(a.out[i])) v = 2000.f;
                if (i < 61440 && BADF(MOD[i])) v = 3000.f;
                if (i < (size_t)INC * DM && BADF(bf2f(w1[i]))) v = 4000.f;
                a.out[i] = v;
            }
            return;
        }
#endif
        DBG_AT(15, PX, 0, a.out, (size_t)ML * DM)
        DBG_AT(16, ABF, (size_t)MT * DM, XC, (size_t)MC * DM)
        { pg8::Gemm g{ABF, (const bf16_t*)(wt + WT_IN)}; pg8::StaticOrder S; S.init(MT / 256, INC / 256, C.G, C.bid, 0);
          pg8::EpiBf16 E{PX, INC}; pg8::gemm_phase<DM, DM, true>(C.lds, g, S, E); }
        GRID_BAR();
        TS(2);
        DBG_AT(1, PX, (size_t)MT * INC, MOD, (size_t)2 * 5 * 6144)
        { const int tid = fresh_tid(); for (int u = C.bid; u < 32 * 16; u += C.G) { if (l == 0) scan_pass1_unit<true>(C, tid, PX, US, DEC, a.in[8], l, u & 31, u >> 5); else scan_pass1_unit<false>(C, tid, PX, US, DEC, a.in[8], l, u & 31, u >> 5); } }
        GRID_BAR();
        TS(3);
        phase_s2(C, US, DEC);
        GRID_BAR();
        TS(4);
        DBG_AT(2, PX, 0, US, (size_t)32 * 16 * 128 * 128)
        {
            const int tid = fresh_tid();
            const int sc0 = (l == 0) ? 0 : 1, nS = 32 * (17 - sc0);
            const int cb0 = (l == 0) ? 0 : 8, nB = (136 - cb0) * 4, ct0 = (l == 0) ? 0 : 16, nC = 272 - ct0;
            int nscan = 0;
            for (int u = C.bid; u < nS; u += C.G) { if (l == 0) scan_unit<3, true>(C, tid, PX, US, DEC, a.in[8], l, u & 31, sc0 + (u >> 5)); else scan_unit<3, false>(C, tid, PX, US, DEC, a.in[8], l, u & 31, sc0 + (u >> 5)); ++nscan; }
            const int extra = nS % C.G;
            const int nsmall = nB + nC;
            int first, stride;
            if (extra > 0 && extra < C.G) { if (C.bid < extra) { first = nsmall; stride = 1; } else { first = C.bid - extra; stride = C.G - extra; } }
            else { first = C.bid; stride = C.G; }
            for (int v = first; v < nsmall; v += stride) {
                if (v < nC) conv_unit(C, tid, PX, ABF, a.in[14] + (size_t)l * 31 * 256, a.in[15] + l * 256, a.in[16] + l * 256, a.in[17] + l * 256, (const bf16_t*)(wt + WT_PW), a.in[19] + l * 256, ct0 + v);
                else { const int w = v - nC; gmlp_unit(C, tid, PX, ABF, a.in[12] + (size_t)l * 4 * 128 * 128, a.in[13] + l * 512, a.in[10] + l * 256, a.in[11] + l * 256, cb0 + (w >> 2), w & 3); }
            }
            (void)nscan;
        }
        GRID_BAR();
        TS(5);
        DBG_AT(3, PX, (size_t)MT * INC, US, 0)
        DBG_AT(4, ABF, (size_t)MT * DM, US, 0)
        phase_xa(C, PX, ABF, a.in[9] + l * 512, (l == 0) ? 0 : MC);
        GRID_BAR();
        TS(6);
        DBG_AT(5, ABF, (size_t)MT * DM, US, 0)
        { pg8::Gemm g{ABF, (const bf16_t*)(wt + WT_OUT)}; pg8::StaticOrder S; S.init(ML / 256, DM / 256, C.G, C.bid, 4);
          float* xb = (float*)(a.ws + WS_XB) + (size_t)(l * 2 + 0) * ML * 4; unsigned* cn = (unsigned*)(a.ws + WS_CNT) + (size_t)(l * 2 + 0) * 64 * 64;
          if (l == 0) { pg8::EpiResNorm<false> E{a.in[0], a.out, mod_l + 2 * 1024, a.in[21] + l * DM, mod_l + 3 * 1024, mod_l + 4 * 1024, ABF, xb, cn}; pg8::gemm_phase<DM, DM, false>(C.lds, g, S, E); }
          else        { pg8::EpiResNorm<true>  E{a.out, US, mod_l + 2 * 1024, a.in[21] + l * DM, mod_l + 3 * 1024, mod_l + 4 * 1024, ABF, xb, cn}; pg8::gemm_phase<DM, DM, false>(C.lds, g, S, E); }
          if (l == 0) { pg8::SliceOrder SS; SS.init(4, C.G, C.bid);
              pg8::EpiPartial EA{US, US, 4}; pg8::gemm_phase<DM, 256, false>(C.lds, g, SS, EA); } }
        GRID_BAR();
        TS(7);
        DBG_AT(6, PX, 0, a.out, (size_t)ML * DM)
        DBG_AT(11, ABF, (size_t)MC * DM, XC, (size_t)MC * DM)
        if (l == 0) {
            { CtxFix fx{US, US, 4, 4, mod_l + (size_t)4 * 6144 + 2 * 1024, XC};
              phase_norm(C, XC, a.out, a.in[21] + l * DM, mod_l, 3, 4, ABF, 0, MC, fx); }
            GRID_BAR();
        }
        TS(1);
        DBG_AT(7, ABF, (size_t)MT * DM, US, 0)
        { const int pm0 = (l == 0) ? 0 : 4;
          pg8::Gemm g{ABF, (const bf16_t*)(wt + WT_13)}; pg8::StaticOrder S; S.init(MT / 256 - pm0, 2 * DFF / 256, C.G, C.bid, pm0);
          pg8::EpiSwiglu E{PX, DFF}; pg8::gemm_phase<DM, DM, true>(C.lds, g, S, E); }
        GRID_BAR();
        TS(8);
        DBG_AT(8, PX, (size_t)MT * DFF, US, 0)
        { pg8::Gemm g{PX, (const bf16_t*)(wt + WT_2)}; pg8::StaticOrder S; S.init(ML / 256, DM / 256, C.G, C.bid, 4);
          const float* mod_n = MOD + (size_t)1 * 5 * 6144;
          float* xb = (float*)(a.ws + WS_XB) + (size_t)(l * 2 + 1) * ML * 4; unsigned* cn = (unsigned*)(a.ws + WS_CNT) + (size_t)(l * 2 + 1) * 64 * 64;
          if (l == 0) { pg8::EpiResNorm<true> E{a.out, a.out, mod_l + 5 * 1024, a.in[6] + DM, mod_n, mod_n + 1024, ABF, xb, cn}; pg8::gemm_phase<DFF, DFF, false>(C.lds, g, S, E); }
          else        { pg8::EpiResNorm<true> E{US, a.out, mod_l + 5 * 1024, a.in[24], nullptr, nullptr, nullptr, xb, cn}; pg8::gemm_phase<DFF, DFF, false>(C.lds, g, S, E); }
          if (l == 0) { pg8::SliceOrder SS; SS.init(11, C.G, C.bid);
              pg8::EpiPartial EA{PTAIL, US, 6}; pg8::gemm_phase<DFF, 256, false>(C.lds, g, SS, EA); } }
        if (l == 0) GRID_BAR();
        TS(9);
        DBG_AT(10, PX, 0, a.out, (size_t)ML * DM)
    }
    { const int l = DBG_L; DBG_AT(9, PX, 0, a.out, (size_t)ML * DM) }
#ifdef DBG_TIME
    TS(10);
    __syncthreads();
    if (C.bid == 0) {
        unsigned long long ta = 0, tb = 0;
#pragma unroll
        for (int c = 0; c < 12; ++c) { if ((DBG_SEL_A >> c) & 1) ta += t_cat[c]; if ((DBG_SEL_B >> c) & 1) tb += t_cat[c]; }
        const float fa = (float)ta * 0.01f, fb = (float)tb * 0.01f;
        for (int i = threadIdx.x; i <= 1000; i += NTHR) a.out[i] = (i == 0) ? fa * 0.25f : fb * 0.01f;
    }
#endif
}

extern "C" void kernel_launch(void* const* d_in, const int* in_sizes, int n_in, void* d_out, int out_size, void* d_ws, size_t ws_size, hipStream_t stream) {
    static int grid = 0;
    if (grid == 0) {
        int dev = 0, cus = 0, per_cu = 0;
        hipGetDevice(&dev);
        hipDeviceGetAttribute(&cus, hipDeviceAttributeMultiprocessorCount, dev);
        hipFuncSetAttribute((const void*)fwd_megakernel, hipFuncAttributeMaxDynamicSharedMemorySize, LDS_BYTES);
        hipOccupancyMaxActiveBlocksPerMultiprocessor(&per_cu, (const void*)fwd_megakernel, NTHR, LDS_BYTES);
        if (per_cu < 1) per_cu = 1;
        grid = cus;
        if (ws_size < WS_END) fprintf(stderr, "kernel_launch: workspace too small: %zu < %zu\n", ws_size, (size_t)WS_END);
        (void)hipGetLastError();
    }
    Args a{};
    for (int i = 0; i < 25; ++i) a.in[i] = (const float*)d_in[i];
    a.out = (float*)d_out; a.ws = (unsigned char*)d_ws;
    void* args[] = {&a};
    hipError_t e = hipLaunchCooperativeKernel((const void*)fwd_megakernel, dim3(grid), dim3(NTHR), args, LDS_BYTES, stream);
    if (e != hipSuccess) fprintf(stderr, "cooperative launch failed: %s (grid %d)\n", hipGetErrorString(e), grid);
}
```

```cpp
#include <hip/hip_runtime.h>
#include <hip/hip_cooperative_groups.h>
#include <cstdio>
namespace cg = cooperative_groups;
#define USE_XCD_BAR 1
#ifndef USE_XCD_BAR
#define GRID_BAR() grid.sync()
#else
#define GRID_BAR() xcd_barrier(bar)
#endif

#define LAS __attribute__((address_space(3)))
typedef unsigned short bf16_t;
typedef short bf16x8 __attribute__((ext_vector_type(8)));
typedef float f32x4 __attribute__((ext_vector_type(4)));
typedef float f32x2 __attribute__((ext_vector_type(2)));
typedef unsigned u32x4 __attribute__((ext_vector_type(4)));
typedef unsigned u32x2 __attribute__((ext_vector_type(2)));

constexpr int DM = 1024, NBATCH = 4, SEQ = 4096, CTXL = 256;
constexpr int MC = NBATCH * CTXL;
constexpr int ML = NBATCH * SEQ;
constexpr int MT = MC + ML;
constexpr int INC = 3584, DFF = 2816;
constexpr float EPS = 1e-6f;
constexpr int NTHR = 512;
constexpr int LDS_BYTES = 163840;
constexpr int LDS_BARW = LDS_BYTES - 64;

constexpr size_t WS_CTL = 0;
constexpr size_t CTL_BYTES = 131072;
constexpr size_t WS_CNT = 16384;
constexpr size_t WS_XB = 131072;
constexpr size_t WS_MOD = WS_XB + 1048576;
constexpr size_t WS_DEC = WS_MOD + 262144;
constexpr size_t WS_WT = WS_DEC + 524288;
constexpr size_t WT_IN = 0, WT_OUT = WT_IN + (size_t)INC * DM * 2, WT_13 = WT_OUT + (size_t)DM * DM * 2,
                 WT_2 = WT_13 + (size_t)2 * DFF * DM * 2, WT_PW = WT_2 + (size_t)DM * DFF * 2, WT_LAYER = WT_PW + (size_t)256 * 256 * 2;
constexpr size_t WS_XC = WS_WT + 2 * WT_LAYER;
constexpr size_t WS_ABF = WS_XC + (size_t)MC * DM * 4;
constexpr size_t WS_PX = WS_ABF + (size_t)MT * DM * 2;
constexpr size_t WS_US = WS_PX + (size_t)MT * INC * 2;
constexpr size_t WS_END = WS_US + (size_t)32 * 16 * 128 * 128 * 4;

__device__ __forceinline__ float bf2f(bf16_t v) { return __uint_as_float(((unsigned)v) << 16); }
__device__ __forceinline__ float bflo(unsigned w) { return __uint_as_float(w << 16); }
__device__ __forceinline__ float bfhi(unsigned w) { return __uint_as_float(w & 0xffff0000u); }
typedef __bf16 bf16x2_t __attribute__((ext_vector_type(2)));
__device__ __forceinline__ unsigned pk2(float lo, float hi) { const f32x2 v = {lo, hi}; const bf16x2_t b = __builtin_convertvector(v, bf16x2_t); return __builtin_bit_cast(unsigned, b); }
__device__ __forceinline__ bf16_t f2bf(float v) { return (bf16_t)(pk2(v, 0.f) & 0xffffu); }
__device__ __forceinline__ float sigmoidf_(float x) { return __builtin_amdgcn_rcpf(1.0f + __expf(-x)); }
__device__ __forceinline__ float siluf_(float x) { return x * sigmoidf_(x); }
__device__ __forceinline__ float gelu_tanh(float x) { const float y = 0.7978845608028654f * (x + 0.044715f * x * x * x); return x * sigmoidf_(2.0f * y); }
__device__ __forceinline__ void logsig2(float zl, float& ls, float& ln) {
    const float e = __builtin_amdgcn_exp2f(-fabsf(zl));
    const float L2 = __builtin_amdgcn_logf(1.0f + e);
    ls = fminf(zl, 0.f) - L2; ln = ls - zl;
}
constexpr float LOG2E = 1.4426950408889634f;
__device__ __forceinline__ float wave_sum(float v) {
#pragma unroll
    for (int o = 1; o < 64; o <<= 1) v += __shfl_xor(v, o);
    return v;
}
__device__ __forceinline__ f32x4 mfma16(bf16x8 a, bf16x8 b, f32x4 c) { return __builtin_amdgcn_mfma_f32_16x16x32_bf16(a, b, c, 0, 0, 0); }
#define LDS_WAIT() asm volatile("s_waitcnt lgkmcnt(0)" ::: "memory")
#define LBAR() do { asm volatile("s_waitcnt lgkmcnt(0)" ::: "memory"); __builtin_amdgcn_s_barrier(); asm volatile("" ::: "memory"); } while (0)
__device__ __forceinline__ int fresh_tid() { int t = threadIdx.x; asm volatile("" : "+v"(t)); return t; }
#define PHASE_IDS() const int tid = fresh_tid(), lane = tid & 63, wid = __builtin_amdgcn_readfirstlane(tid >> 6); (void)lane; (void)wid

#define XB_TMO      128
#define XB_XCNT(j)  (256  + 64 * (j))
#define XB_XSUB(j)  (1280 + 64 * (j))
#define XB_XGEN(j)  (2304 + 64 * (j))
#define XB_TOP      3328
#define XB_TOPGEN   3392
#define XCD_BAR_WORDS 3456
#define XB_SPIN_CAP (1u << 20)
__device__ __forceinline__ unsigned xb_ld(unsigned* p)              { return __hip_atomic_load(p, __ATOMIC_RELAXED, __HIP_MEMORY_SCOPE_AGENT); }
__device__ __forceinline__ unsigned xb_add(unsigned* p, unsigned v) { return __hip_atomic_fetch_add(p, v, __ATOMIC_RELAXED, __HIP_MEMORY_SCOPE_AGENT); }
__device__ __forceinline__ unsigned xb_xcc_id() { return (unsigned)__builtin_amdgcn_s_getreg((3 << 11) | 20) & 0xFu; }
#define XB_SPIN(cond, bar) do { unsigned _sp = 0; while (cond) { __builtin_amdgcn_s_sleep(1); \
    if ((++_sp & 255u) == 0u) { if (xb_ld(&(bar)[XB_TMO])) break; if (_sp > XB_SPIN_CAP) { atomicAdd(&(bar)[XB_TMO], 1u); break; } } } } while (0)
struct XcdBarrier { unsigned* bar; unsigned x; volatile LAS unsigned* st; };
__device__ __forceinline__ XcdBarrier xcd_barrier_post(unsigned* bar, volatile LAS unsigned* st) {
    XcdBarrier b; b.bar = bar; b.x = xb_xcc_id(); b.st = st;
    if (threadIdx.x == 0) (void)xb_add(&bar[XB_XCNT(b.x)], 1u);
    return b;
}
__device__ __forceinline__ void xcd_barrier_complete(unsigned* bar, unsigned x, unsigned& nloc, unsigned& nx) {
    const unsigned G = gridDim.x * gridDim.y * gridDim.z;
    unsigned sum, cnt, mine, sp = 0u;
    for (;;) {
        sum = 0u; cnt = 0u; mine = 0u;
#pragma unroll
        for (unsigned j = 0; j < 16; ++j) { const unsigned c = xb_ld(&bar[XB_XCNT(j)]); sum += c; cnt += (c > 0u) ? 1u : 0u; mine = (j == x) ? c : mine; }
        if (sum == G) break;
        __builtin_amdgcn_s_sleep(1);
        if ((++sp & 255u) == 0u) { if (xb_ld(&bar[XB_TMO])) break; if (sp > XB_SPIN_CAP) { atomicAdd(&bar[XB_TMO], 1u); break; } }
    }
    nloc = mine > 0u ? mine : 1u; nx = cnt > 0u ? cnt : 1u;
}
__device__ __forceinline__ void xcd_barrier(const XcdBarrier& b) {
    asm volatile("s_waitcnt vmcnt(0)" ::: "memory");
    __syncthreads();
    if (threadIdx.x == 0) {
        unsigned* bar = b.bar;
        __builtin_amdgcn_s_waitcnt(0);
        unsigned nloc = b.st[0], nx = b.st[1];
        if (nloc == 0u) { xcd_barrier_complete(bar, b.x, nloc, nx); b.st[0] = nloc; b.st[1] = nx; }
        const unsigned old = xb_add(&bar[XB_XSUB(b.x)], 1u);
        const unsigned gen = old / nloc;
        if (old + 1u == (gen + 1u) * nloc) {
            __builtin_amdgcn_fence(__ATOMIC_RELEASE, "agent");
            asm volatile("s_waitcnt vmcnt(0)" ::: "memory");
            const unsigned og = xb_add(&bar[XB_TOP], 1u);
            const unsigned tg = og / nx;
            if (og + 1u == (tg + 1u) * nx) xb_add(&bar[XB_TOPGEN], 1u);
            else XB_SPIN(xb_ld(&bar[XB_TOPGEN]) == tg, bar);
            __builtin_amdgcn_fence(__ATOMIC_ACQUIRE, "agent");
            xb_add(&bar[XB_XGEN(b.x)], 1u);
            asm volatile("s_waitcnt vmcnt(0)" ::: "memory");
        } else {
            XB_SPIN(xb_ld(&bar[XB_XGEN(b.x)]) == gen, bar);
            __builtin_amdgcn_fence(__ATOMIC_ACQUIRE, "agent");
            asm volatile("s_waitcnt vmcnt(0)" ::: "memory");
        }
    }
    __syncthreads();
}

namespace pg8 {
constexpr int BM = 256, BK = 64, HALF = 128, HTB = HALF * BK * 2, STAGE_BYTES = 8 * HTB, NXCD = 8, WGM = 4;
__device__ __forceinline__ int lds_byte(int r, int c) { const int st = (r >> 4) * 2 + (c >> 5), rr = r & 15, cc = c & 31, ob = rr * 64 + cc * 2; return st * 1024 + (ob ^ (((ob >> 9) & 1) << 5)); }
__device__ __forceinline__ void stage_rc(int b, int& R, int& C) { const int st = b / 1024, sb = b % 1024, swz = sb ^ (((sb >> 9) & 1) << 5); R = (st >> 1) * 16 + swz / 64; C = (st & 1) * 32 + (swz % 64) / 2; }
__device__ __forceinline__ int perm32(int rho) { const int n = rho >> 4, i = rho & 15; return 8 * (i >> 2) + 4 * n + (i & 3); }
struct Unit { int pm, pn, k0; };
struct Gemm { const bf16_t* A; const bf16_t* Bt; };
struct StaticOrder {
    int nM, nN, nwg, G, c, pm0;
    __device__ void init(int nM_, int nN_, int G_, int c_, int pm0_) { nM = nM_; nN = nN_; nwg = nM * nN; G = G_; c = c_; pm0 = pm0_; }
    __device__ bool next(int i, Unit& u) const {
        const long L = (long)i * G + c; if (L >= nwg) return false;
        int wgid = (int)L; { const int q = nwg / NXCD, r = nwg % NXCD, xcd = wgid % NXCD, off = wgid / NXCD; wgid = (xcd < r ? xcd * (q + 1) : r * (q + 1) + (xcd - r) * q) + off; }
        const int nig = WGM * nN, gid = wgid / nig, fm = gid * WGM, gsz = (nM - fm) < WGM ? (nM - fm) : WGM;
        u.pm = pm0 + fm + ((wgid % nig) % gsz); u.pn = (wgid % nig) / gsz; u.k0 = 0; return true;
    }
};

struct EpiBf16 {
    static constexpr bool PERM = true, AFTER_DRAIN = false;
    bf16_t* O; int ldc;
    __device__ __forceinline__ void operator()(const f32x4 (&acc)[2][2][4][2], const Unit& u, int wr, int wc, int fr, int fq) const {
        const int row0 = u.pm * BM + wr * 64 + fr; const int col0 = u.pn * BM + wc * 32 + 8 * fq;
#pragma unroll
        for (int ai = 0; ai < 2; ++ai)
#pragma unroll
            for (int m = 0; m < 4; ++m) { bf16_t* rowp = O + (size_t)(row0 + ai * HALF + m * 16) * ldc + col0;
#pragma unroll
                for (int bj = 0; bj < 2; ++bj) { const f32x4 v0 = acc[ai][bj][m][0], v1 = acc[ai][bj][m][1];
                    u32x4 w; w.x = pk2(v0[0], v0[1]); w.y = pk2(v0[2], v0[3]); w.z = pk2(v1[0], v1[1]); w.w = pk2(v1[2], v1[3]);
                    *(u32x4*)(rowp + bj * HALF) = w; } }
    }
};
struct EpiSwiglu {
    static constexpr bool PERM = true, AFTER_DRAIN = false;
    bf16_t* O; int ldc;
    __device__ __forceinline__ void operator()(const f32x4 (&acc)[2][2][4][2], const Unit& u, int wr, int wc, int fr, int fq) const {
        const int row0 = u.pm * BM + wr * 64 + fr; const int col0 = u.pn * HALF + wc * 32 + 8 * fq;
#pragma unroll
        for (int ai = 0; ai < 2; ++ai)
#pragma unroll
            for (int m = 0; m < 4; ++m) { bf16_t* rowp = O + (size_t)(row0 + ai * HALF + m * 16) * ldc + col0;
                float o[8];
#pragma unroll
                for (int n = 0; n < 2; ++n)
#pragma unroll
                    for (int j = 0; j < 4; ++j) { const float a = acc[ai][0][m][n][j], b = acc[ai][1][m][n][j]; o[n * 4 + j] = siluf_(a) * b; }
                u32x4 w; w.x = pk2(o[0], o[1]); w.y = pk2(o[2], o[3]); w.z = pk2(o[4], o[5]); w.w = pk2(o[6], o[7]);
                *(u32x4*)rowp = w; }
    }
};
struct EpiRes {
    static constexpr bool PERM = false, AFTER_DRAIN = false;
    const float* base_c; const float* base_l; float* out_c; float* out_l; const float* gate;
    __device__ __forceinline__ void operator()(const f32x4 (&acc)[2][2][4][2], const Unit& u, int wr, int wc, int fr, int fq) const {
        const int bi = (u.pm < 4) ? 4 : ((u.pm - 4) >> 4);
        const float* base = (u.pm < 4) ? base_c + (size_t)u.pm * BM * DM : base_l + (size_t)(u.pm - 4) * BM * DM;
        float* out = (u.pm < 4) ? out_c + (size_t)u.pm * BM * DM : out_l + (size_t)(u.pm - 4) * BM * DM;
        const int row0 = wr * 64 + fr, col0 = u.pn * BM + wc * 32 + 4 * fq;
        f32x4 gv[2][2];
#pragma unroll
        for (int bj = 0; bj < 2; ++bj)
#pragma unroll
            for (int n = 0; n < 2; ++n) gv[bj][n] = *(const f32x4*)(gate + (size_t)bi * 6144 + col0 + bj * HALF + n * 16);
#pragma unroll
        for (int ai = 0; ai < 2; ++ai)
#pragma unroll
            for (int mh = 0; mh < 2; ++mh) {
                f32x4 bs[2][2][2];
#pragma unroll
                for (int m2 = 0; m2 < 2; ++m2) { const size_t off = (size_t)(row0 + ai * HALF + (mh * 2 + m2) * 16) * DM + col0;
#pragma unroll
                    for (int bj = 0; bj < 2; ++bj)
#pragma unroll
                        for (int n = 0; n < 2; ++n) bs[m2][bj][n] = *(const f32x4*)(base + off + bj * HALF + n * 16); }
#pragma unroll
                for (int m2 = 0; m2 < 2; ++m2) { const size_t off = (size_t)(row0 + ai * HALF + (mh * 2 + m2) * 16) * DM + col0;
#pragma unroll
                    for (int bj = 0; bj < 2; ++bj)
#pragma unroll
                        for (int n = 0; n < 2; ++n) *(f32x4*)(out + off + bj * HALF + n * 16) = bs[m2][bj][n] + gv[bj][n] * acc[ai][bj][mh * 2 + m2][n]; }
            }
    }
};

template <bool BASE16>
struct EpiResNorm {
    static constexpr bool PERM = true, AFTER_DRAIN = true;
    const void* base_l; void* out_l; const float* gate;
    const float* ng; const float* nsh; const float* nsc;
    bf16_t* hn; float* xbuf; unsigned* cnt;
    __device__ __forceinline__ void fused(f32x4 (&acc)[2][2][4][2], const Unit& u, int wr, int wc, int fr, int fq, LAS unsigned char* lds, int wid, int lane) const {
        const int pl = u.pm - 4, bi = pl >> 4;
        const float* base = (const float*)base_l + (size_t)pl * BM * DM; const bf16_t* base16 = (const bf16_t*)base_l + (size_t)pl * BM * DM;
        float* out = (float*)out_l + (size_t)pl * BM * DM; bf16_t* out16 = (bf16_t*)out_l + (size_t)pl * BM * DM;
        const int row0 = wr * 64 + fr, col0 = u.pn * BM + wc * 32 + 8 * fq;
        LAS float* P = (LAS float*)lds;
        LAS float* S = (LAS float*)(lds + 4096);
        f32x4 gv[2][2];
#pragma unroll
        for (int bj = 0; bj < 2; ++bj)
#pragma unroll
            for (int n = 0; n < 2; ++n) gv[bj][n] = *(const f32x4*)(gate + (size_t)bi * 6144 + col0 + bj * HALF + n * 4);
#pragma unroll
        for (int ai = 0; ai < 2; ++ai)
#pragma unroll
            for (int mh = 0; mh < 2; ++mh) {
                f32x4 bs[2][2][2];
#pragma unroll
                for (int m2 = 0; m2 < 2; ++m2) { const size_t off = (size_t)(row0 + ai * HALF + (mh * 2 + m2) * 16) * DM + col0;
#pragma unroll
                    for (int bj = 0; bj < 2; ++bj)
#pragma unroll
                        for (int n = 0; n < 2; ++n) {
                            if (BASE16) { const u32x2 w = *(const u32x2*)(base16 + off + bj * HALF + n * 4); bs[m2][bj][n] = (f32x4){bflo(w.x), bfhi(w.x), bflo(w.y), bfhi(w.y)}; }
                            else bs[m2][bj][n] = *(const f32x4*)(base + off + bj * HALF + n * 4); } }
#pragma unroll
                for (int m2 = 0; m2 < 2; ++m2) { const int m = mh * 2 + m2; const size_t off = (size_t)(row0 + ai * HALF + m * 16) * DM + col0;
                    float sq = 0.f;
#pragma unroll
                    for (int bj = 0; bj < 2; ++bj)
#pragma unroll
                        for (int n = 0; n < 2; ++n) { const f32x4 x = bs[m2][bj][n] + gv[bj][n] * acc[ai][bj][m][n]; acc[ai][bj][m][n] = x;
                            if (hn) { u32x2 w; w.x = pk2(x[0], x[1]); w.y = pk2(x[2], x[3]); *(u32x2*)(out16 + off + bj * HALF + n * 4) = w; }
                            sq += (x[0] * x[0] + x[1] * x[1]) + (x[2] * x[2] + x[3] * x[3]); }
                    sq += __shfl_xor(sq, 16); sq += __shfl_xor(sq, 32);
                    if (fq == 0) P[(ai * HALF + wr * 64 + m * 16 + fr) * 4 + wc] = sq; }
            }
        f32x4 ngv[2][2], shv[2][2];
#pragma unroll
        for (int bj = 0; bj < 2; ++bj)
#pragma unroll
            for (int n = 0; n < 2; ++n) { const int c = col0 + bj * HALF + n * 4; ngv[bj][n] = *(const f32x4*)(ng + c);
                if (nsh) { shv[bj][n] = *(const f32x4*)(nsh + (size_t)bi * 6144 + c); ngv[bj][n] = ngv[bj][n] * (*(const f32x4*)(nsc + (size_t)bi * 6144 + c) + 1.0f); }
                else shv[bj][n] = (f32x4){0.f, 0.f, 0.f, 0.f}; }
        asm volatile("s_waitcnt lgkmcnt(0)" ::: "memory"); __builtin_amdgcn_s_barrier(); asm volatile("" ::: "memory");
        const int row = wid * 32 + (lane & 31);
        if (lane < 32) { const float t = (P[row * 4 + 0] + P[row * 4 + 1]) + (P[row * 4 + 2] + P[row * 4 + 3]);
            __hip_atomic_store(xbuf + ((size_t)(pl * BM + row) * 4 + u.pn), t, __ATOMIC_RELAXED, __HIP_MEMORY_SCOPE_AGENT); }
        asm volatile("s_waitcnt vmcnt(0)" ::: "memory");
        if (lane == 0) __hip_atomic_fetch_add(cnt + 64 * pl, 1u, __ATOMIC_RELAXED, __HIP_MEMORY_SCOPE_AGENT);
        if (wid == 0) {
            unsigned sp = 0;
            while ((unsigned)__builtin_amdgcn_readfirstlane(__hip_atomic_load(cnt + 64 * pl, __ATOMIC_RELAXED, __HIP_MEMORY_SCOPE_AGENT)) < 32u) { __builtin_amdgcn_s_sleep(2); if (++sp > (1u << 22)) break; }
            __builtin_amdgcn_fence(__ATOMIC_ACQUIRE, "agent");
        }
        asm volatile("s_waitcnt vmcnt(0) lgkmcnt(0)" ::: "memory"); __builtin_amdgcn_s_barrier(); asm volatile("" ::: "memory");
        if (lane < 32) { const float* sl = xbuf + (size_t)(pl * BM + row) * 4; float ss = 0.f;
#pragma unroll
            for (int t = 0; t < 4; ++t) ss += __hip_atomic_load(sl + t, __ATOMIC_RELAXED, __HIP_MEMORY_SCOPE_AGENT);
            S[row] = rsqrtf(ss * (1.0f / DM) + EPS); }
        asm volatile("s_waitcnt lgkmcnt(0)" ::: "memory"); __builtin_amdgcn_s_barrier(); asm volatile("" ::: "memory");
#pragma unroll
        for (int ai = 0; ai < 2; ++ai)
#pragma unroll
            for (int m = 0; m < 4; ++m) { const int r = ai * HALF + wr * 64 + m * 16 + fr; const float rs = S[r];
#pragma unroll
                for (int bj = 0; bj < 2; ++bj)
#pragma unroll
                    for (int n = 0; n < 2; ++n) { const f32x4 y = acc[ai][bj][m][n] * rs * ngv[bj][n] + shv[bj][n]; const int c = col0 + bj * HALF + n * 4;
                        if (hn) { u32x2 w; w.x = pk2(y[0], y[1]); w.y = pk2(y[2], y[3]); *(u32x2*)(hn + (size_t)(u.pm * BM + r) * DM + c) = w; }
                        else *(f32x4*)(out + (size_t)r * DM + c) = y; } }
        asm volatile("s_waitcnt lgkmcnt(0)" ::: "memory"); __builtin_amdgcn_s_barrier(); asm volatile("" ::: "memory");
    }
};
struct SliceOrder {
    int ns, nu, G, c;
    __device__ void init(int ns_, int G_, int c_) { ns = ns_; nu = 16 * ns_; G = G_; c = G_ - 1 - c_; }
    __device__ bool next(int i, Unit& u) const {
        const int L = i * G + c; if (L >= nu) return false;
        const int t = L / ns, sl = L % ns; u.pm = t >> 2; u.pn = t & 3; u.k0 = sl * 256; return true;
    }
};
struct EpiPartial {
    static constexpr bool PERM = false, AFTER_DRAIN = false;
    float* p0; float* p1; int split;
    __device__ __forceinline__ void operator()(const f32x4 (&acc)[2][2][4][2], const Unit& u, int wr, int wc, int fr, int fq) const {
        const int sl = u.k0 >> 8;
        float* out = ((sl < split) ? p0 + (size_t)sl * MC * DM : p1 + (size_t)(sl - split) * MC * DM) + (size_t)u.pm * BM * DM;
        const int row0 = wr * 64 + fr, col0 = u.pn * BM + wc * 32 + 4 * fq;
#pragma unroll
        for (int ai = 0; ai < 2; ++ai)
#pragma unroll
            for (int m = 0; m < 4; ++m) { const size_t off = (size_t)(row0 + ai * HALF + m * 16) * DM + col0;
#pragma unroll
                for (int bj = 0; bj < 2; ++bj)
#pragma unroll
                    for (int n = 0; n < 2; ++n) *(f32x4*)(out + off + bj * HALF + n * 16) = acc[ai][bj][m][n]; }
    }
};

template <int LD, int KLEN, bool ALIGN_EPI, class Epi, class Sched>
__device__ __forceinline__ void gemm_phase(LAS unsigned char* lds, const Gemm g, const Sched& S, const Epi& E) {
    const int tid = fresh_tid(), wid = __builtin_amdgcn_readfirstlane(tid >> 6), lane = tid & 63, wr = wid >> 2, wc = wid & 3, fr = lane & 15, fq = lane >> 4;
    constexpr int nt = KLEN / BK;
    unsigned voffA[2], voffB[2];
#pragma unroll
    for (int i = 0; i < 2; ++i) { int R, C; stage_rc(tid * 16 + i * 8192, R, C); const int Rb = Epi::PERM ? ((R & ~31) + perm32(R & 31)) : R;
        voffA[i] = (unsigned)(R * LD + C) * 2u; voffB[i] = (unsigned)(Rb * LD + C) * 2u; }
    const size_t kstep = (size_t)(BK * 2);
    constexpr size_t hstepA = (size_t)HALF * LD * 2, hstepB = hstepA;
    constexpr size_t tstepA = 2 * hstepA, tstepB = tstepA;
    const unsigned ldsw = (unsigned)wid * 1024u;
    const int aoff = lds_byte(wr * 64 + fr, fq * 8), boff = lds_byte(wc * 32 + fr, fq * 8);
#define PG8_SA(b, h) (((b) * 2 + (h)) * HTB)
#define PG8_SB(b, h) ((4 + (b) * 2 + (h)) * HTB)
#define PG8_STAGE(bufoff, gbase, voff) do { _Pragma("unroll") for (int _i = 0; _i < 2; ++_i) \
        __builtin_amdgcn_global_load_lds((const unsigned*)((const char*)(gbase) + (voff)[_i]), (LAS unsigned*)(lds + (bufoff) + ldsw + _i * 8192), 16, 0, 0); } while (0)
#define PG8_LDA(dst, b, h) do { _Pragma("unroll") for (int m = 0; m < 4; ++m) _Pragma("unroll") for (int k = 0; k < 2; ++k) dst[m][k] = *(const LAS bf16x8*)(lds + PG8_SA(b, h) + aoff + m * 2048 + k * 1024); } while (0)
#define PG8_LDB(dst, b, h) do { _Pragma("unroll") for (int n = 0; n < 2; ++n) _Pragma("unroll") for (int k = 0; k < 2; ++k) dst[n][k] = *(const LAS bf16x8*)(lds + PG8_SB(b, h) + boff + n * 2048 + k * 1024); } while (0)
#define PG8_MMA(ai, bj, At, Bt) do { __builtin_amdgcn_s_setprio(1); _Pragma("unroll") for (int m = 0; m < 4; ++m) _Pragma("unroll") for (int n = 0; n < 2; ++n) _Pragma("unroll") for (int k = 0; k < 2; ++k) \
        acc[ai][bj][m][n] = __builtin_amdgcn_mfma_f32_16x16x32_bf16(Bt[n][k], At[m][k], acc[ai][bj][m][n], 0, 0, 0); __builtin_amdgcn_s_setprio(0); } while (0)
#define PG8_WAIT_V(n) asm volatile("s_waitcnt vmcnt(" #n ")" ::: "memory")
#define PG8_WAIT_L(n) asm volatile("s_waitcnt lgkmcnt(" #n ")" ::: "memory")
#define PG8_BAR __builtin_amdgcn_s_barrier()
#define PG8_SCHED __builtin_amdgcn_sched_barrier(0)
    Unit cur, nxt; int ui = 0;
    if (!S.next(0, cur)) return;
    f32x4 acc[2][2][4][2];
#pragma unroll
    for (int a = 0; a < 2; ++a)
#pragma unroll
        for (int b = 0; b < 2; ++b)
#pragma unroll
            for (int m = 0; m < 4; ++m)
#pragma unroll
                for (int n = 0; n < 2; ++n) acc[a][b][m][n] = (f32x4){0.f, 0.f, 0.f, 0.f};
    bf16x8 At[4][2], B0[2][2], B1[2][2];
    const char* cA = (const char*)g.A + (size_t)cur.pm * tstepA + (size_t)cur.k0 * 2; const char* cB = (const char*)g.Bt + (size_t)cur.pn * tstepB + (size_t)cur.k0 * 2;
    PG8_STAGE(PG8_SB(0, 0), cB, voffB); PG8_STAGE(PG8_SB(0, 1), cB + hstepB, voffB); PG8_STAGE(PG8_SA(0, 0), cA, voffA); PG8_STAGE(PG8_SA(0, 1), cA + hstepA, voffA);
    if (wr == 1) PG8_BAR;
    PG8_WAIT_V(2); PG8_BAR;
    PG8_STAGE(PG8_SB(1, 0), cB + kstep, voffB); PG8_STAGE(PG8_SA(1, 0), cA + kstep, voffA); PG8_STAGE(PG8_SB(1, 1), cB + hstepB + kstep, voffB);
    PG8_WAIT_V(6); PG8_BAR;
    for (;;) {
        const bool has_next = S.next(ui + 1, nxt);
        const char* nA = has_next ? (const char*)g.A + (size_t)nxt.pm * tstepA + (size_t)nxt.k0 * 2 : cA; const char* nB = has_next ? (const char*)g.Bt + (size_t)nxt.pn * tstepB + (size_t)nxt.k0 * 2 : cB;
#pragma unroll 1
        for (int t = 0; t < nt; t += 2) {
            const bool last = (t == nt - 2);
            const char* a1 = cA + (size_t)(t + 1) * kstep;
            const char* a2 = last ? nA : cA + (size_t)(t + 2) * kstep; const char* b2 = last ? nB : cB + (size_t)(t + 2) * kstep;
            const char* a3 = a2 + kstep; const char* b3 = b2 + kstep;
            PG8_LDB(B0, 0, 0); PG8_LDB(B1, 0, 1); PG8_SCHED; PG8_LDA(At, 0, 0); PG8_STAGE(PG8_SA(1, 1), a1 + hstepA, voffA);
            PG8_WAIT_V(8); PG8_WAIT_L(0); PG8_BAR; PG8_MMA(0, 0, At, B0); PG8_MMA(0, 1, At, B1); PG8_BAR; PG8_SCHED;
            PG8_LDA(At, 0, 1); PG8_STAGE(PG8_SB(0, 0), b2, voffB); PG8_STAGE(PG8_SB(0, 1), b2 + hstepB, voffB); PG8_STAGE(PG8_SA(0, 0), a2, voffA);
            PG8_WAIT_V(8); PG8_WAIT_L(0); PG8_BAR; PG8_MMA(1, 0, At, B0); PG8_MMA(1, 1, At, B1); PG8_BAR; PG8_SCHED;
            PG8_LDB(B0, 1, 0); PG8_LDB(B1, 1, 1); PG8_SCHED; PG8_LDA(At, 1, 0); PG8_STAGE(PG8_SA(0, 1), a2 + hstepA, voffA);
            PG8_WAIT_V(8); PG8_WAIT_L(0); PG8_BAR; PG8_MMA(0, 0, At, B0); PG8_MMA(0, 1, At, B1); PG8_BAR; PG8_SCHED;
            PG8_LDA(At, 1, 1); PG8_STAGE(PG8_SB(1, 0), b3, voffB); PG8_STAGE(PG8_SB(1, 1), b3 + hstepB, voffB); PG8_STAGE(PG8_SA(1, 0), a3, voffA);
            PG8_WAIT_V(8); PG8_WAIT_L(0); PG8_BAR; PG8_MMA(1, 0, At, B0); PG8_MMA(1, 1, At, B1); PG8_BAR; PG8_SCHED;
        }
        if constexpr (ALIGN_EPI) { if (wr == 0) PG8_BAR; }
        if constexpr (!Epi::AFTER_DRAIN) E(acc, cur, wr, wc, fr, fq);
        if (!has_next) break;
#pragma unroll
        for (int a = 0; a < 2; ++a)
#pragma unroll
            for (int b = 0; b < 2; ++b)
#pragma unroll
                for (int m = 0; m < 4; ++m)
#pragma unroll
                    for (int n = 0; n < 2; ++n) acc[a][b][m][n] = (f32x4){0.f, 0.f, 0.f, 0.f};
        cur = nxt; cA = nA; cB = nB; ++ui;
        if constexpr (ALIGN_EPI) { if (wr == 1) PG8_BAR; }
    }
    PG8_WAIT_V(0);
    if constexpr (!ALIGN_EPI) { if (wr == 0) PG8_BAR; }
    PG8_BAR;
    if constexpr (Epi::AFTER_DRAIN) E.fused(acc, cur, wr, wc, fr, fq, lds, wid, lane);
#undef PG8_SA
#undef PG8_SB
#undef PG8_STAGE
#undef PG8_LDA
#undef PG8_LDB
#undef PG8_MMA
#undef PG8_WAIT_V
#undef PG8_WAIT_L
#undef PG8_BAR
#undef PG8_SCHED
}
}

struct Args {
    const float* in[25];
    float* out;
    unsigned char* ws;
};

struct Ctx {
    LAS unsigned char* lds;
    int G, bid;
};


__device__ __forceinline__ void transpose_item(const float* W, int K, int N, int k0, int nsrc0, bf16_t* WT, int ndst0, LAS float* scr, int lane) {
#pragma unroll
    for (int i = 0; i < 32; ++i) { const int kk = 2 * i + (lane >> 5); scr[kk * 33 + (lane & 31)] = W[(size_t)(k0 + kk) * N + nsrc0 + (lane & 31)]; }
    LDS_WAIT();
    const int c = lane & 7;
#pragma unroll
    for (int j = 0; j < 4; ++j) { const int n = (lane >> 3) + 8 * j; const LAS float* s = scr + (8 * c) * 33 + n;
        u32x4 o; o.x = pk2(s[0 * 33], s[1 * 33]); o.y = pk2(s[2 * 33], s[3 * 33]); o.z = pk2(s[4 * 33], s[5 * 33]); o.w = pk2(s[6 * 33], s[7 * 33]);
        *(u32x4*)(WT + (size_t)(ndst0 + n) * K + k0 + 8 * c) = o; }
    LDS_WAIT();
}

__device__ __forceinline__ void phase_p0(const Ctx& C, const Args& a) {
    PHASE_IDS();
    {
        LAS float* sc = (LAS float*)(C.lds);
        LAS float* red = (LAS float*)(C.lds + 20480);
        float* MOD = (float*)(a.ws + WS_MOD);
        for (int idx = tid; idx < 5 * 1024; idx += NTHR) { const int bi = idx >> 10, k = idx & 1023; const float v = bi < 4 ? a.in[1][bi * 1024 + k] : a.in[3][k]; sc[idx] = siluf_(v); }
        __syncthreads();
        for (int u = C.bid; u < 192; u += C.G) {
            const int l = u / 96, cb = u % 96, col = cb * 64 + lane;
            const float* W = a.in[4] + ((size_t)l * 1024 + wid * 128) * 6144 + col;
            float acc[5] = {0.f, 0.f, 0.f, 0.f, 0.f};
#pragma unroll 32
            for (int kk = 0; kk < 128; ++kk) { const float w = W[(size_t)kk * 6144]; const int k = wid * 128 + kk;
#pragma unroll
                for (int bi = 0; bi < 5; ++bi) acc[bi] += sc[bi * 1024 + k] * w; }
#pragma unroll
            for (int bi = 0; bi < 5; ++bi) red[(wid * 5 + bi) * 64 + lane] = acc[bi];
            __syncthreads();
            if (tid < 320) { const int bi = tid >> 6, ln = tid & 63; float s = a.in[5][l * 6144 + cb * 64 + ln];
#pragma unroll
                for (int w = 0; w < 8; ++w) s += red[(w * 5 + bi) * 64 + ln];
                MOD[((size_t)l * 5 + bi) * 6144 + cb * 64 + ln] = s; }
            __syncthreads();
        }
    }
    {
        LAS float* scr = (LAS float*)(C.lds + wid * 8448);
        const int gw = C.bid * 8 + wid, NGW = C.G * 8;
        constexpr int I_IN = 16 * 112, I_OUT = 16 * 32, I_13 = 16 * 176, I_2 = 44 * 32, I_PW = 4 * 8, I_L = I_IN + I_OUT + I_13 + I_2 + I_PW;
        for (int it = gw; it < 2 * I_L; it += NGW) {
            const int l = it / I_L; int r = it % I_L;
            unsigned char* wt = a.ws + WS_WT + (size_t)l * WT_LAYER;
            if (r < I_IN) { const int kb = r / 112, nb = r % 112; transpose_item(a.in[7] + (size_t)l * DM * INC, DM, INC, kb * 64, nb * 32, (bf16_t*)(wt + WT_IN), nb * 32, scr, lane); continue; } r -= I_IN;
            if (r < I_OUT) { const int kb = r / 32, nb = r % 32; transpose_item(a.in[20] + (size_t)l * DM * DM, DM, DM, kb * 64, nb * 32, (bf16_t*)(wt + WT_OUT), nb * 32, scr, lane); continue; } r -= I_OUT;
            if (r < I_13) { const int kb = r / 176, nb = r % 176; const int nd = nb * 32, pn = nd >> 8, bj = (nd >> 7) & 1, j = nd & 127;
                transpose_item(a.in[22] + (size_t)l * DM * 2 * DFF, DM, 2 * DFF, kb * 64, bj * DFF + pn * 128 + j, (bf16_t*)(wt + WT_13), nd, scr, lane); continue; } r -= I_13;
            if (r < I_2) { const int kb = r / 32, nb = r % 32; transpose_item(a.in[23] + (size_t)l * DFF * DM, DFF, DM, kb * 64, nb * 32, (bf16_t*)(wt + WT_2), nb * 32, scr, lane); continue; } r -= I_2;
            { const int kb = r / 8, nb = r % 8; transpose_item(a.in[18] + (size_t)l * 256 * 256, 256, 256, kb * 64, nb * 32, (bf16_t*)(wt + WT_PW), nb * 32, scr, lane); }
        }
    }
}

__device__ __forceinline__ void norm_row_load(const float* srcc, const float* srcl, const float* mod_l, int shift_idx, int scale_idx, int r, int lane, f32x4 (&v)[4], f32x4 (&shv)[4], f32x4 (&scv)[4]) {
    const float* xr = (r < MC) ? srcc + (size_t)r * DM : srcl + (size_t)(r - MC) * DM;
    const int bi = (r < MC) ? 4 : ((r - MC) >> 12);
    const float* sh = mod_l + (size_t)bi * 6144 + shift_idx * 1024; const float* sc = mod_l + (size_t)bi * 6144 + scale_idx * 1024;
#pragma unroll
    for (int j = 0; j < 4; ++j) { v[j] = *(const f32x4*)(xr + 4 * lane + 256 * j); shv[j] = *(const f32x4*)(sh + 4 * lane + 256 * j); scv[j] = *(const f32x4*)(sc + 4 * lane + 256 * j); }
}
__device__ __forceinline__ void norm_row_store(bf16_t* dst, int r, int lane, const f32x4 (&v)[4], const f32x4 (&shv)[4], const f32x4 (&scv)[4], const f32x4 (&gv)[4], float rs) {
#pragma unroll
    for (int j = 0; j < 4; ++j) { const f32x4 y = v[j] * rs * gv[j] * (scv[j] + 1.0f) + shv[j];
        u32x2 w; w.x = pk2(y[0], y[1]); w.y = pk2(y[2], y[3]);
        *(u32x2*)(dst + (size_t)r * DM + 4 * lane + 256 * j) = w; }
}
__device__ __forceinline__ float sumsq4(const f32x4 (&v)[4]) { float s = 0.f;
#pragma unroll
    for (int j = 0; j < 4; ++j) s += (v[j][0] * v[j][0] + v[j][1] * v[j][1]) + (v[j][2] * v[j][2] + v[j][3] * v[j][3]);
    return s; }
struct CtxFix { const float* p0; const float* p1; int split, ns; const float* gate; float* xc_out; };
__device__ __forceinline__ void phase_norm(const Ctx& C, const float* srcc, const float* srcl, const float* g, const float* mod_l  , int shift_idx, int scale_idx, bf16_t* dst, int r_lo, int r_hi, const CtxFix fx) {
    PHASE_IDS();
    const int gw = C.bid * 8 + wid, NGW = C.G * 8;
    f32x4 gv[4];
#pragma unroll
    for (int j = 0; j < 4; ++j) gv[j] = *(const f32x4*)(g + 4 * lane + 256 * j);
    for (int r = r_lo + gw; r < r_hi; r += 2 * NGW) {
        const int r2 = r + NGW; const bool two = r2 < r_hi;
        f32x4 v0[4], sh0[4], sc0[4], v1[4], sh1[4], sc1[4];
        norm_row_load(srcc, srcl, mod_l, shift_idx, scale_idx, r, lane, v0, sh0, sc0);
        if (two) norm_row_load(srcc, srcl, mod_l, shift_idx, scale_idx, r2, lane, v1, sh1, sc1);
        if (r < MC && fx.ns > 0) {
            f32x4 ps[4];
#pragma unroll
            for (int j = 0; j < 4; ++j) ps[j] = (f32x4){0.f, 0.f, 0.f, 0.f};
            for (int s0 = 0; s0 < fx.ns; s0 += 4) {
                f32x4 pl[4][4];
#pragma unroll
                for (int q = 0; q < 4; ++q) { const int sl = (s0 + q < fx.ns) ? s0 + q : s0;
                    const float* pr = ((sl < fx.split) ? fx.p0 + (size_t)sl * MC * DM : fx.p1 + (size_t)(sl - fx.split) * MC * DM) + (size_t)r * DM;
#pragma unroll
                    for (int j = 0; j < 4; ++j) pl[q][j] = *(const f32x4*)(pr + 4 * lane + 256 * j); }
#pragma unroll
                for (int q = 0; q < 4; ++q) if (s0 + q < fx.ns) {
#pragma unroll
                    for (int j = 0; j < 4; ++j) ps[j] += pl[q][j]; }
            }
#pragma unroll
            for (int j = 0; j < 4; ++j) { v0[j] += *(const f32x4*)(fx.gate + 4 * lane + 256 * j) * ps[j];
                if (fx.xc_out) *(f32x4*)(fx.xc_out + (size_t)r * DM + 4 * lane + 256 * j) = v0[j]; }
        }
        float s0 = sumsq4(v0), s1 = two ? sumsq4(v1) : 0.f;
#pragma unroll
        for (int o = 1; o < 64; o <<= 1) { s0 += __shfl_xor(s0, o); s1 += __shfl_xor(s1, o); }
        norm_row_store(dst, r, lane, v0, sh0, sc0, gv, rsqrtf(s0 * (1.0f / DM) + EPS));
        if (two) norm_row_store(dst, r2, lane, v1, sh1, sc1, gv, rsqrtf(s1 * (1.0f / DM) + EPS));
    }
}
__device__ __forceinline__ void phase_final(const Ctx& C, float* out, const float* g) {
    PHASE_IDS();
    const int gw = C.bid * 8 + wid, NGW = C.G * 8;
    f32x4 gv[4];
#pragma unroll
    for (int j = 0; j < 4; ++j) gv[j] = *(const f32x4*)(g + 4 * lane + 256 * j);
    for (int r = gw; r < ML; r += 2 * NGW) {
        float* x0 = out + (size_t)r * DM; float* x1 = out + (size_t)(r + NGW) * DM;
        f32x4 v0[4], v1[4];
#pragma unroll
        for (int j = 0; j < 4; ++j) { v0[j] = *(const f32x4*)(x0 + 4 * lane + 256 * j); v1[j] = *(const f32x4*)(x1 + 4 * lane + 256 * j); }
        float s0 = sumsq4(v0), s1 = sumsq4(v1);
#pragma unroll
        for (int o = 1; o < 64; o <<= 1) { s0 += __shfl_xor(s0, o); s1 += __shfl_xor(s1, o); }
        const float r0s = rsqrtf(s0 * (1.0f / DM) + EPS), r1s = rsqrtf(s1 * (1.0f / DM) + EPS);
#pragma unroll
        for (int j = 0; j < 4; ++j) { *(f32x4*)(x0 + 4 * lane + 256 * j) = v0[j] * r0s * gv[j]; *(f32x4*)(x1 + 4 * lane + 256 * j) = v1[j] * r1s * gv[j]; }
    }
}

constexpr int SC_QT = 0, SC_QS = 17408, SC_KT = 34816, SC_KDT = 52224, SC_VT = 70656, SC_ST = 89088, SC_P = 123904, SC_SEG = 133120, SC_DK = 135168;
template <int PASS, bool L0>
__device__ __forceinline__ void scan_unit(const Ctx& C, int tid, bf16_t* px, float* US, float* DEC, const float* lbl, int layer, int seq, int sc) {
    const int dir = seq & 1, h = (seq >> 1) & 3, b = seq >> 3;
    const int lane = tid & 63, wid = __builtin_amdgcn_readfirstlane(tid >> 6), fr = lane & 15, fq = lane >> 4;
    LAS bf16_t* QT = (LAS bf16_t*)(C.lds + SC_QT);
    LAS bf16_t* QS = (LAS bf16_t*)(C.lds + SC_QS);
    LAS bf16_t* KT = (LAS bf16_t*)(C.lds + SC_KT);
    LAS bf16_t* KDT = (LAS bf16_t*)(C.lds + SC_KDT);
    LAS bf16_t* VT = (LAS bf16_t*)(C.lds + SC_VT);
    LAS bf16_t* ST = (LAS bf16_t*)(C.lds + SC_ST);
    LAS bf16_t* P = (LAS bf16_t*)(C.lds + SC_P);
    LAS float* SEG = (LAS float*)(C.lds + SC_SEG);
    LAS float* DK = (LAS float*)(C.lds + SC_DK);
    const int k = tid & 127, sg = tid >> 7;
    float lb = 0.f;
    if (!L0) { const float l0 = lbl[(0 * 2 + dir) * 512 + h * 128 + k], l1 = lbl[(1 * 2 + dir) * 512 + h * 128 + k]; lb = sigmoidf_(l1 - l0); }
    const float omlb = 1.0f - lb;
    const int zcol = (dir ? 1024 : 512) + h * 128;
    const unsigned zo = (unsigned)(zcol - h * 128);

    unsigned pz[16], pq[16], pv[16];
    {
        const int p00 = sc * 256;
        const int rb0 = (p00 < 256) ? (b * 256 + (dir ? 255 - p00 : p00)) : (MC + b * 4096 + (dir ? 4095 - (p00 - 256) : (p00 - 256)));
        const int rs0 = dir ? -1 : 1;
#pragma unroll
        for (int i = 0; i < 16; ++i) { const unsigned idx = (unsigned)((rb0 + rs0 * (sg * 16 + i)) * INC + h * 128 + k);
            pz[i] = px[idx + zo]; pq[i] = px[idx]; pv[i] = px[idx + 1536]; }
    }
    f32x4 accS[8];
    if (PASS == 1 || sc == 0) {
#pragma unroll
        for (int vb = 0; vb < 8; ++vb) accS[vb] = (f32x4){0.f, 0.f, 0.f, 0.f};
    } else {
        const float* S0 = US + ((size_t)(seq * 16 + sc - 1) * 128) * 128;
#pragma unroll
        for (int vb = 0; vb < 8; ++vb)
#pragma unroll
            for (int j = 0; j < 4; ++j) accS[vb][j] = S0[(size_t)(wid * 16 + 4 * fq + j) * 128 + vb * 16 + fr];
    }
    if (PASS == 3) {
#pragma unroll
        for (int vb = 0; vb < 8; ++vb) { u32x2 w; w.x = pk2(accS[vb][0], accS[vb][1]); w.y = pk2(accS[vb][2], accS[vb][3]);
            *(LAS u32x2*)(ST + (vb * 16 + fr) * 136 + wid * 16 + 4 * fq) = w; }
    }
    float dtot[4] = {1.f, 1.f, 1.f, 1.f};

    for (int c = 0; c < 4; ++c) {
        const int p0 = sc * 256 + c * 64;
        const int rbase = (p0 < 256) ? (b * 256 + (dir ? 255 - p0 : p0)) : (MC + b * 4096 + (dir ? 4095 - (p0 - 256) : (p0 - 256)));
        const int rstep = dir ? -1 : 1;
        float cq[16], ck[16], cb[16]; bf16_t vv[16];
        float run = 0.f;
#pragma unroll
        for (int i = 0; i < 16; ++i) {
            const float zl = __uint_as_float(pz[i] << 16) * LOG2E;
            if (PASS == 3) cq[i] = __uint_as_float(pq[i] << 16);
            vv[i] = (bf16_t)pv[i];
            if (L0) { float ls, ln; logsig2(zl, ls, ln); ck[i] = ln; run += ls; }
            else {
                const float e = __builtin_amdgcn_exp2f(-fabsf(zl)); const float inv = __builtin_amdgcn_rcpf(1.0f + e); const float big = inv, small = e * inv;
                const float sig = zl >= 0.f ? big : small, nsig = zl >= 0.f ? small : big;
                ck[i] = omlb * nsig;
                run += __builtin_amdgcn_logf(fmaxf(lb + omlb * sig, 1e-30f));
            }
            cb[i] = run;
        }
        SEG[sg * 128 + k] = run;
        LBAR();
        const float s0 = SEG[k], s1 = SEG[128 + k], s2 = SEG[256 + k], s3 = SEG[384 + k];
        const float off = (sg > 0 ? s0 : 0.f) + (sg > 1 ? s1 : 0.f) + (sg > 2 ? s2 : 0.f);
        const float blast = (s0 + s1) + (s2 + s3), rr = 0.5f * blast, er = __builtin_amdgcn_exp2f(rr);
        if (sg == 0) DK[k] = er * er;
        unsigned kdp[8], vvp[8];
#pragma unroll
        for (int i = 0; i < 16; i += 2) {
            float kd2[2];
#pragma unroll
            for (int e = 0; e < 2; ++e) {
                const int ii = i + e; const int tau = sg * 16 + ii;
                const float d = rr - (off + cb[ii]);
                const float kt = L0 ? __builtin_amdgcn_exp2f(ck[ii] + d) : ck[ii] * __builtin_amdgcn_exp2f(d);
                kd2[e] = kt * er;
                if (PASS == 3) { const float qt = cq[ii] * __builtin_amdgcn_exp2f(-d); QT[tau * 136 + k] = f2bf(qt); QS[tau * 136 + k] = f2bf(qt * er); KT[tau * 136 + k] = f2bf(kt); }
            }
            kdp[i >> 1] = pk2(kd2[0], kd2[1]);
            vvp[i >> 1] = (unsigned)vv[i] | ((unsigned)vv[i + 1] << 16);
        }
        *(LAS u32x4*)(KDT + k * 72 + sg * 16) = (u32x4){kdp[0], kdp[1], kdp[2], kdp[3]};
        *(LAS u32x4*)(KDT + k * 72 + sg * 16 + 8) = (u32x4){kdp[4], kdp[5], kdp[6], kdp[7]};
        *(LAS u32x4*)(VT + k * 72 + sg * 16) = (u32x4){vvp[0], vvp[1], vvp[2], vvp[3]};
        *(LAS u32x4*)(VT + k * 72 + sg * 16 + 8) = (u32x4){vvp[4], vvp[5], vvp[6], vvp[7]};
        LBAR();
        if (c < 3) {
            const int rb2 = rbase + rstep * 64;
#pragma unroll
            for (int i = 0; i < 16; ++i) { const unsigned idx = (unsigned)((rb2 + rstep * (sg * 16 + i)) * INC + h * 128 + k);
                pz[i] = px[idx + zo]; pq[i] = px[idx]; pv[i] = px[idx + 1536]; }
        }

        if (PASS == 3) {
            f32x4 oacc[4];
#pragma unroll
            for (int tb = 0; tb < 4; ++tb) oacc[tb] = (f32x4){0.f, 0.f, 0.f, 0.f};
#pragma unroll
            for (int kp = 0; kp < 2; ++kp) {
                bf16x8 av[2], bq[2][4];
#pragma unroll
                for (int k2 = 0; k2 < 2; ++k2) { const int ks = kp * 2 + k2; av[k2] = *(const LAS bf16x8*)(ST + (wid * 16 + fr) * 136 + ks * 32 + fq * 8);
#pragma unroll
                    for (int tb = 0; tb < 4; ++tb) bq[k2][tb] = *(const LAS bf16x8*)(QS + (tb * 16 + fr) * 136 + ks * 32 + fq * 8); }
                asm volatile("" ::: "memory");
#pragma unroll
                for (int k2 = 0; k2 < 2; ++k2)
#pragma unroll
                    for (int tb = 0; tb < 4; ++tb) oacc[tb] = mfma16(av[k2], bq[k2][tb], oacc[tb]);
            }
#pragma unroll
            for (int e = 0; e < 2; ++e) { const int id = 2 * wid + e, sb = id >> 2, tb = id & 3;
                f32x4 sacc = (f32x4){0.f, 0.f, 0.f, 0.f};
                if (sb <= tb) {
                    bf16x8 av[4], bq[4];
#pragma unroll
                    for (int ks = 0; ks < 4; ++ks) { av[ks] = *(const LAS bf16x8*)(KT + (sb * 16 + fr) * 136 + ks * 32 + fq * 8); bq[ks] = *(const LAS bf16x8*)(QT + (tb * 16 + fr) * 136 + ks * 32 + fq * 8); }
                    asm volatile("" ::: "memory");
#pragma unroll
                    for (int ks = 0; ks < 4; ++ks) sacc = mfma16(av[ks], bq[ks], sacc); }
                const int t = tb * 16 + fr, s = sb * 16 + 4 * fq;
                float m[4];
#pragma unroll
                for (int j = 0; j < 4; ++j) m[j] = (s + j <= t) ? sacc[j] : 0.f;
                u32x2 w; w.x = pk2(m[0], m[1]); w.y = pk2(m[2], m[3]);
                *(LAS u32x2*)(P + t * 72 + s) = w; }
            LBAR();
            {
                bf16x8 av[2], bq[2][4];
#pragma unroll
                for (int ks = 0; ks < 2; ++ks) { av[ks] = *(const LAS bf16x8*)(VT + (wid * 16 + fr) * 72 + ks * 32 + fq * 8);
#pragma unroll
                    for (int tb = 0; tb < 4; ++tb) bq[ks][tb] = *(const LAS bf16x8*)(P + (tb * 16 + fr) * 72 + ks * 32 + fq * 8); }
                asm volatile("" ::: "memory");
#pragma unroll
                for (int ks = 0; ks < 2; ++ks)
#pragma unroll
                    for (int tb = 0; tb < 4; ++tb) oacc[tb] = mfma16(av[ks], bq[ks][tb], oacc[tb]);
            }
#pragma unroll
            for (int tb = 0; tb < 4; ++tb) { const int r = rbase + rstep * (tb * 16 + fr);
                u32x2 w; w.x = pk2(oacc[tb][0], oacc[tb][1]); w.y = pk2(oacc[tb][2], oacc[tb][3]);
                *(u32x2*)(px + (size_t)r * INC + zcol + wid * 16 + 4 * fq) = w; }
        }
        {
            float dk[4];
#pragma unroll
            for (int j = 0; j < 4; ++j) { dk[j] = DK[wid * 16 + 4 * fq + j]; dtot[j] *= dk[j]; }
#pragma unroll
            for (int vb = 0; vb < 8; ++vb)
#pragma unroll
                for (int j = 0; j < 4; ++j) accS[vb][j] *= dk[j];
#pragma unroll
            for (int ks = 0; ks < 2; ++ks) {
                bf16x8 bq[8]; const bf16x8 av = *(const LAS bf16x8*)(KDT + (wid * 16 + fr) * 72 + ks * 32 + fq * 8);
#pragma unroll
                for (int vb = 0; vb < 8; ++vb) bq[vb] = *(const LAS bf16x8*)(VT + (vb * 16 + fr) * 72 + ks * 32 + fq * 8);
                asm volatile("" ::: "memory");
#pragma unroll
                for (int vb = 0; vb < 8; ++vb) accS[vb] = mfma16(av, bq[vb], accS[vb]);
            }
            if (PASS == 3 && c < 3) {
#pragma unroll
                for (int vb = 0; vb < 8; ++vb) { u32x2 w; w.x = pk2(accS[vb][0], accS[vb][1]); w.y = pk2(accS[vb][2], accS[vb][3]);
                    *(LAS u32x2*)(ST + (vb * 16 + fr) * 136 + wid * 16 + 4 * fq) = w; }
            }
        }
        LBAR();
    }
    if (PASS == 1) {
        float* S1 = US + ((size_t)(seq * 16 + sc) * 128) * 128;
#pragma unroll
        for (int vb = 0; vb < 8; ++vb)
#pragma unroll
            for (int j = 0; j < 4; ++j) S1[(size_t)(wid * 16 + 4 * fq + j) * 128 + vb * 16 + fr] = accS[vb][j];
        if (fr == 0) {
#pragma unroll
            for (int j = 0; j < 4; ++j) DEC[(size_t)(seq * 17 + sc) * 128 + wid * 16 + 4 * fq + j] = dtot[j];
        }
    }
}

template <bool L0>
__device__ __forceinline__ void scan_pass1_unit(const Ctx& C, int tid, const bf16_t* px, float* US, float* DEC, const float* lbl, int layer, int seq, int sc) {
    const int dir = seq & 1, h = (seq >> 1) & 3, b = seq >> 3;
    const int lane = tid & 63, wid = __builtin_amdgcn_readfirstlane(tid >> 6), fr = lane & 15, fq = lane >> 4;
    LAS bf16_t* KDT = (LAS bf16_t*)(C.lds);
    LAS bf16_t* VT = (LAS bf16_t*)(C.lds + 67584);
    LAS float* DKc = (LAS float*)(C.lds + 135168);
    const int k = tid & 127, c = tid >> 7;
    float lb = 0.f;
    if (!L0) { const float l0 = lbl[(0 * 2 + dir) * 512 + h * 128 + k], l1 = lbl[(1 * 2 + dir) * 512 + h * 128 + k]; lb = sigmoidf_(l1 - l0); }
    const float omlb = 1.0f - lb;
    const int zcol = (dir ? 1024 : 512) + h * 128;
    const unsigned zo = (unsigned)(zcol - h * 128);
    const int p0 = sc * 256 + c * 64;
    const int rbase = (p0 < 256) ? (b * 256 + (dir ? 255 - p0 : p0)) : (MC + b * 4096 + (dir ? 4095 - (p0 - 256) : (p0 - 256)));
    const int rstep = dir ? -1 : 1;
    float R = 0.f;
    unsigned rz[16], rv[16];
#pragma unroll
    for (int i = 0; i < 16; ++i) { const unsigned idx = (unsigned)((rbase + rstep * (48 + i)) * INC + h * 128 + k); rz[i] = px[idx + zo]; rv[i] = px[idx + 1536]; }
#pragma unroll
    for (int p = 3; p >= 0; --p) {
        unsigned nz[16], nv[16];
        if (p > 0) {
#pragma unroll
            for (int i = 0; i < 16; ++i) { const unsigned idx = (unsigned)((rbase + rstep * ((p - 1) * 16 + i)) * INC + h * 128 + k); nz[i] = px[idx + zo]; nv[i] = px[idx + 1536]; }
        }
#pragma unroll
        for (int gh = 1; gh >= 0; --gh) {
            const int g = 2 * p + gh;
            float kd[8];
#pragma unroll
            for (int i = 7; i >= 0; --i) {
                const float zl = __uint_as_float(rz[gh * 8 + i] << 16) * LOG2E;
                if (L0) { float ls, ln; logsig2(zl, ls, ln); kd[i] = __builtin_amdgcn_exp2f(R + ln); R += ls; }
                else {
                    const float e = __builtin_amdgcn_exp2f(-fabsf(zl)); const float inv = __builtin_amdgcn_rcpf(1.0f + e); const float big = inv, small = e * inv;
                    const float sig = zl >= 0.f ? big : small, nsig = zl >= 0.f ? small : big;
                    kd[i] = omlb * nsig * __builtin_amdgcn_exp2f(R);
                    R += __builtin_amdgcn_logf(fmaxf(lb + omlb * sig, 1e-30f));
                }
            }
            *(LAS u32x4*)(KDT + k * 264 + c * 64 + g * 8) = (u32x4){pk2(kd[0], kd[1]), pk2(kd[2], kd[3]), pk2(kd[4], kd[5]), pk2(kd[6], kd[7])};
            const unsigned* v8 = rv + gh * 8;
            *(LAS u32x4*)(VT + k * 264 + c * 64 + g * 8) = (u32x4){v8[0] | (v8[1] << 16), v8[2] | (v8[3] << 16), v8[4] | (v8[5] << 16), v8[6] | (v8[7] << 16)};
        }
        if (p > 0) {
#pragma unroll
            for (int i = 0; i < 16; ++i) { rz[i] = nz[i]; rv[i] = nv[i]; }
        }
    }
    DKc[c * 128 + k] = __builtin_amdgcn_exp2f(R);
    __syncthreads();
    f32x4 accS[8];
#pragma unroll
    for (int vb = 0; vb < 8; ++vb) accS[vb] = (f32x4){0.f, 0.f, 0.f, 0.f};
    float dtot[4] = {1.f, 1.f, 1.f, 1.f};
#pragma unroll
    for (int cc = 0; cc < 4; ++cc) {
        float dk[4];
#pragma unroll
        for (int j = 0; j < 4; ++j) { dk[j] = DKc[cc * 128 + wid * 16 + 4 * fq + j]; dtot[j] *= dk[j]; }
        if (cc > 0) {
#pragma unroll
            for (int vb = 0; vb < 8; ++vb)
#pragma unroll
                for (int j = 0; j < 4; ++j) accS[vb][j] *= dk[j];
        }
#pragma unroll
        for (int ks = 0; ks < 2; ++ks) {
            bf16x8 bq[8]; const bf16x8 av = *(const LAS bf16x8*)(KDT + (wid * 16 + fr) * 264 + cc * 64 + ks * 32 + fq * 8);
#pragma unroll
            for (int vb = 0; vb < 8; ++vb) bq[vb] = *(const LAS bf16x8*)(VT + (vb * 16 + fr) * 264 + cc * 64 + ks * 32 + fq * 8);
            asm volatile("" ::: "memory");
#pragma unroll
            for (int vb = 0; vb < 8; ++vb) accS[vb] = mfma16(av, bq[vb], accS[vb]);
        }
    }
    float* S1 = US + ((size_t)(seq * 16 + sc) * 128) * 128;
#pragma unroll
    for (int vb = 0; vb < 8; ++vb)
#pragma unroll
        for (int j = 0; j < 4; ++j) S1[(size_t)(wid * 16 + 4 * fq + j) * 128 + vb * 16 + fr] = accS[vb][j];
    if (fr == 0) {
#pragma unroll
        for (int j = 0; j < 4; ++j) DEC[(size_t)(seq * 17 + sc) * 128 + wid * 16 + 4 * fq + j] = dtot[j];
    }
    __syncthreads();
}

__device__ __forceinline__ void phase_s2(const Ctx& C, float* US, const float* DEC) {
    PHASE_IDS();
    for (int idx = C.bid * NTHR + tid; idx < 32 * 4096; idx += C.G * NTHR) {
        const int seq = idx >> 12, kk = (idx & 4095) >> 5, v4 = idx & 31;
        float* p = US + ((size_t)(seq * 16) * 128 + kk) * 128 + v4 * 4;
        const float* dp = DEC + (size_t)(seq * 17) * 128 + kk;
        f32x4 U[16]; float d[16];
#pragma unroll
        for (int sc = 0; sc < 16; ++sc) { U[sc] = *(const f32x4*)(p + (size_t)sc * 16384); d[sc] = dp[sc * 128]; }
        f32x4 S = (f32x4){0.f, 0.f, 0.f, 0.f};
#pragma unroll
        for (int sc = 0; sc < 16; ++sc) { S = S * d[sc] + U[sc]; *(f32x4*)(p + (size_t)sc * 16384) = S; }
    }
}

__device__ __forceinline__ void gmlp_unit(const Ctx& C, int tid, const bf16_t* px, bf16_t* ycat, const float* w_s  , const float* b_s  , const float* ln_g, const float* ln_b, int cidx, int g) {
    LAS bf16_t* Wl = (LAS bf16_t*)(C.lds);
    LAS bf16_t* VnT = (LAS bf16_t*)(C.lds + 34816);
    const int r0 = cidx * 128, lane = tid & 63, wid = __builtin_amdgcn_readfirstlane(tid >> 6), fr = lane & 15, fq = lane >> 4;
    const float* W = w_s + (size_t)g * 128 * 128;
#pragma unroll
    for (int i = 0; i < 8; ++i) { const int f4 = tid + NTHR * i, t = f4 >> 5, s4 = (f4 & 31) * 4; const f32x4 v = *(const f32x4*)(W + t * 128 + s4);
        u32x2 w; w.x = pk2(v[0], v[1]); w.y = pk2(v[2], v[3]); *(LAS u32x2*)(Wl + t * 136 + s4) = w; }
    {
        const int s = tid >> 2, part = tid & 3, d0 = part * 16;
        const bf16_t* src = px + (size_t)(r0 + s) * INC + 2816 + g * 64 + d0;
        const u32x4 w0 = *(const u32x4*)src, w1 = *(const u32x4*)(src + 8);
        float x[16];
        x[0] = bflo(w0.x); x[1] = bfhi(w0.x); x[2] = bflo(w0.y); x[3] = bfhi(w0.y); x[4] = bflo(w0.z); x[5] = bfhi(w0.z); x[6] = bflo(w0.w); x[7] = bfhi(w0.w);
        x[8] = bflo(w1.x); x[9] = bfhi(w1.x); x[10] = bflo(w1.y); x[11] = bfhi(w1.y); x[12] = bflo(w1.z); x[13] = bfhi(w1.z); x[14] = bflo(w1.w); x[15] = bfhi(w1.w);
        float sm = 0.f;
#pragma unroll
        for (int i = 0; i < 16; ++i) { x[i] = gelu_tanh(x[i]); sm += x[i]; }
        sm += __shfl_xor(sm, 1); sm += __shfl_xor(sm, 2);
        const float mu = sm * (1.0f / 64.0f); float q = 0.f;
#pragma unroll
        for (int i = 0; i < 16; ++i) { x[i] -= mu; q += x[i] * x[i]; }
        q += __shfl_xor(q, 1); q += __shfl_xor(q, 2);
        const float rs = rsqrtf(q * (1.0f / 64.0f) + EPS);
#pragma unroll
        for (int i = 0; i < 16; ++i) { const int d = d0 + i; const float y = x[i] * rs * ln_g[g * 64 + d] + ln_b[g * 64 + d]; VnT[d * 136 + s] = f2bf(y); }
    }
    __syncthreads();
    f32x4 acc[4];
#pragma unroll
    for (int db = 0; db < 4; ++db) acc[db] = (f32x4){0.f, 0.f, 0.f, 0.f};
#pragma unroll
    for (int ks = 0; ks < 4; ++ks) { const bf16x8 bw = *(const LAS bf16x8*)(Wl + (wid * 16 + fr) * 136 + ks * 32 + fq * 8);
#pragma unroll
        for (int db = 0; db < 4; ++db) { const bf16x8 av = *(const LAS bf16x8*)(VnT + (db * 16 + fr) * 136 + ks * 32 + fq * 8); acc[db] = mfma16(av, bw, acc[db]); } }
    {
        const int t = wid * 16 + fr, r = r0 + t; const float bias = b_s[g * 128 + t];
        u32x2 uw[4];
#pragma unroll
        for (int db = 0; db < 4; ++db) uw[db] = *(const u32x2*)(px + (size_t)r * INC + 2560 + g * 64 + db * 16 + 4 * fq);
#pragma unroll
        for (int db = 0; db < 4; ++db) { const int col = g * 64 + db * 16 + 4 * fq;
            const float u0 = gelu_tanh(bflo(uw[db].x)), u1 = gelu_tanh(bfhi(uw[db].x)), u2 = gelu_tanh(bflo(uw[db].y)), u3 = gelu_tanh(bfhi(uw[db].y));
            u32x2 w; w.x = pk2(u0 * (acc[db][0] + bias), u1 * (acc[db][1] + bias)); w.y = pk2(u2 * (acc[db][2] + bias), u3 * (acc[db][3] + bias));
            *(u32x2*)(ycat + (size_t)r * DM + 512 + col) = w; }
    }
    __syncthreads();
}

__device__ __forceinline__ void conv_unit(const Ctx& C, int tid, const bf16_t* px, bf16_t* ycat, const float* dw_w  , const float* dw_b, const float* ln_g, const float* ln_b, const bf16_t* pwt  , const float* pw_b, int tix) {
    LAS float* Z = (LAS float*)(C.lds);
    LAS bf16_t* Hn = (LAS bf16_t*)(C.lds + 96256);
    LAS float* Wd = (LAS float*)(C.lds + 130048);
    const int r0 = tix * 64, lane = tid & 63, wid = __builtin_amdgcn_readfirstlane(tid >> 6), fr = lane & 15, fq = lane >> 4;
    const int seg_lo = (r0 < MC) ? (r0 & ~255) : r0, seg_hi = seg_lo + ((r0 < MC) ? 256 : 64);
    {
        f32x4 wv[4]; u32x4 aw[6], gw[6]; bool zin[6];
#pragma unroll
        for (int q = 0; q < 4; ++q) { const int it = tid + q * NTHR; wv[q] = (it < 31 * 64) ? *(const f32x4*)(dw_w + it * 4) : (f32x4){0.f, 0.f, 0.f, 0.f}; }
#pragma unroll
        for (int q = 0; q < 6; ++q) { const int it = tid + q * NTHR, zr = it >> 5, c8 = (it & 31) * 8, r = r0 - 15 + zr;
            zin[q] = (it < 94 * 32) && r >= seg_lo && r < seg_hi;
            const size_t ro = (size_t)(zin[q] ? r : r0) * INC;
            aw[q] = *(const u32x4*)(px + ro + 3072 + c8); gw[q] = *(const u32x4*)(px + ro + 3328 + c8); }
#pragma unroll
        for (int q = 0; q < 4; ++q) { const int it = tid + q * NTHR; if (it < 31 * 64) *(LAS f32x4*)(Wd + it * 4) = wv[q]; }
#pragma unroll
        for (int q = 0; q < 6; ++q) { const int it = tid + q * NTHR, zr = it >> 5, c8 = (it & 31) * 8;
            if (it < 94 * 32) {
                f32x4 z0 = (f32x4){0.f, 0.f, 0.f, 0.f}, z1 = z0;
                if (zin[q]) {
                    z0[0] = bflo(aw[q].x) * sigmoidf_(bflo(gw[q].x)); z0[1] = bfhi(aw[q].x) * sigmoidf_(bfhi(gw[q].x)); z0[2] = bflo(aw[q].y) * sigmoidf_(bflo(gw[q].y)); z0[3] = bfhi(aw[q].y) * sigmoidf_(bfhi(gw[q].y));
                    z1[0] = bflo(aw[q].z) * sigmoidf_(bflo(gw[q].z)); z1[1] = bfhi(aw[q].z) * sigmoidf_(bfhi(gw[q].z)); z1[2] = bflo(aw[q].w) * sigmoidf_(bflo(gw[q].w)); z1[3] = bfhi(aw[q].w) * sigmoidf_(bfhi(gw[q].w));
                }
                *(LAS f32x4*)(Z + zr * 256 + c8) = z0; *(LAS f32x4*)(Z + zr * 256 + c8 + 4) = z1;
            }
        }
    }
    __syncthreads();
    {
        const int t0 = wid * 8, c4 = lane * 4;
        f32x4 acc[8], win[8];
#pragma unroll
        for (int t = 0; t < 8; ++t) acc[t] = (f32x4){0.f, 0.f, 0.f, 0.f};
#pragma unroll
        for (int t = 0; t < 7; ++t) win[t] = *(const LAS f32x4*)(Z + (t0 + t) * 256 + c4);
#pragma unroll 1
        for (int j0 = 0; j0 < 32; j0 += 8) {
#pragma unroll
            for (int jj = 0; jj < 8; ++jj) {
                const int j = j0 + jj;
                if (j < 31) {
                    win[(jj + 7) & 7] = *(const LAS f32x4*)(Z + (t0 + j + 7) * 256 + c4);
                    const f32x4 wj = *(const LAS f32x4*)(Wd + j * 256 + c4);
#pragma unroll
                    for (int t = 0; t < 8; ++t) acc[t] += win[(t + jj) & 7] * wj;
                }
            }
        }
        const f32x4 bv = *(const f32x4*)(dw_b + c4), gv = *(const f32x4*)(ln_g + c4), bb = *(const f32x4*)(ln_b + c4);
#pragma unroll
        for (int t = 0; t < 8; ++t) {
            f32x4 x = acc[t] + bv;
            float sm = (x[0] + x[1]) + (x[2] + x[3]);
            sm += __shfl_xor(sm, 1); sm += __shfl_xor(sm, 2); sm += __shfl_xor(sm, 4); sm += __shfl_xor(sm, 8);
            const float mu = sm * (1.0f / 64.0f);
            x = x - mu;
            float q = (x[0] * x[0] + x[1] * x[1]) + (x[2] * x[2] + x[3] * x[3]);
            q += __shfl_xor(q, 1); q += __shfl_xor(q, 2); q += __shfl_xor(q, 4); q += __shfl_xor(q, 8);
            const float rs = rsqrtf(q * (1.0f / 64.0f) + EPS);
            const f32x4 y = x * rs * gv + bb;
            u32x2 w; w.x = pk2(siluf_(y[0]), siluf_(y[1])); w.y = pk2(siluf_(y[2]), siluf_(y[3]));
            *(LAS u32x2*)(Hn + (t0 + t) * 264 + c4) = w;
        }
    }
    __syncthreads();
    {
        f32x4 acc[2][4];
#pragma unroll
        for (int e = 0; e < 2; ++e)
#pragma unroll
            for (int tb = 0; tb < 4; ++tb) acc[e][tb] = (f32x4){0.f, 0.f, 0.f, 0.f};
#pragma unroll
        for (int ks = 0; ks < 8; ++ks) {
            bf16x8 bh[4];
#pragma unroll
            for (int tb = 0; tb < 4; ++tb) bh[tb] = *(const LAS bf16x8*)(Hn + (tb * 16 + fr) * 264 + ks * 32 + fq * 8);
#pragma unroll
            for (int e = 0; e < 2; ++e) { const bf16x8 aw = *(const bf16x8*)(pwt + (size_t)((2 * wid + e) * 16 + fr) * 256 + ks * 32 + fq * 8);
#pragma unroll
                for (int tb = 0; tb < 4; ++tb) acc[e][tb] = mfma16(aw, bh[tb], acc[e][tb]); }
        }
#pragma unroll
        for (int e = 0; e < 2; ++e) { const int o = (2 * wid + e) * 16 + 4 * fq; const f32x4 pb = *(const f32x4*)(pw_b + o);
#pragma unroll
            for (int tb = 0; tb < 4; ++tb) { const int r = r0 + tb * 16 + fr; const f32x4 y = acc[e][tb] + pb;
                u32x2 w; w.x = pk2(y[0], y[1]); w.y = pk2(y[2], y[3]);
                *(u32x2*)(ycat + (size_t)r * DM + 768 + o) = w; } }
    }
    __syncthreads();
}

__device__ __forceinline__ void phase_xa(const Ctx& C, const bf16_t* px, bf16_t* ycat, const float* onorm_g, int r_lo) {
    PHASE_IDS();
    const int gw = C.bid * 8 + wid, NGW = C.G * 8;
    const int col = 8 * lane;
    const f32x4 gn0 = *(const f32x4*)(onorm_g + col), gn1 = *(const f32x4*)(onorm_g + col + 4);
    for (int r = r_lo + gw; r < MT; r += 4 * NGW) {
        u32x4 wf[4], wb[4], wg[4]; bool ok[4];
#pragma unroll
        for (int q = 0; q < 4; ++q) { const int rq = r + q * NGW; ok[q] = rq < MT; const bf16_t* pr = px + (size_t)(ok[q] ? rq : r) * INC;
            wf[q] = *(const u32x4*)(pr + 512 + col); wb[q] = *(const u32x4*)(pr + 1024 + col); wg[q] = *(const u32x4*)(pr + 2048 + col); }
#pragma unroll
        for (int q = 0; q < 4; ++q) {
            float o[8];
            o[0] = bflo(wf[q].x) + bflo(wb[q].x); o[1] = bfhi(wf[q].x) + bfhi(wb[q].x); o[2] = bflo(wf[q].y) + bflo(wb[q].y); o[3] = bfhi(wf[q].y) + bfhi(wb[q].y);
            o[4] = bflo(wf[q].z) + bflo(wb[q].z); o[5] = bfhi(wf[q].z) + bfhi(wb[q].z); o[6] = bflo(wf[q].w) + bflo(wb[q].w); o[7] = bfhi(wf[q].w) + bfhi(wb[q].w);
            float ss = 0.f;
#pragma unroll
            for (int i = 0; i < 8; ++i) ss += o[i] * o[i];
            ss += __shfl_xor(ss, 1); ss += __shfl_xor(ss, 2); ss += __shfl_xor(ss, 4); ss += __shfl_xor(ss, 8);
            const float rs = rsqrtf(ss * (1.0f / 128.0f) + EPS);
            const float g0 = siluf_(bflo(wg[q].x)), g1 = siluf_(bfhi(wg[q].x)), g2 = siluf_(bflo(wg[q].y)), g3 = siluf_(bfhi(wg[q].y));
            const float g4 = siluf_(bflo(wg[q].z)), g5 = siluf_(bfhi(wg[q].z)), g6 = siluf_(bflo(wg[q].w)), g7 = siluf_(bfhi(wg[q].w));
            u32x4 w;
            w.x = pk2(o[0] * rs * gn0[0] * g0, o[1] * rs * gn0[1] * g1); w.y = pk2(o[2] * rs * gn0[2] * g2, o[3] * rs * gn0[3] * g3);
            w.z = pk2(o[4] * rs * gn1[0] * g4, o[5] * rs * gn1[1] * g5); w.w = pk2(o[6] * rs * gn1[2] * g6, o[7] * rs * gn1[3] * g7);
            if (ok[q]) *(u32x4*)(ycat + (size_t)(r + q * NGW) * DM + col) = w;
        }
    }
}

#ifdef DBG_STOP
__device__ __forceinline__ void dbg_digest(const Ctx& C, const XcdBarrier& bar, float* out, const bf16_t* pb, size_t nb, const float* pf, size_t nf) {
    xcd_barrier(bar);
    const size_t NO = (size_t)ML * DM;
    for (size_t i = (size_t)C.bid * NTHR + threadIdx.x; i < NO; i += (size_t)C.G * NTHR) {
        float s = 0.f;
        for (size_t j = i; j < nb; j += NO) s += bf2f(pb[j]);
        for (size_t j = i; j < nf; j += NO) s += pf[j];
        if (!(fabsf(s) < 1e30f)) s = 7777.0f;
        out[i] = s;
    }
}
#define DBG_AT(n, pb, nb, pf, nf) if (DBG_STOP == (n) && l == DBG_L) { dbg_digest(C, bar, a.out, (pb), (nb), (pf), (nf)); return; }
#else
#define DBG_AT(n, pb, nb, pf, nf)
#define DBG_L 0
#endif
__global__ void __launch_bounds__(NTHR, 2) fwd_megakernel(Args a) {
    extern __shared__ __attribute__((aligned(16))) unsigned char lds_raw[];
    cg::grid_group grid = cg::this_grid();
    Ctx C;
    C.lds = (LAS unsigned char*)lds_raw;
    C.G = gridDim.x; C.bid = blockIdx.x;
    volatile LAS unsigned* barw = (volatile LAS unsigned*)(C.lds + LDS_BARW);
    if (threadIdx.x < 4) barw[threadIdx.x] = 0u;
    for (int i = C.bid * NTHR + threadIdx.x; i < (int)(CTL_BYTES / 16); i += C.G * NTHR) ((u32x4*)(a.ws + WS_CTL))[i] = (u32x4){0u, 0u, 0u, 0u};
    __syncthreads();

    float* MOD = (float*)(a.ws + WS_MOD);
    float* DEC = (float*)(a.ws + WS_DEC);
    float* XC = (float*)(a.ws + WS_XC);
    bf16_t* ABF = (bf16_t*)(a.ws + WS_ABF);
    bf16_t* PX = (bf16_t*)(a.ws + WS_PX);
    float* US = (float*)(a.ws + WS_US);
    float* PTAIL = (float*)(a.ws + WS_PX + (size_t)MT * DFF * 2);

#ifdef DBG_TIME
    unsigned long long t_last = __builtin_amdgcn_s_memrealtime(); unsigned long long t_cat[12] = {0,0,0,0,0,0,0,0,0,0,0,0};
#define TS(c) do { const unsigned long long _n = __builtin_amdgcn_s_memrealtime(); t_cat[c] += _n - t_last; t_last = _n; } while (0)
#else
#define TS(c)
#endif
    phase_p0(C, a);
    grid.sync();
    XcdBarrier bar = xcd_barrier_post((unsigned*)(a.ws + WS_CTL), barw);
    TS(0);

    const int dbgl = (a.in[0] == nullptr) ? 1 : 0; (void)dbgl;
    for (int l = 0; l < 2; ++l) {
        unsigned char* wt = a.ws + WS_WT + (size_t)l * WT_LAYER;
        const float* mod_l = MOD + (size_t)l * 5 * 6144;
        const float* srcc = (l == 0) ? a.in[2] : XC;
        const float* srcl = (l == 0) ? a.in[0] : a.out;
        DBG_AT(17, PX, 0, a.out, (size_t)ML * DM)
        { CtxFix fx{PTAIL, US, 6, (l == 0) ? 0 : 11, MOD + (size_t)4 * 6144 + 5 * 1024, nullptr};
          phase_norm(C, srcc, srcl, a.in[6] + l * DM, mod_l, 0, 1, ABF, 0, (l == 0) ? MT : MC, fx); }
        if (l == 0) { for (int i = C.bid * NTHR + threadIdx.x; i < MC * DM / 4; i += C.G * NTHR) ((f32x4*)XC)[i] = ((const f32x4*)a.in[2])[i]; }
        GRID_BAR();
        TS(1);

#if defined(DBG_STOP) && DBG_STOP == 14
        if (l == 1) {
            xcd_barrier(bar);
            const bf16_t* w1 = (const bf16_t*)(a.ws + WS_WT + WT_LAYER + WT_IN);
            for (size_t i = (size_t)C.bid * NTHR + threadIdx.x; i < (size_t)ML * DM; i += (size_t)C.G * NTHR) {
                float v = 0.f;
                #define BADF(x) (!(fabsf(x) < 1e30f))
                if (BADF(bf2f(ABF[i])) || (i + (size_t)ML * DM < (size_t)MT * DM && BADF(bf2f(ABF[i + (size_t)ML * DM])))) v = 500.f;
                if (i < (size_t)MC * DM && BADF(XC[i])) v = 1000.f;
                if (BADF(a.out[i])) v = 2000.f;
                if (i < 61440 && BADF(MOD[i])) v = 3000.f;
                if (i < (size_t)INC * DM && BADF(bf2f(w1[i]))) v = 4000.f;
                a.out[i] = v;
            }
            return;
        }
#endif
        DBG_AT(15, PX, 0, a.out, (size_t)ML * DM)
        DBG_AT(16, ABF, (size_t)MT * DM, XC, (size_t)MC * DM)
        { pg8::Gemm g{ABF, (const bf16_t*)(wt + WT_IN)}; pg8::StaticOrder S; S.init(MT / 256, INC / 256, C.G, C.bid, 0);
          pg8::EpiBf16 E{PX, INC}; pg8::gemm_phase<DM, DM, true>(C.lds, g, S, E); }
        GRID_BAR();
        TS(2);
        DBG_AT(1, PX, (size_t)MT * INC, MOD, (size_t)2 * 5 * 6144)
        { const int tid = fresh_tid(); for (int u = C.bid; u < 32 * 16; u += C.G) { if (l == 0) scan_pass1_unit<true>(C, tid, PX, US, DEC, a.in[8], l, u & 31, u >> 5); else scan_pass1_unit<false>(C, tid, PX, US, DEC, a.in[8], l, u & 31, u >> 5); } }
        GRID_BAR();
        TS(3);
        phase_s2(C, US, DEC);
        GRID_BAR();
        TS(4);
        DBG_AT(2, PX, 0, US, (size_t)32 * 16 * 128 * 128)
        {
            const int tid = fresh_tid();
            const int sc0 = (l == 0) ? 0 : 1, nS = 32 * (17 - sc0);
            const int cb0 = (l == 0) ? 0 : 8, nB = (136 - cb0) * 4, ct0 = (l == 0) ? 0 : 16, nC = 272 - ct0;
            int nscan = 0;
            for (int u = C.bid; u < nS; u += C.G) { if (l == 0) scan_unit<3, true>(C, tid, PX, US, DEC, a.in[8], l, u & 31, sc0 + (u >> 5)); else scan_unit<3, false>(C, tid, PX, US, DEC, a.in[8], l, u & 31, sc0 + (u >> 5)); ++nscan; }
            const int extra = nS % C.G;
            const int nsmall = nB + nC;
            int first, stride;
            if (extra > 0 && extra < C.G) { if (C.bid < extra) { first = nsmall; stride = 1; } else { first = C.bid - extra; stride = C.G - extra; } }
            else { first = C.bid; stride = C.G; }
            for (int v = first; v < nsmall; v += stride) {
                if (v < nC) conv_unit(C, tid, PX, ABF, a.in[14] + (size_t)l * 31 * 256, a.in[15] + l * 256, a.in[16] + l * 256, a.in[17] + l * 256, (const bf16_t*)(wt + WT_PW), a.in[19] + l * 256, ct0 + v);
                else { const int w = v - nC; gmlp_unit(C, tid, PX, ABF, a.in[12] + (size_t)l * 4 * 128 * 128, a.in[13] + l * 512, a.in[10] + l * 256, a.in[11] + l * 256, cb0 + (w >> 2), w & 3); }
            }
            (void)nscan;
        }
        GRID_BAR();
        TS(5);
        DBG_AT(3, PX, (size_t)MT * INC, US, 0)
        DBG_AT(4, ABF, (size_t)MT * DM, US, 0)
        phase_xa(C, PX, ABF, a.in[9] + l * 512, (l == 0) ? 0 : MC);
        GRID_BAR();
        TS(6);
        DBG_AT(5, ABF, (size_t)MT * DM, US, 0)
        { pg8::Gemm g{ABF, (const bf16_t*)(wt + WT_OUT)}; pg8::StaticOrder S; S.init(ML / 256, DM / 256, C.G, C.bid, 4);
          float* xb = (float*)(a.ws + WS_XB) + (size_t)(l * 2 + 0) * ML * 4; unsigned* cn = (unsigned*)(a.ws + WS_CNT) + (size_t)(l * 2 + 0) * 64 * 64;
          if (l == 0) { pg8::EpiResNorm<false> E{a.in[0], a.out, mod_l + 2 * 1024, a.in[21] + l * DM, mod_l + 3 * 1024, mod_l + 4 * 1024, ABF, xb, cn}; pg8::gemm_phase<DM, DM, false>(C.lds, g, S, E); }
          else        { pg8::EpiResNorm<true>  E{a.out, US, mod_l + 2 * 1024, a.in[21] + l * DM, mod_l + 3 * 1024, mod_l + 4 * 1024, ABF, xb, cn}; pg8::gemm_phase<DM, DM, false>(C.lds, g, S, E); }
          if (l == 0) { pg8::SliceOrder SS; SS.init(4, C.G, C.bid);
              pg8::EpiPartial EA{US, US, 4}; pg8::gemm_phase<DM, 256, false>(C.lds, g, SS, EA); } }
        GRID_BAR();
        TS(7);
        DBG_AT(6, PX, 0, a.out, (size_t)ML * DM)
        DBG_AT(11, ABF, (size_t)MC * DM, XC, (size_t)MC * DM)
        if (l == 0) {
            { CtxFix fx{US, US, 4, 4, mod_l + (size_t)4 * 6144 + 2 * 1024, XC};
              phase_norm(C, XC, a.out, a.in[21] + l * DM, mod_l, 3, 4, ABF, 0, MC, fx); }
            GRID_BAR();
        }
        TS(1);
        DBG_AT(7, ABF, (size_t)MT * DM, US, 0)
        { const int pm0 = (l == 0) ? 0 : 4;
          pg8::Gemm g{ABF, (const bf16_t*)(wt + WT_13)}; pg8::StaticOrder S; S.init(MT / 256 - pm0, 2 * DFF / 256, C.G, C.bid, pm0);
          pg8::EpiSwiglu E{PX, DFF}; pg8::gemm_phase<DM, DM, true>(C.lds, g, S, E); }
        GRID_BAR();
        TS(8);
        DBG_AT(8, PX, (size_t)MT * DFF, US, 0)
        { pg8::Gemm g{PX, (const bf16_t*)(wt + WT_2)}; pg8::StaticOrder S; S.init(ML / 256, DM / 256, C.G, C.bid, 4);
          const float* mod_n = MOD + (size_t)1 * 5 * 6144;
          float* xb = (float*)(a.ws + WS_XB) + (size_t)(l * 2 + 1) * ML * 4; unsigned* cn = (unsigned*)(a.ws + WS_CNT) + (size_t)(l * 2 + 1) * 64 * 64;
          if (l == 0) { pg8::EpiResNorm<true> E{a.out, a.out, mod_l + 5 * 1024, a.in[6] + DM, mod_n, mod_n + 1024, ABF, xb, cn}; pg8::gemm_phase<DFF, DFF, false>(C.lds, g, S, E); }
          else        { pg8::EpiResNorm<true> E{US, a.out, mod_l + 5 * 1024, a.in[24], nullptr, nullptr, nullptr, xb, cn}; pg8::gemm_phase<DFF, DFF, false>(C.lds, g, S, E); }
          if (l == 0) { pg8::SliceOrder SS; SS.init(11, C.G, C.bid);
              pg8::EpiPartial EA{PTAIL, US, 6}; pg8::gemm_phase<DFF, 256, false>(C.lds, g, SS, EA); } }
        if (l == 0) GRID_BAR();
        TS(9);
        DBG_AT(10, PX, 0, a.out, (size_t)ML * DM)
    }
    { const int l = DBG_L; DBG_AT(9, PX, 0, a.out, (size_t)ML * DM) }
#ifdef DBG_TIME
    TS(10);
    __syncthreads();
    if (C.bid == 0) {
        unsigned long long ta = 0, tb = 0;
#pragma unroll
        for (int c = 0; c < 12; ++c) { if ((DBG_SEL_A >> c) & 1) ta += t_cat[c]; if ((DBG_SEL_B >> c) & 1) tb += t_cat[c]; }
        const float fa = (float)ta * 0.01f, fb = (float)tb * 0.01f;
        for (int i = threadIdx.x; i <= 1000; i += NTHR) a.out[i] = (i == 0) ? fa * 0.25f : fb * 0.01f;
    }
#endif
}

extern "C" void kernel_launch(void* const* d_in, const int* in_sizes, int n_in, void* d_out, int out_size, void* d_ws, size_t ws_size, hipStream_t stream) {
    static int grid = 0;
    if (grid == 0) {
        int dev = 0, cus = 0, per_cu = 0;
        hipGetDevice(&dev);
        hipDeviceGetAttribute(&cus, hipDeviceAttributeMultiprocessorCount, dev);
        hipFuncSetAttribute((const void*)fwd_megakernel, hipFuncAttributeMaxDynamicSharedMemorySize, LDS_BYTES);
        hipOccupancyMaxActiveBlocksPerMultiprocessor(&per_cu, (const void*)fwd_megakernel, NTHR, LDS_BYTES);
        if (per_cu < 1) per_cu = 1;
        grid = cus;
        if (ws_size < WS_END) fprintf(stderr, "kernel_launch: workspace too small: %zu < %zu\n", ws_size, (size_t)WS_END);
        (void)hipGetLastError();
    }
    Args a{};
    for (int i = 0; i < 25; ++i) a.in[i] = (const float*)d_in[i];
    a.out = (float*)d_out; a.ws = (unsigned char*)d_ws;
    void* args[] = {&a};
    hipError_t e = hipLaunchCooperativeKernel((const void*)fwd_megakernel, dim3(grid), dim3(NTHR), args, LDS_BYTES, stream);
    if (e != hipSuccess) fprintf(stderr, "cooperative launch failed: %s (grid %d)\n", hipGetErrorString(e), grid);
}
```

```cpp
#include <hip/hip_runtime.h>
#include <hip/hip_cooperative_groups.h>
#include <cstdio>
namespace cg = cooperative_groups;
#define USE_XCD_BAR 1
#ifndef USE_XCD_BAR
#define GRID_BAR() grid.sync()
#else
#define GRID_BAR() xcd_barrier(bar)
#endif

#define LAS __attribute__((address_space(3)))
typedef unsigned short bf16_t;
typedef short bf16x8 __attribute__((ext_vector_type(8)));
typedef float f32x4 __attribute__((ext_vector_type(4)));
typedef float f32x2 __attribute__((ext_vector_type(2)));
typedef unsigned u32x4 __attribute__((ext_vector_type(4)));
typedef unsigned u32x2 __attribute__((ext_vector_type(2)));

constexpr int DM = 1024, NBATCH = 4, SEQ = 4096, CTXL = 256;
constexpr int MC = NBATCH * CTXL;
constexpr int ML = NBATCH * SEQ;
constexpr int MT = MC + ML;
constexpr int INC = 3584, DFF = 2816;
constexpr float EPS = 1e-6f;
constexpr int NTHR = 512;
constexpr int LDS_BYTES = 163840;
constexpr int LDS_BARW = LDS_BYTES - 64;

constexpr size_t WS_CTL = 0;
constexpr size_t CTL_BYTES = 131072;
constexpr size_t WS_CNT = 16384;
constexpr size_t WS_XB = 131072;
constexpr size_t WS_MOD = WS_XB + 1048576;
constexpr size_t WS_DEC = WS_MOD + 262144;
constexpr size_t WS_WT = WS_DEC + 524288;
constexpr size_t WT_IN = 0, WT_OUT = WT_IN + (size_t)INC * DM * 2, WT_13 = WT_OUT + (size_t)DM * DM * 2,
                 WT_2 = WT_13 + (size_t)2 * DFF * DM * 2, WT_PW = WT_2 + (size_t)DM * DFF * 2, WT_LAYER = WT_PW + (size_t)256 * 256 * 2;
constexpr size_t WS_XC = WS_WT + 2 * WT_LAYER;
constexpr size_t WS_ABF = WS_XC + (size_t)MC * DM * 4;
constexpr size_t WS_PX = WS_ABF + (size_t)MT * DM * 2;
constexpr size_t WS_US = WS_PX + (size_t)MT * INC * 2;
constexpr size_t WS_END = WS_US + (size_t)32 * 16 * 128 * 128 * 4;

__device__ __forceinline__ float bf2f(bf16_t v) { return __uint_as_float(((unsigned)v) << 16); }
__device__ __forceinline__ float bflo(unsigned w) { return __uint_as_float(w << 16); }
__device__ __forceinline__ float bfhi(unsigned w) { return __uint_as_float(w & 0xffff0000u); }
typedef __bf16 bf16x2_t __attribute__((ext_vector_type(2)));
__device__ __forceinline__ unsigned pk2(float lo, float hi) { const f32x2 v = {lo, hi}; const bf16x2_t b = __builtin_convertvector(v, bf16x2_t); return __builtin_bit_cast(unsigned, b); }
__device__ __forceinline__ bf16_t f2bf(float v) { return (bf16_t)(pk2(v, 0.f) & 0xffffu); }
__device__ __forceinline__ float sigmoidf_(float x) { return __builtin_amdgcn_rcpf(1.0f + __expf(-x)); }
__device__ __forceinline__ float siluf_(float x) { return x * sigmoidf_(x); }
__device__ __forceinline__ float gelu_tanh(float x) { const float y = 0.7978845608028654f * (x + 0.044715f * x * x * x); return x * sigmoidf_(2.0f * y); }
__device__ __forceinline__ void logsig2(float zl, float& ls, float& ln) {
    const float e = __builtin_amdgcn_exp2f(-fabsf(zl));
    const float L2 = __builtin_amdgcn_logf(1.0f + e);
    ls = fminf(zl, 0.f) - L2; ln = ls - zl;
}
constexpr float LOG2E = 1.4426950408889634f;
__device__ __forceinline__ float wave_sum(float v) {
#pragma unroll
    for (int o = 1; o < 64; o <<= 1) v += __shfl_xor(v, o);
    return v;
}
__device__ __forceinline__ f32x4 mfma16(bf16x8 a, bf16x8 b, f32x4 c) { return __builtin_amdgcn_mfma_f32_16x16x32_bf16(a, b, c, 0, 0, 0); }
#define LDS_WAIT() asm volatile("s_waitcnt lgkmcnt(0)" ::: "memory")
#define LBAR() do { asm volatile("s_waitcnt lgkmcnt(0)" ::: "memory"); __builtin_amdgcn_s_barrier(); asm volatile("" ::: "memory"); } while (0)
__device__ __forceinline__ int fresh_tid() { int t = threadIdx.x; asm volatile("" : "+v"(t)); return t; }
#define PHASE_IDS() const int tid = fresh_tid(), lane = tid & 63, wid = __builtin_amdgcn_readfirstlane(tid >> 6); (void)lane; (void)wid

#define XB_TMO      128
#define XB_XCNT(j)  (256  + 64 * (j))
#define XB_XSUB(j)  (1280 + 64 * (j))
#define XB_XGEN(j)  (2304 + 64 * (j))
#define XB_TOP      3328
#define XB_TOPGEN   3392
#define XCD_BAR_WORDS 3456
#define XB_SPIN_CAP (1u << 20)
__device__ __forceinline__ unsigned xb_ld(unsigned* p)              { return __hip_atomic_load(p, __ATOMIC_RELAXED, __HIP_MEMORY_SCOPE_AGENT); }
__device__ __forceinline__ unsigned xb_add(unsigned* p, unsigned v) { return __hip_atomic_fetch_add(p, v, __ATOMIC_RELAXED, __HIP_MEMORY_SCOPE_AGENT); }
__device__ __forceinline__ unsigned xb_xcc_id() { return (unsigned)__builtin_amdgcn_s_getreg((3 << 11) | 20) & 0xFu; }
#define XB_SPIN(cond, bar) do { unsigned _sp = 0; while (cond) { __builtin_amdgcn_s_sleep(1); \
    if ((++_sp & 255u) == 0u) { if (xb_ld(&(bar)[XB_TMO])) break; if (_sp > XB_SPIN_CAP) { atomicAdd(&(bar)[XB_TMO], 1u); break; } } } } while (0)
struct XcdBarrier { unsigned* bar; unsigned x; volatile LAS unsigned* st; };
__device__ __forceinline__ XcdBarrier xcd_barrier_post(unsigned* bar, volatile LAS unsigned* st) {
    XcdBarrier b; b.bar = bar; b.x = xb_xcc_id(); b.st = st;
    if (threadIdx.x == 0) (void)xb_add(&bar[XB_XCNT(b.x)], 1u);
    return b;
}
__device__ __forceinline__ void xcd_barrier_complete(unsigned* bar, unsigned x, unsigned& nloc, unsigned& nx) {
    const unsigned G = gridDim.x * gridDim.y * gridDim.z;
    unsigned sum, cnt, mine, sp = 0u;
    for (;;) {
        sum = 0u; cnt = 0u; mine = 0u;
#pragma unroll
        for (unsigned j = 0; j < 16; ++j) { const unsigned c = xb_ld(&bar[XB_XCNT(j)]); sum += c; cnt += (c > 0u) ? 1u : 0u; mine = (j == x) ? c : mine; }
        if (sum == G) break;
        __builtin_amdgcn_s_sleep(1);
        if ((++sp & 255u) == 0u) { if (xb_ld(&bar[XB_TMO])) break; if (sp > XB_SPIN_CAP) { atomicAdd(&bar[XB_TMO], 1u); break; } }
    }
    nloc = mine > 0u ? mine : 1u; nx = cnt > 0u ? cnt : 1u;
}
__device__ __forceinline__ void xcd_barrier(const XcdBarrier& b) {
    asm volatile("s_waitcnt vmcnt(0)" ::: "memory");
    __syncthreads();
    if (threadIdx.x == 0) {
        unsigned* bar = b.bar;
        __builtin_amdgcn_s_waitcnt(0);
        unsigned nloc = b.st[0], nx = b.st[1];
        if (nloc == 0u) { xcd_barrier_complete(bar, b.x, nloc, nx); b.st[0] = nloc; b.st[1] = nx; }
        const unsigned old = xb_add(&bar[XB_XSUB(b.x)], 1u);
        const unsigned gen = old / nloc;
        if (old + 1u == (gen + 1u) * nloc) {
            __builtin_amdgcn_fence(__ATOMIC_RELEASE, "agent");
            asm volatile("s_waitcnt vmcnt(0)" ::: "memory");
            const unsigned og = xb_add(&bar[XB_TOP], 1u);
            const unsigned tg = og / nx;
            if (og + 1u == (tg + 1u) * nx) xb_add(&bar[XB_TOPGEN], 1u);
            else XB_SPIN(xb_ld(&bar[XB_TOPGEN]) == tg, bar);
            __builtin_amdgcn_fence(__ATOMIC_ACQUIRE, "agent");
            xb_add(&bar[XB_XGEN(b.x)], 1u);
            asm volatile("s_waitcnt vmcnt(0)" ::: "memory");
        } else {
            XB_SPIN(xb_ld(&bar[XB_XGEN(b.x)]) == gen, bar);
            __builtin_amdgcn_fence(__ATOMIC_ACQUIRE, "agent");
            asm volatile("s_waitcnt vmcnt(0)" ::: "memory");
        }
    }
    __syncthreads();
}

namespace pg8 {
constexpr int BM = 256, BK = 64, HALF = 128, HTB = HALF * BK * 2, STAGE_BYTES = 8 * HTB, NXCD = 8, WGM = 4;
__device__ __forceinline__ int lds_byte(int r, int c) { const int st = (r >> 4) * 2 + (c >> 5), rr = r & 15, cc = c & 31, ob = rr * 64 + cc * 2; return st * 1024 + (ob ^ (((ob >> 9) & 1) << 5)); }
__device__ __forceinline__ void stage_rc(int b, int& R, int& C) { const int st = b / 1024, sb = b % 1024, swz = sb ^ (((sb >> 9) & 1) << 5); R = (st >> 1) * 16 + swz / 64; C = (st & 1) * 32 + (swz % 64) / 2; }
__device__ __forceinline__ int perm32(int rho) { const int n = rho >> 4, i = rho & 15; return 8 * (i >> 2) + 4 * n + (i & 3); }
struct Unit { int pm, pn, k0; };
struct Gemm { const bf16_t* A; const bf16_t* Bt; };
struct StaticOrder {
    int nM, nN, nwg, G, c, pm0;
    __device__ void init(int nM_, int nN_, int G_, int c_, int pm0_) { nM = nM_; nN = nN_; nwg = nM * nN; G = G_; c = c_; pm0 = pm0_; }
    __device__ bool next(int i, Unit& u) const {
        const long L = (long)i * G + c; if (L >= nwg) return false;
        int wgid = (int)L; { const int q = nwg / NXCD, r = nwg % NXCD, xcd = wgid % NXCD, off = wgid / NXCD; wgid = (xcd < r ? xcd * (q + 1) : r * (q + 1) + (xcd - r) * q) + off; }
        const int nig = WGM * nN, gid = wgid / nig, fm = gid * WGM, gsz = (nM - fm) < WGM ? (nM - fm) : WGM;
        u.pm = pm0 + fm + ((wgid % nig) % gsz); u.pn = (wgid % nig) / gsz; u.k0 = 0; return true;
    }
};

struct EpiBf16 {
    static constexpr bool PERM = true, AFTER_DRAIN = false;
    bf16_t* O; int ldc;
    __device__ __forceinline__ void operator()(const f32x4 (&acc)[2][2][4][2], const Unit& u, int wr, int wc, int fr, int fq) const {
        const int row0 = u.pm * BM + wr * 64 + fr; const int col0 = u.pn * BM + wc * 32 + 8 * fq;
#pragma unroll
        for (int ai = 0; ai < 2; ++ai)
#pragma unroll
            for (int m = 0; m < 4; ++m) { bf16_t* rowp = O + (size_t)(row0 + ai * HALF + m * 16) * ldc + col0;
#pragma unroll
                for (int bj = 0; bj < 2; ++bj) { const f32x4 v0 = acc[ai][bj][m][0], v1 = acc[ai][bj][m][1];
                    u32x4 w; w.x = pk2(v0[0], v0[1]); w.y = pk2(v0[2], v0[3]); w.z = pk2(v1[0], v1[1]); w.w = pk2(v1[2], v1[3]);
                    *(u32x4*)(rowp + bj * HALF) = w; } }
    }
};
struct EpiSwiglu {
    static constexpr bool PERM = true, AFTER_DRAIN = false;
    bf16_t* O; int ldc;
    __device__ __forceinline__ void operator()(const f32x4 (&acc)[2][2][4][2], const Unit& u, int wr, int wc, int fr, int fq) const {
        const int row0 = u.pm * BM + wr * 64 + fr; const int col0 = u.pn * HALF + wc * 32 + 8 * fq;
#pragma unroll
        for (int ai = 0; ai < 2; ++ai)
#pragma unroll
            for (int m = 0; m < 4; ++m) { bf16_t* rowp = O + (size_t)(row0 + ai * HALF + m * 16) * ldc + col0;
                float o[8];
#pragma unroll
                for (int n = 0; n < 2; ++n)
#pragma unroll
                    for (int j = 0; j < 4; ++j) { const float a = acc[ai][0][m][n][j], b = acc[ai][1][m][n][j]; o[n * 4 + j] = siluf_(a) * b; }
                u32x4 w; w.x = pk2(o[0], o[1]); w.y = pk2(o[2], o[3]); w.z = pk2(o[4], o[5]); w.w = pk2(o[6], o[7]);
                *(u32x4*)rowp = w; }
    }
};
struct EpiRes {
    static constexpr bool PERM = false, AFTER_DRAIN = false;
    const float* base_c; const float* base_l; float* out_c; float* out_l; const float* gate;
    __device__ __forceinline__ void operator()(const f32x4 (&acc)[2][2][4][2], const Unit& u, int wr, int wc, int fr, int fq) const {
        const int bi = (u.pm < 4) ? 4 : ((u.pm - 4) >> 4);
        const float* base = (u.pm < 4) ? base_c + (size_t)u.pm * BM * DM : base_l + (size_t)(u.pm - 4) * BM * DM;
        float* out = (u.pm < 4) ? out_c + (size_t)u.pm * BM * DM : out_l + (size_t)(u.pm - 4) * BM * DM;
        const int row0 = wr * 64 + fr, col0 = u.pn * BM + wc * 32 + 4 * fq;
        f32x4 gv[2][2];
#pragma unroll
        for (int bj = 0; bj < 2; ++bj)
#pragma unroll
            for (int n = 0; n < 2; ++n) gv[bj][n] = *(const f32x4*)(gate + (size_t)bi * 6144 + col0 + bj * HALF + n * 16);
#pragma unroll
        for (int ai = 0; ai < 2; ++ai)
#pragma unroll
            for (int mh = 0; mh < 2; ++mh) {
                f32x4 bs[2][2][2];
#pragma unroll
                for (int m2 = 0; m2 < 2; ++m2) { const size_t off = (size_t)(row0 + ai * HALF + (mh * 2 + m2) * 16) * DM + col0;
#pragma unroll
                    for (int bj = 0; bj < 2; ++bj)
#pragma unroll
                        for (int n = 0; n < 2; ++n) bs[m2][bj][n] = *(const f32x4*)(base + off + bj * HALF + n * 16); }
#pragma unroll
                for (int m2 = 0; m2 < 2; ++m2) { const size_t off = (size_t)(row0 + ai * HALF + (mh * 2 + m2) * 16) * DM + col0;
#pragma unroll
                    for (int bj = 0; bj < 2; ++bj)
#pragma unroll
                        for (int n = 0; n < 2; ++n) *(f32x4*)(out + off + bj * HALF + n * 16) = bs[m2][bj][n] + gv[bj][n] * acc[ai][bj][mh * 2 + m2][n]; }
            }
    }
};

template <bool BASE16>
struct EpiResNorm {
    static constexpr bool PERM = true, AFTER_DRAIN = true;
    const void* base_l; void* out_l; const float* gate;
    const float* ng; const float* nsh; const float* nsc;
    bf16_t* hn; float* xbuf; unsigned* cnt;
    __device__ __forceinline__ void fused(f32x4 (&acc)[2][2][4][2], const Unit& u, int wr, int wc, int fr, int fq, LAS unsigned char* lds, int wid, int lane) const {
        const int pl = u.pm - 4, bi = pl >> 4;
        const float* base = (const float*)base_l + (size_t)pl * BM * DM; const bf16_t* base16 = (const bf16_t*)base_l + (size_t)pl * BM * DM;
        float* out = (float*)out_l + (size_t)pl * BM * DM; bf16_t* out16 = (bf16_t*)out_l + (size_t)pl * BM * DM;
        const int row0 = wr * 64 + fr, col0 = u.pn * BM + wc * 32 + 8 * fq;
        LAS float* P = (LAS float*)lds;
        LAS float* S = (LAS float*)(lds + 4096);
        f32x4 gv[2][2];
#pragma unroll
        for (int bj = 0; bj < 2; ++bj)
#pragma unroll
            for (int n = 0; n < 2; ++n) gv[bj][n] = *(const f32x4*)(gate + (size_t)bi * 6144 + col0 + bj * HALF + n * 4);
#pragma unroll
        for (int ai = 0; ai < 2; ++ai)
#pragma unroll
            for (int mh = 0; mh < 2; ++mh) {
                f32x4 bs[2][2][2];
#pragma unroll
                for (int m2 = 0; m2 < 2; ++m2) { const size_t off = (size_t)(row0 + ai * HALF + (mh * 2 + m2) * 16) * DM + col0;
#pragma unroll
                    for (int bj = 0; bj < 2; ++bj)
#pragma unroll
                        for (int n = 0; n < 2; ++n) {
                            if (BASE16) { const u32x2 w = __builtin_nontemporal_load((const u32x2*)(base16 + off + bj * HALF + n * 4)); bs[m2][bj][n] = (f32x4){bflo(w.x), bfhi(w.x), bflo(w.y), bfhi(w.y)}; }
                            else bs[m2][bj][n] = __builtin_nontemporal_load((const f32x4*)(base + off + bj * HALF + n * 4)); } }
#pragma unroll
                for (int m2 = 0; m2 < 2; ++m2) { const int m = mh * 2 + m2; const size_t off = (size_t)(row0 + ai * HALF + m * 16) * DM + col0;
                    float sq = 0.f;
#pragma unroll
                    for (int bj = 0; bj < 2; ++bj)
#pragma unroll
                        for (int n = 0; n < 2; ++n) { const f32x4 x = bs[m2][bj][n] + gv[bj][n] * acc[ai][bj][m][n]; acc[ai][bj][m][n] = x;
                            if (hn) { u32x2 w; w.x = pk2(x[0], x[1]); w.y = pk2(x[2], x[3]); *(u32x2*)(out16 + off + bj * HALF + n * 4) = w; }
                            sq += (x[0] * x[0] + x[1] * x[1]) + (x[2] * x[2] + x[3] * x[3]); }
                    sq += __shfl_xor(sq, 16); sq += __shfl_xor(sq, 32);
                    if (fq == 0) P[(ai * HALF + wr * 64 + m * 16 + fr) * 4 + wc] = sq; }
            }
        f32x4 ngv[2][2], shv[2][2];
#pragma unroll
        for (int bj = 0; bj < 2; ++bj)
#pragma unroll
            for (int n = 0; n < 2; ++n) { const int c = col0 + bj * HALF + n * 4; ngv[bj][n] = *(const f32x4*)(ng + c);
                if (nsh) { shv[bj][n] = *(const f32x4*)(nsh + (size_t)bi * 6144 + c); ngv[bj][n] = ngv[bj][n] * (*(const f32x4*)(nsc + (size_t)bi * 6144 + c) + 1.0f); }
                else shv[bj][n] = (f32x4){0.f, 0.f, 0.f, 0.f}; }
        asm volatile("s_waitcnt lgkmcnt(0)" ::: "memory"); __builtin_amdgcn_s_barrier(); asm volatile("" ::: "memory");
        const int row = wid * 32 + (lane & 31);
        if (lane < 32) { const float t = (P[row * 4 + 0] + P[row * 4 + 1]) + (P[row * 4 + 2] + P[row * 4 + 3]);
            __hip_atomic_store(xbuf + ((size_t)(pl * BM + row) * 4 + u.pn), t, __ATOMIC_RELAXED, __HIP_MEMORY_SCOPE_AGENT); }
        asm volatile("s_waitcnt vmcnt(0)" ::: "memory");
        if (lane == 0) __hip_atomic_fetch_add(cnt + 64 * pl, 1u, __ATOMIC_RELAXED, __HIP_MEMORY_SCOPE_AGENT);
        if (wid == 0) {
            unsigned sp = 0;
            while ((unsigned)__builtin_amdgcn_readfirstlane(__hip_atomic_load(cnt + 64 * pl, __ATOMIC_RELAXED, __HIP_MEMORY_SCOPE_AGENT)) < 32u) { __builtin_amdgcn_s_sleep(2); if (++sp > (1u << 22)) break; }
            __builtin_amdgcn_fence(__ATOMIC_ACQUIRE, "agent");
        }
        asm volatile("s_waitcnt vmcnt(0) lgkmcnt(0)" ::: "memory"); __builtin_amdgcn_s_barrier(); asm volatile("" ::: "memory");
        if (lane < 32) { const float* sl = xbuf + (size_t)(pl * BM + row) * 4; float ss = 0.f;
#pragma unroll
            for (int t = 0; t < 4; ++t) ss += __hip_atomic_load(sl + t, __ATOMIC_RELAXED, __HIP_MEMORY_SCOPE_AGENT);
            S[row] = rsqrtf(ss * (1.0f / DM) + EPS); }
        asm volatile("s_waitcnt lgkmcnt(0)" ::: "memory"); __builtin_amdgcn_s_barrier(); asm volatile("" ::: "memory");
#pragma unroll
        for (int ai = 0; ai < 2; ++ai)
#pragma unroll
            for (int m = 0; m < 4; ++m) { const int r = ai * HALF + wr * 64 + m * 16 + fr; const float rs = S[r];
#pragma unroll
                for (int bj = 0; bj < 2; ++bj)
#pragma unroll
                    for (int n = 0; n < 2; ++n) { const f32x4 y = acc[ai][bj][m][n] * rs * ngv[bj][n] + shv[bj][n]; const int c = col0 + bj * HALF + n * 4;
                        if (hn) { u32x2 w; w.x = pk2(y[0], y[1]); w.y = pk2(y[2], y[3]); *(u32x2*)(hn + (size_t)(u.pm * BM + r) * DM + c) = w; }
                        else *(f32x4*)(out + (size_t)r * DM + c) = y; } }
        asm volatile("s_waitcnt lgkmcnt(0)" ::: "memory"); __builtin_amdgcn_s_barrier(); asm volatile("" ::: "memory");
    }
};
struct SliceOrder {
    int ns, nu, G, c;
    __device__ void init(int ns_, int G_, int c_) { ns = ns_; nu = 16 * ns_; G = G_; c = G_ - 1 - c_; }
    __device__ bool next(int i, Unit& u) const {
        const int L = i * G + c; if (L >= nu) return false;
        const int t = L / ns, sl = L % ns; u.pm = t >> 2; u.pn = t & 3; u.k0 = sl * 256; return true;
    }
};
struct EpiPartial {
    static constexpr bool PERM = false, AFTER_DRAIN = false;
    float* p0; float* p1; int split;
    __device__ __forceinline__ void operator()(const f32x4 (&acc)[2][2][4][2], const Unit& u, int wr, int wc, int fr, int fq) const {
        const int sl = u.k0 >> 8;
        float* out = ((sl < split) ? p0 + (size_t)sl * MC * DM : p1 + (size_t)(sl - split) * MC * DM) + (size_t)u.pm * BM * DM;
        const int row0 = wr * 64 + fr, col0 = u.pn * BM + wc * 32 + 4 * fq;
#pragma unroll
        for (int ai = 0; ai < 2; ++ai)
#pragma unroll
            for (int m = 0; m < 4; ++m) { const size_t off = (size_t)(row0 + ai * HALF + m * 16) * DM + col0;
#pragma unroll
                for (int bj = 0; bj < 2; ++bj)
#pragma unroll
                    for (int n = 0; n < 2; ++n) *(f32x4*)(out + off + bj * HALF + n * 16) = acc[ai][bj][m][n]; }
    }
};

template <int LD, int KLEN, bool ALIGN_EPI, class Epi, class Sched>
__device__ __forceinline__ void gemm_phase(LAS unsigned char* lds, const Gemm g, const Sched& S, const Epi& E) {
    const int tid = fresh_tid(), wid = __builtin_amdgcn_readfirstlane(tid >> 6), lane = tid & 63, wr = wid >> 2, wc = wid & 3, fr = lane & 15, fq = lane >> 4;
    constexpr int nt = KLEN / BK;
    unsigned voffA[2], voffB[2];
#pragma unroll
    for (int i = 0; i < 2; ++i) { int R, C; stage_rc(tid * 16 + i * 8192, R, C); const int Rb = Epi::PERM ? ((R & ~31) + perm32(R & 31)) : R;
        voffA[i] = (unsigned)(R * LD + C) * 2u; voffB[i] = (unsigned)(Rb * LD + C) * 2u; }
    const size_t kstep = (size_t)(BK * 2);
    constexpr size_t hstepA = (size_t)HALF * LD * 2, hstepB = hstepA;
    constexpr size_t tstepA = 2 * hstepA, tstepB = tstepA;
    const unsigned ldsw = (unsigned)wid * 1024u;
    const int aoff = lds_byte(wr * 64 + fr, fq * 8), boff = lds_byte(wc * 32 + fr, fq * 8);
#define PG8_SA(b, h) (((b) * 2 + (h)) * HTB)
#define PG8_SB(b, h) ((4 + (b) * 2 + (h)) * HTB)
#define PG8_STAGE(bufoff, gbase, voff) do { _Pragma("unroll") for (int _i = 0; _i < 2; ++_i) \
        __builtin_amdgcn_global_load_lds((const unsigned*)((const char*)(gbase) + (voff)[_i]), (LAS unsigned*)(lds + (bufoff) + ldsw + _i * 8192), 16, 0, 0); } while (0)
#define PG8_LDA(dst, b, h) do { _Pragma("unroll") for (int m = 0; m < 4; ++m) _Pragma("unroll") for (int k = 0; k < 2; ++k) dst[m][k] = *(const LAS bf16x8*)(lds + PG8_SA(b, h) + aoff + m * 2048 + k * 1024); } while (0)
#define PG8_LDB(dst, b, h) do { _Pragma("unroll") for (int n = 0; n < 2; ++n) _Pragma("unroll") for (int k = 0; k < 2; ++k) dst[n][k] = *(const LAS bf16x8*)(lds + PG8_SB(b, h) + boff + n * 2048 + k * 1024); } while (0)
#define PG8_MMA(ai, bj, At, Bt) do { __builtin_amdgcn_s_setprio(1); _Pragma("unroll") for (int m = 0; m < 4; ++m) _Pragma("unroll") for (int n = 0; n < 2; ++n) _Pragma("unroll") for (int k = 0; k < 2; ++k) \
        acc[ai][bj][m][n] = __builtin_amdgcn_mfma_f32_16x16x32_bf16(Bt[n][k], At[m][k], acc[ai][bj][m][n], 0, 0, 0); __builtin_amdgcn_s_setprio(0); } while (0)
#define PG8_WAIT_V(n) asm volatile("s_waitcnt vmcnt(" #n ")" ::: "memory")
#define PG8_WAIT_L(n) asm volatile("s_waitcnt lgkmcnt(" #n ")" ::: "memory")
#define PG8_BAR __builtin_amdgcn_s_barrier()
#define PG8_SCHED __builtin_amdgcn_sched_barrier(0)
    Unit cur, nxt; int ui = 0;
    if (!S.next(0, cur)) return;
    f32x4 acc[2][2][4][2];
#pragma unroll
    for (int a = 0; a < 2; ++a)
#pragma unroll
        for (int b = 0; b < 2; ++b)
#pragma unroll
            for (int m = 0; m < 4; ++m)
#pragma unroll
                for (int n = 0; n < 2; ++n) acc[a][b][m][n] = (f32x4){0.f, 0.f, 0.f, 0.f};
    bf16x8 At[4][2], B0[2][2], B1[2][2];
    const char* cA = (const char*)g.A + (size_t)cur.pm * tstepA + (size_t)cur.k0 * 2; const char* cB = (const char*)g.Bt + (size_t)cur.pn * tstepB + (size_t)cur.k0 * 2;
    PG8_STAGE(PG8_SB(0, 0), cB, voffB); PG8_STAGE(PG8_SB(0, 1), cB + hstepB, voffB); PG8_STAGE(PG8_SA(0, 0), cA, voffA); PG8_STAGE(PG8_SA(0, 1), cA + hstepA, voffA);
    if (wr == 1) PG8_BAR;
    PG8_WAIT_V(2); PG8_BAR;
    PG8_STAGE(PG8_SB(1, 0), cB + kstep, voffB); PG8_STAGE(PG8_SA(1, 0), cA + kstep, voffA); PG8_STAGE(PG8_SB(1, 1), cB + hstepB + kstep, voffB);
    PG8_WAIT_V(6); PG8_BAR;
    for (;;) {
        const bool has_next = S.next(ui + 1, nxt);
        const char* nA = has_next ? (const char*)g.A + (size_t)nxt.pm * tstepA + (size_t)nxt.k0 * 2 : cA; const char* nB = has_next ? (const char*)g.Bt + (size_t)nxt.pn * tstepB + (size_t)nxt.k0 * 2 : cB;
#pragma unroll 1
        for (int t = 0; t < nt; t += 2) {
            const bool last = (t == nt - 2);
            const char* a1 = cA + (size_t)(t + 1) * kstep;
            const char* a2 = last ? nA : cA + (size_t)(t + 2) * kstep; const char* b2 = last ? nB : cB + (size_t)(t + 2) * kstep;
            const char* a3 = a2 + kstep; const char* b3 = b2 + kstep;
            PG8_LDB(B0, 0, 0); PG8_LDB(B1, 0, 1); PG8_SCHED; PG8_LDA(At, 0, 0); PG8_STAGE(PG8_SA(1, 1), a1 + hstepA, voffA);
            PG8_WAIT_V(8); PG8_WAIT_L(0); PG8_BAR; PG8_MMA(0, 0, At, B0); PG8_MMA(0, 1, At, B1); PG8_BAR; PG8_SCHED;
            PG8_LDA(At, 0, 1); PG8_STAGE(PG8_SB(0, 0), b2, voffB); PG8_STAGE(PG8_SB(0, 1), b2 + hstepB, voffB); PG8_STAGE(PG8_SA(0, 0), a2, voffA);
            PG8_WAIT_V(8); PG8_WAIT_L(0); PG8_BAR; PG8_MMA(1, 0, At, B0); PG8_MMA(1, 1, At, B1); PG8_BAR; PG8_SCHED;
            PG8_LDB(B0, 1, 0); PG8_LDB(B1, 1, 1); PG8_SCHED; PG8_LDA(At, 1, 0); PG8_STAGE(PG8_SA(0, 1), a2 + hstepA, voffA);
            PG8_WAIT_V(8); PG8_WAIT_L(0); PG8_BAR; PG8_MMA(0, 0, At, B0); PG8_MMA(0, 1, At, B1); PG8_BAR; PG8_SCHED;
            PG8_LDA(At, 1, 1); PG8_STAGE(PG8_SB(1, 0), b3, voffB); PG8_STAGE(PG8_SB(1, 1), b3 + hstepB, voffB); PG8_STAGE(PG8_SA(1, 0), a3, voffA);
            PG8_WAIT_V(8); PG8_WAIT_L(0); PG8_BAR; PG8_MMA(1, 0, At, B0); PG8_MMA(1, 1, At, B1); PG8_BAR; PG8_SCHED;
        }
        if constexpr (ALIGN_EPI) { if (wr == 0) PG8_BAR; }
        if constexpr (!Epi::AFTER_DRAIN) E(acc, cur, wr, wc, fr, fq);
        if (!has_next) break;
#pragma unroll
        for (int a = 0; a < 2; ++a)
#pragma unroll
            for (int b = 0; b < 2; ++b)
#pragma unroll
                for (int m = 0; m < 4; ++m)
#pragma unroll
                    for (int n = 0; n < 2; ++n) acc[a][b][m][n] = (f32x4){0.f, 0.f, 0.f, 0.f};
        cur = nxt; cA = nA; cB = nB; ++ui;
        if constexpr (ALIGN_EPI) { if (wr == 1) PG8_BAR; }
    }
    PG8_WAIT_V(0);
    if constexpr (!ALIGN_EPI) { if (wr == 0) PG8_BAR; }
    PG8_BAR;
    if constexpr (Epi::AFTER_DRAIN) E.fused(acc, cur, wr, wc, fr, fq, lds, wid, lane);
#undef PG8_SA
#undef PG8_SB
#undef PG8_STAGE
#undef PG8_LDA
#undef PG8_LDB
#undef PG8_MMA
#undef PG8_WAIT_V
#undef PG8_WAIT_L
#undef PG8_BAR
#undef PG8_SCHED
}
}

struct Args {
    const float* in[25];
    float* out;
    unsigned char* ws;
};

struct Ctx {
    LAS unsigned char* lds;
    int G, bid;
};


__device__ __forceinline__ void transpose_item(const float* W, int K, int N, int k0, int nsrc0, bf16_t* WT, int ndst0, LAS float* scr, int lane) {
#pragma unroll
    for (int i = 0; i < 32; ++i) { const int kk = 2 * i + (lane >> 5); scr[kk * 33 + (lane & 31)] = __builtin_nontemporal_load(W + (size_t)(k0 + kk) * N + nsrc0 + (lane & 31)); }
    LDS_WAIT();
    const int c = lane & 7;
#pragma unroll
    for (int j = 0; j < 4; ++j) { const int n = (lane >> 3) + 8 * j; const LAS float* s = scr + (8 * c) * 33 + n;
        u32x4 o; o.x = pk2(s[0 * 33], s[1 * 33]); o.y = pk2(s[2 * 33], s[3 * 33]); o.z = pk2(s[4 * 33], s[5 * 33]); o.w = pk2(s[6 * 33], s[7 * 33]);
        *(u32x4*)(WT + (size_t)(ndst0 + n) * K + k0 + 8 * c) = o; }
    LDS_WAIT();
}

__device__ __forceinline__ void phase_p0(const Ctx& C, const Args& a) {
    PHASE_IDS();
    {
        LAS float* sc = (LAS float*)(C.lds);
        LAS float* red = (LAS float*)(C.lds + 20480);
        float* MOD = (float*)(a.ws + WS_MOD);
        for (int idx = tid; idx < 5 * 1024; idx += NTHR) { const int bi = idx >> 10, k = idx & 1023; const float v = bi < 4 ? a.in[1][bi * 1024 + k] : a.in[3][k]; sc[idx] = siluf_(v); }
        __syncthreads();
        for (int u = C.bid; u < 192; u += C.G) {
            const int l = u / 96, cb = u % 96, col = cb * 64 + lane;
            const float* W = a.in[4] + ((size_t)l * 1024 + wid * 128) * 6144 + col;
            float acc[5] = {0.f, 0.f, 0.f, 0.f, 0.f};
#pragma unroll 32
            for (int kk = 0; kk < 128; ++kk) { const float w = __builtin_nontemporal_load(W + (size_t)kk * 6144); const int k = wid * 128 + kk;
#pragma unroll
                for (int bi = 0; bi < 5; ++bi) acc[bi] += sc[bi * 1024 + k] * w; }
#pragma unroll
            for (int bi = 0; bi < 5; ++bi) red[(wid * 5 + bi) * 64 + lane] = acc[bi];
            __syncthreads();
            if (tid < 320) { const int bi = tid >> 6, ln = tid & 63; float s = a.in[5][l * 6144 + cb * 64 + ln];
#pragma unroll
                for (int w = 0; w < 8; ++w) s += red[(w * 5 + bi) * 64 + ln];
                MOD[((size_t)l * 5 + bi) * 6144 + cb * 64 + ln] = s; }
            __syncthreads();
        }
    }
    {
        LAS float* scr = (LAS float*)(C.lds + wid * 8448);
        const int gw = C.bid * 8 + wid, NGW = C.G * 8;
        constexpr int I_IN = 16 * 112, I_OUT = 16 * 32, I_13 = 16 * 176, I_2 = 44 * 32, I_PW = 4 * 8, I_L = I_IN + I_OUT + I_13 + I_2 + I_PW;
        for (int it = gw; it < 2 * I_L; it += NGW) {
            const int l = it / I_L; int r = it % I_L;
            unsigned char* wt = a.ws + WS_WT + (size_t)l * WT_LAYER;
            if (r < I_IN) { const int kb = r / 112, nb = r % 112; transpose_item(a.in[7] + (size_t)l * DM * INC, DM, INC, kb * 64, nb * 32, (bf16_t*)(wt + WT_IN), nb * 32, scr, lane); continue; } r -= I_IN;
            if (r < I_OUT) { const int kb = r / 32, nb = r % 32; transpose_item(a.in[20] + (size_t)l * DM * DM, DM, DM, kb * 64, nb * 32, (bf16_t*)(wt + WT_OUT), nb * 32, scr, lane); continue; } r -= I_OUT;
            if (r < I_13) { const int kb = r / 176, nb = r % 176; const int nd = nb * 32, pn = nd >> 8, bj = (nd >> 7) & 1, j = nd & 127;
                transpose_item(a.in[22] + (size_t)l * DM * 2 * DFF, DM, 2 * DFF, kb * 64, bj * DFF + pn * 128 + j, (bf16_t*)(wt + WT_13), nd, scr, lane); continue; } r -= I_13;
            if (r < I_2) { const int kb = r / 32, nb = r % 32; transpose_item(a.in[23] + (size_t)l * DFF * DM, DFF, DM, kb * 64, nb * 32, (bf16_t*)(wt + WT_2), nb * 32, scr, lane); continue; } r -= I_2;
            { const int kb = r / 8, nb = r % 8; transpose_item(a.in[18] + (size_t)l * 256 * 256, 256, 256, kb * 64, nb * 32, (bf16_t*)(wt + WT_PW), nb * 32, scr, lane); }
        }
    }
}

__device__ __forceinline__ void norm_row_load(const float* srcc, const float* srcl, const float* mod_l, int shift_idx, int scale_idx, int r, int lane, f32x4 (&v)[4], f32x4 (&shv)[4], f32x4 (&scv)[4]) {
    const float* xr = (r < MC) ? srcc + (size_t)r * DM : srcl + (size_t)(r - MC) * DM;
    const int bi = (r < MC) ? 4 : ((r - MC) >> 12);
    const float* sh = mod_l + (size_t)bi * 6144 + shift_idx * 1024; const float* sc = mod_l + (size_t)bi * 6144 + scale_idx * 1024;
#pragma unroll
    for (int j = 0; j < 4; ++j) { v[j] = __builtin_nontemporal_load((const f32x4*)(xr + 4 * lane + 256 * j)); shv[j] = *(const f32x4*)(sh + 4 * lane + 256 * j); scv[j] = *(const f32x4*)(sc + 4 * lane + 256 * j); }
}
__device__ __forceinline__ void norm_row_store(bf16_t* dst, int r, int lane, const f32x4 (&v)[4], const f32x4 (&shv)[4], const f32x4 (&scv)[4], const f32x4 (&gv)[4], float rs) {
#pragma unroll
    for (int j = 0; j < 4; ++j) { const f32x4 y = v[j] * rs * gv[j] * (scv[j] + 1.0f) + shv[j];
        u32x2 w; w.x = pk2(y[0], y[1]); w.y = pk2(y[2], y[3]);
        *(u32x2*)(dst + (size_t)r * DM + 4 * lane + 256 * j) = w; }
}
__device__ __forceinline__ float sumsq4(const f32x4 (&v)[4]) { float s = 0.f;
#pragma unroll
    for (int j = 0; j < 4; ++j) s += (v[j][0] * v[j][0] + v[j][1] * v[j][1]) + (v[j][2] * v[j][2] + v[j][3] * v[j][3]);
    return s; }
struct CtxFix { const float* p0; const float* p1; int split, ns; const float* gate; float* xc_out; };
__device__ __forceinline__ void phase_norm(const Ctx& C, const float* srcc, const float* srcl, const float* g, const float* mod_l  , int shift_idx, int scale_idx, bf16_t* dst, int r_lo, int r_hi, const CtxFix fx) {
    PHASE_IDS();
    const int gw = C.bid * 8 + wid, NGW = C.G * 8;
    f32x4 gv[4];
#pragma unroll
    for (int j = 0; j < 4; ++j) gv[j] = *(const f32x4*)(g + 4 * lane + 256 * j);
    for (int r = r_lo + gw; r < r_hi; r += 2 * NGW) {
        const int r2 = r + NGW; const bool two = r2 < r_hi;
        f32x4 v0[4], sh0[4], sc0[4], v1[4], sh1[4], sc1[4];
        norm_row_load(srcc, srcl, mod_l, shift_idx, scale_idx, r, lane, v0, sh0, sc0);
        if (two) norm_row_load(srcc, srcl, mod_l, shift_idx, scale_idx, r2, lane, v1, sh1, sc1);
        if (r < MC && fx.ns > 0) {
            f32x4 ps[4];
#pragma unroll
            for (int j = 0; j < 4; ++j) ps[j] = (f32x4){0.f, 0.f, 0.f, 0.f};
            for (int s0 = 0; s0 < fx.ns; s0 += 4) {
                f32x4 pl[4][4];
#pragma unroll
                for (int q = 0; q < 4; ++q) { const int sl = (s0 + q < fx.ns) ? s0 + q : s0;
                    const float* pr = ((sl < fx.split) ? fx.p0 + (size_t)sl * MC * DM : fx.p1 + (size_t)(sl - fx.split) * MC * DM) + (size_t)r * DM;
#pragma unroll
                    for (int j = 0; j < 4; ++j) pl[q][j] = *(const f32x4*)(pr + 4 * lane + 256 * j); }
#pragma unroll
                for (int q = 0; q < 4; ++q) if (s0 + q < fx.ns) {
#pragma unroll
                    for (int j = 0; j < 4; ++j) ps[j] += pl[q][j]; }
            }
#pragma unroll
            for (int j = 0; j < 4; ++j) { v0[j] += *(const f32x4*)(fx.gate + 4 * lane + 256 * j) * ps[j];
                if (fx.xc_out) *(f32x4*)(fx.xc_out + (size_t)r * DM + 4 * lane + 256 * j) = v0[j]; }
        }
        float s0 = sumsq4(v0), s1 = two ? sumsq4(v1) : 0.f;
#pragma unroll
        for (int o = 1; o < 64; o <<= 1) { s0 += __shfl_xor(s0, o); s1 += __shfl_xor(s1, o); }
        norm_row_store(dst, r, lane, v0, sh0, sc0, gv, rsqrtf(s0 * (1.0f / DM) + EPS));
        if (two) norm_row_store(dst, r2, lane, v1, sh1, sc1, gv, rsqrtf(s1 * (1.0f / DM) + EPS));
    }
}
__device__ __forceinline__ void phase_final(const Ctx& C, float* out, const float* g) {
    PHASE_IDS();
    const int gw = C.bid * 8 + wid, NGW = C.G * 8;
    f32x4 gv[4];
#pragma unroll
    for (int j = 0; j < 4; ++j) gv[j] = *(const f32x4*)(g + 4 * lane + 256 * j);
    for (int r = gw; r < ML; r += 2 * NGW) {
        float* x0 = out + (size_t)r * DM; float* x1 = out + (size_t)(r + NGW) * DM;
        f32x4 v0[4], v1[4];
#pragma unroll
        for (int j = 0; j < 4; ++j) { v0[j] = *(const f32x4*)(x0 + 4 * lane + 256 * j); v1[j] = *(const f32x4*)(x1 + 4 * lane + 256 * j); }
        float s0 = sumsq4(v0), s1 = sumsq4(v1);
#pragma unroll
        for (int o = 1; o < 64; o <<= 1) { s0 += __shfl_xor(s0, o); s1 += __shfl_xor(s1, o); }
        const float r0s = rsqrtf(s0 * (1.0f / DM) + EPS), r1s = rsqrtf(s1 * (1.0f / DM) + EPS);
#pragma unroll
        for (int j = 0; j < 4; ++j) { *(f32x4*)(x0 + 4 * lane + 256 * j) = v0[j] * r0s * gv[j]; *(f32x4*)(x1 + 4 * lane + 256 * j) = v1[j] * r1s * gv[j]; }
    }
}

constexpr int SC_QT = 0, SC_QS = 17408, SC_KT = 34816, SC_KDT = 52224, SC_VT = 70656, SC_ST = 89088, SC_P = 123904, SC_SEG = 133120, SC_DK = 135168;
template <int PASS, bool L0>
__device__ __forceinline__ void scan_unit(const Ctx& C, int tid, bf16_t* px, float* US, float* DEC, const float* lbl, int layer, int seq, int sc) {
    const int dir = seq & 1, h = (seq >> 1) & 3, b = seq >> 3;
    const int lane = tid & 63, wid = __builtin_amdgcn_readfirstlane(tid >> 6), fr = lane & 15, fq = lane >> 4;
    LAS bf16_t* QT = (LAS bf16_t*)(C.lds + SC_QT);
    LAS bf16_t* QS = (LAS bf16_t*)(C.lds + SC_QS);
    LAS bf16_t* KT = (LAS bf16_t*)(C.lds + SC_KT);
    LAS bf16_t* KDT = (LAS bf16_t*)(C.lds + SC_KDT);
    LAS bf16_t* VT = (LAS bf16_t*)(C.lds + SC_VT);
    LAS bf16_t* ST = (LAS bf16_t*)(C.lds + SC_ST);
    LAS bf16_t* P = (LAS bf16_t*)(C.lds + SC_P);
    LAS float* SEG = (LAS float*)(C.lds + SC_SEG);
    LAS float* DK = (LAS float*)(C.lds + SC_DK);
    const int k = tid & 127, sg = tid >> 7;
    float lb = 0.f;
    if (!L0) { const float l0 = lbl[(0 * 2 + dir) * 512 + h * 128 + k], l1 = lbl[(1 * 2 + dir) * 512 + h * 128 + k]; lb = sigmoidf_(l1 - l0); }
    const float omlb = 1.0f - lb;
    const int zcol = (dir ? 1024 : 512) + h * 128;
    const unsigned zo = (unsigned)(zcol - h * 128);

    unsigned pz[16], pq[16], pv[16];
    {
        const int p00 = sc * 256;
        const int rb0 = (p00 < 256) ? (b * 256 + (dir ? 255 - p00 : p00)) : (MC + b * 4096 + (dir ? 4095 - (p00 - 256) : (p00 - 256)));
        const int rs0 = dir ? -1 : 1;
#pragma unroll
        for (int i = 0; i < 16; ++i) { const unsigned idx = (unsigned)((rb0 + rs0 * (sg * 16 + i)) * INC + h * 128 + k);
            pz[i] = px[idx + zo]; pq[i] = px[idx]; pv[i] = px[idx + 1536]; }
    }
    f32x4 accS[8];
    if (PASS == 1 || sc == 0) {
#pragma unroll
        for (int vb = 0; vb < 8; ++vb) accS[vb] = (f32x4){0.f, 0.f, 0.f, 0.f};
    } else {
        const float* S0 = US + ((size_t)(seq * 16 + sc - 1) * 128) * 128;
#pragma unroll
        for (int vb = 0; vb < 8; ++vb)
#pragma unroll
            for (int j = 0; j < 4; ++j) accS[vb][j] = S0[(size_t)(wid * 16 + 4 * fq + j) * 128 + vb * 16 + fr];
    }
    if (PASS == 3) {
#pragma unroll
        for (int vb = 0; vb < 8; ++vb) { u32x2 w; w.x = pk2(accS[vb][0], accS[vb][1]); w.y = pk2(accS[vb][2], accS[vb][3]);
            *(LAS u32x2*)(ST + (vb * 16 + fr) * 136 + wid * 16 + 4 * fq) = w; }
    }
    float dtot[4] = {1.f, 1.f, 1.f, 1.f};

    for (int c = 0; c < 4; ++c) {
        const int p0 = sc * 256 + c * 64;
        const int rbase = (p0 < 256) ? (b * 256 + (dir ? 255 - p0 : p0)) : (MC + b * 4096 + (dir ? 4095 - (p0 - 256) : (p0 - 256)));
        const int rstep = dir ? -1 : 1;
        float cq[16], ck[16], cb[16]; bf16_t vv[16];
        float run = 0.f;
#pragma unroll
        for (int i = 0; i < 16; ++i) {
            const float zl = __uint_as_float(pz[i] << 16) * LOG2E;
            if (PASS == 3) cq[i] = __uint_as_float(pq[i] << 16);
            vv[i] = (bf16_t)pv[i];
            if (L0) { float ls, ln; logsig2(zl, ls, ln); ck[i] = ln; run += ls; }
            else {
                const float e = __builtin_amdgcn_exp2f(-fabsf(zl)); const float inv = __builtin_amdgcn_rcpf(1.0f + e); const float big = inv, small = e * inv;
                const float sig = zl >= 0.f ? big : small, nsig = zl >= 0.f ? small : big;
                ck[i] = omlb * nsig;
                run += __builtin_amdgcn_logf(fmaxf(lb + omlb * sig, 1e-30f));
            }
            cb[i] = run;
        }
        SEG[sg * 128 + k] = run;
        LBAR();
        const float s0 = SEG[k], s1 = SEG[128 + k], s2 = SEG[256 + k], s3 = SEG[384 + k];
        const float off = (sg > 0 ? s0 : 0.f) + (sg > 1 ? s1 : 0.f) + (sg > 2 ? s2 : 0.f);
        const float blast = (s0 + s1) + (s2 + s3), rr = 0.5f * blast, er = __builtin_amdgcn_exp2f(rr);
        if (sg == 0) DK[k] = er * er;
        unsigned kdp[8], vvp[8];
#pragma unroll
        for (int i = 0; i < 16; i += 2) {
            float kd2[2];
#pragma unroll
            for (int e = 0; e < 2; ++e) {
                const int ii = i + e; const int tau = sg * 16 + ii;
                const float d = rr - (off + cb[ii]);
                const float kt = L0 ? __builtin_amdgcn_exp2f(ck[ii] + d) : ck[ii] * __builtin_amdgcn_exp2f(d);
                kd2[e] = kt * er;
                if (PASS == 3) { const float qt = cq[ii] * __builtin_amdgcn_exp2f(-d); QT[tau * 136 + k] = f2bf(qt); QS[tau * 136 + k] = f2bf(qt * er); KT[tau * 136 + k] = f2bf(kt); }
            }
            kdp[i >> 1] = pk2(kd2[0], kd2[1]);
            vvp[i >> 1] = (unsigned)vv[i] | ((unsigned)vv[i + 1] << 16);
        }
        *(LAS u32x4*)(KDT + k * 72 + sg * 16) = (u32x4){kdp[0], kdp[1], kdp[2], kdp[3]};
        *(LAS u32x4*)(KDT + k * 72 + sg * 16 + 8) = (u32x4){kdp[4], kdp[5], kdp[6], kdp[7]};
        *(LAS u32x4*)(VT + k * 72 + sg * 16) = (u32x4){vvp[0], vvp[1], vvp[2], vvp[3]};
        *(LAS u32x4*)(VT + k * 72 + sg * 16 + 8) = (u32x4){vvp[4], vvp[5], vvp[6], vvp[7]};
        LBAR();
        if (c < 3) {
            const int rb2 = rbase + rstep * 64;
#pragma unroll
            for (int i = 0; i < 16; ++i) { const unsigned idx = (unsigned)((rb2 + rstep * (sg * 16 + i)) * INC + h * 128 + k);
                pz[i] = px[idx + zo]; pq[i] = px[idx]; pv[i] = px[idx + 1536]; }
        }

        if (PASS == 3) {
            f32x4 oacc[4];
#pragma unroll
            for (int tb = 0; tb < 4; ++tb) oacc[tb] = (f32x4){0.f, 0.f, 0.f, 0.f};
#pragma unroll
            for (int kp = 0; kp < 2; ++kp) {
                bf16x8 av[2], bq[2][4];
#pragma unroll
                for (int k2 = 0; k2 < 2; ++k2) { const int ks = kp * 2 + k2; av[k2] = *(const LAS bf16x8*)(ST + (wid * 16 + fr) * 136 + ks * 32 + fq * 8);
#pragma unroll
                    for (int tb = 0; tb < 4; ++tb) bq[k2][tb] = *(const LAS bf16x8*)(QS + (tb * 16 + fr) * 136 + ks * 32 + fq * 8); }
                asm volatile("" ::: "memory");
#pragma unroll
                for (int k2 = 0; k2 < 2; ++k2)
#pragma unroll
                    for (int tb = 0; tb < 4; ++tb) oacc[tb] = mfma16(av[k2], bq[k2][tb], oacc[tb]);
            }
#pragma unroll
            for (int e = 0; e < 2; ++e) { const int id = 2 * wid + e, sb = id >> 2, tb = id & 3;
                f32x4 sacc = (f32x4){0.f, 0.f, 0.f, 0.f};
                if (sb <= tb) {
                    bf16x8 av[4], bq[4];
#pragma unroll
                    for (int ks = 0; ks < 4; ++ks) { av[ks] = *(const LAS bf16x8*)(KT + (sb * 16 + fr) * 136 + ks * 32 + fq * 8); bq[ks] = *(const LAS bf16x8*)(QT + (tb * 16 + fr) * 136 + ks * 32 + fq * 8); }
                    asm volatile("" ::: "memory");
#pragma unroll
                    for (int ks = 0; ks < 4; ++ks) sacc = mfma16(av[ks], bq[ks], sacc); }
                const int t = tb * 16 + fr, s = sb * 16 + 4 * fq;
                float m[4];
#pragma unroll
                for (int j = 0; j < 4; ++j) m[j] = (s + j <= t) ? sacc[j] : 0.f;
                u32x2 w; w.x = pk2(m[0], m[1]); w.y = pk2(m[2], m[3]);
                *(LAS u32x2*)(P + t * 72 + s) = w; }
            LBAR();
            {
                bf16x8 av[2], bq[2][4];
#pragma unroll
                for (int ks = 0; ks < 2; ++ks) { av[ks] = *(const LAS bf16x8*)(VT + (wid * 16 + fr) * 72 + ks * 32 + fq * 8);
#pragma unroll
                    for (int tb = 0; tb < 4; ++tb) bq[ks][tb] = *(const LAS bf16x8*)(P + (tb * 16 + fr) * 72 + ks * 32 + fq * 8); }
                asm volatile("" ::: "memory");
#pragma unroll
                for (int ks = 0; ks < 2; ++ks)
#pragma unroll
                    for (int tb = 0; tb < 4; ++tb) oacc[tb] = mfma16(av[ks], bq[ks][tb], oacc[tb]);
            }
#pragma unroll
            for (int tb = 0; tb < 4; ++tb) { const int r = rbase + rstep * (tb * 16 + fr);
                u32x2 w; w.x = pk2(oacc[tb][0], oacc[tb][1]); w.y = pk2(oacc[tb][2], oacc[tb][3]);
                *(u32x2*)(px + (size_t)r * INC + zcol + wid * 16 + 4 * fq) = w; }
        }
        {
            float dk[4];
#pragma unroll
            for (int j = 0; j < 4; ++j) { dk[j] = DK[wid * 16 + 4 * fq + j]; dtot[j] *= dk[j]; }
#pragma unroll
            for (int vb = 0; vb < 8; ++vb)
#pragma unroll
                for (int j = 0; j < 4; ++j) accS[vb][j] *= dk[j];
#pragma unroll
            for (int ks = 0; ks < 2; ++ks) {
                bf16x8 bq[8]; const bf16x8 av = *(const LAS bf16x8*)(KDT + (wid * 16 + fr) * 72 + ks * 32 + fq * 8);
#pragma unroll
                for (int vb = 0; vb < 8; ++vb) bq[vb] = *(const LAS bf16x8*)(VT + (vb * 16 + fr) * 72 + ks * 32 + fq * 8);
                asm volatile("" ::: "memory");
#pragma unroll
                for (int vb = 0; vb < 8; ++vb) accS[vb] = mfma16(av, bq[vb], accS[vb]);
            }
            if (PASS == 3 && c < 3) {
#pragma unroll
                for (int vb = 0; vb < 8; ++vb) { u32x2 w; w.x = pk2(accS[vb][0], accS[vb][1]); w.y = pk2(accS[vb][2], accS[vb][3]);
                    *(LAS u32x2*)(ST + (vb * 16 + fr) * 136 + wid * 16 + 4 * fq) = w; }
            }
        }
        LBAR();
    }
    if (PASS == 1) {
        float* S1 = US + ((size_t)(seq * 16 + sc) * 128) * 128;
#pragma unroll
        for (int vb = 0; vb < 8; ++vb)
#pragma unroll
            for (int j = 0; j < 4; ++j) S1[(size_t)(wid * 16 + 4 * fq + j) * 128 + vb * 16 + fr] = accS[vb][j];
        if (fr == 0) {
#pragma unroll
            for (int j = 0; j < 4; ++j) DEC[(size_t)(seq * 17 + sc) * 128 + wid * 16 + 4 * fq + j] = dtot[j];
        }
    }
}

template <bool L0>
__device__ __forceinline__ void scan_pass1_unit(const Ctx& C, int tid, const bf16_t* px, float* US, float* DEC, const float* lbl, int layer, int seq, int sc) {
    const int dir = seq & 1, h = (seq >> 1) & 3, b = seq >> 3;
    const int lane = tid & 63, wid = __builtin_amdgcn_readfirstlane(tid >> 6), fr = lane & 15, fq = lane >> 4;
    LAS bf16_t* KDT = (LAS bf16_t*)(C.lds);
    LAS bf16_t* VT = (LAS bf16_t*)(C.lds + 67584);
    LAS float* DKc = (LAS float*)(C.lds + 135168);
    const int k = tid & 127, c = tid >> 7;
    float lb = 0.f;
    if (!L0) { const float l0 = lbl[(0 * 2 + dir) * 512 + h * 128 + k], l1 = lbl[(1 * 2 + dir) * 512 + h * 128 + k]; lb = sigmoidf_(l1 - l0); }
    const float omlb = 1.0f - lb;
    const int zcol = (dir ? 1024 : 512) + h * 128;
    const unsigned zo = (unsigned)(zcol - h * 128);
    const int p0 = sc * 256 + c * 64;
    const int rbase = (p0 < 256) ? (b * 256 + (dir ? 255 - p0 : p0)) : (MC + b * 4096 + (dir ? 4095 - (p0 - 256) : (p0 - 256)));
    const int rstep = dir ? -1 : 1;
    float R = 0.f;
    unsigned rz[16], rv[16];
#pragma unroll
    for (int i = 0; i < 16; ++i) { const unsigned idx = (unsigned)((rbase + rstep * (48 + i)) * INC + h * 128 + k); rz[i] = px[idx + zo]; rv[i] = px[idx + 1536]; }
#pragma unroll
    for (int p = 3; p >= 0; --p) {
        unsigned nz[16], nv[16];
        if (p > 0) {
#pragma unroll
            for (int i = 0; i < 16; ++i) { const unsigned idx = (unsigned)((rbase + rstep * ((p - 1) * 16 + i)) * INC + h * 128 + k); nz[i] = px[idx + zo]; nv[i] = px[idx + 1536]; }
        }
#pragma unroll
        for (int gh = 1; gh >= 0; --gh) {
            const int g = 2 * p + gh;
            float kd[8];
#pragma unroll
            for (int i = 7; i >= 0; --i) {
                const float zl = __uint_as_float(rz[gh * 8 + i] << 16) * LOG2E;
                if (L0) { float ls, ln; logsig2(zl, ls, ln); kd[i] = __builtin_amdgcn_exp2f(R + ln); R += ls; }
                else {
                    const float e = __builtin_amdgcn_exp2f(-fabsf(zl)); const float inv = __builtin_amdgcn_rcpf(1.0f + e); const float big = inv, small = e * inv;
                    const float sig = zl >= 0.f ? big : small, nsig = zl >= 0.f ? small : big;
                    kd[i] = omlb * nsig * __builtin_amdgcn_exp2f(R);
                    R += __builtin_amdgcn_logf(fmaxf(lb + omlb * sig, 1e-30f));
                }
            }
            *(LAS u32x4*)(KDT + k * 264 + c * 64 + g * 8) = (u32x4){pk2(kd[0], kd[1]), pk2(kd[2], kd[3]), pk2(kd[4], kd[5]), pk2(kd[6], kd[7])};
            const unsigned* v8 = rv + gh * 8;
            *(LAS u32x4*)(VT + k * 264 + c * 64 + g * 8) = (u32x4){v8[0] | (v8[1] << 16), v8[2] | (v8[3] << 16), v8[4] | (v8[5] << 16), v8[6] | (v8[7] << 16)};
        }
        if (p > 0) {
#pragma unroll
            for (int i = 0; i < 16; ++i) { rz[i] = nz[i]; rv[i] = nv[i]; }
        }
    }
    DKc[c * 128 + k] = __builtin_amdgcn_exp2f(R);
    __syncthreads();
    f32x4 accS[8];
#pragma unroll
    for (int vb = 0; vb < 8; ++vb) accS[vb] = (f32x4){0.f, 0.f, 0.f, 0.f};
    float dtot[4] = {1.f, 1.f, 1.f, 1.f};
#pragma unroll
    for (int cc = 0; cc < 4; ++cc) {
        float dk[4];
#pragma unroll
        for (int j = 0; j < 4; ++j) { dk[j] = DKc[cc * 128 + wid * 16 + 4 * fq + j]; dtot[j] *= dk[j]; }
        if (cc > 0) {
#pragma unroll
            for (int vb = 0; vb < 8; ++vb)
#pragma unroll
                for (int j = 0; j < 4; ++j) accS[vb][j] *= dk[j];
        }
#pragma unroll
        for (int ks = 0; ks < 2; ++ks) {
            bf16x8 bq[8]; const bf16x8 av = *(const LAS bf16x8*)(KDT + (wid * 16 + fr) * 264 + cc * 64 + ks * 32 + fq * 8);
#pragma unroll
            for (int vb = 0; vb < 8; ++vb) bq[vb] = *(const LAS bf16x8*)(VT + (vb * 16 + fr) * 264 + cc * 64 + ks * 32 + fq * 8);
            asm volatile("" ::: "memory");
#pragma unroll
            for (int vb = 0; vb < 8; ++vb) accS[vb] = mfma16(av, bq[vb], accS[vb]);
        }
    }
    float* S1 = US + ((size_t)(seq * 16 + sc) * 128) * 128;
#pragma unroll
    for (int vb = 0; vb < 8; ++vb)
#pragma unroll
        for (int j = 0; j < 4; ++j) S1[(size_t)(wid * 16 + 4 * fq + j) * 128 + vb * 16 + fr] = accS[vb][j];
    if (fr == 0) {
#pragma unroll
        for (int j = 0; j < 4; ++j) DEC[(size_t)(seq * 17 + sc) * 128 + wid * 16 + 4 * fq + j] = dtot[j];
    }
    __syncthreads();
}

__device__ __forceinline__ void phase_s2(const Ctx& C, float* US, const float* DEC) {
    PHASE_IDS();
    for (int idx = C.bid * NTHR + tid; idx < 32 * 4096; idx += C.G * NTHR) {
        const int seq = idx >> 12, kk = (idx & 4095) >> 5, v4 = idx & 31;
        float* p = US + ((size_t)(seq * 16) * 128 + kk) * 128 + v4 * 4;
        const float* dp = DEC + (size_t)(seq * 17) * 128 + kk;
        f32x4 U[16]; float d[16];
#pragma unroll
        for (int sc = 0; sc < 16; ++sc) { U[sc] = __builtin_nontemporal_load((const f32x4*)(p + (size_t)sc * 16384)); d[sc] = dp[sc * 128]; }
        f32x4 S = (f32x4){0.f, 0.f, 0.f, 0.f};
#pragma unroll
        for (int sc = 0; sc < 16; ++sc) { S = S * d[sc] + U[sc]; *(f32x4*)(p + (size_t)sc * 16384) = S; }
    }
}

__device__ __forceinline__ void gmlp_unit(const Ctx& C, int tid, const bf16_t* px, bf16_t* ycat, const float* w_s  , const float* b_s  , const float* ln_g, const float* ln_b, int cidx, int g) {
    LAS bf16_t* Wl = (LAS bf16_t*)(C.lds);
    LAS bf16_t* VnT = (LAS bf16_t*)(C.lds + 34816);
    const int r0 = cidx * 128, lane = tid & 63, wid = __builtin_amdgcn_readfirstlane(tid >> 6), fr = lane & 15, fq = lane >> 4;
    const float* W = w_s + (size_t)g * 128 * 128;
#pragma unroll
    for (int i = 0; i < 8; ++i) { const int f4 = tid + NTHR * i, t = f4 >> 5, s4 = (f4 & 31) * 4; const f32x4 v = *(const f32x4*)(W + t * 128 + s4);
        u32x2 w; w.x = pk2(v[0], v[1]); w.y = pk2(v[2], v[3]); *(LAS u32x2*)(Wl + t * 136 + s4) = w; }
    {
        const int s = tid >> 2, part = tid & 3, d0 = part * 16;
        const bf16_t* src = px + (size_t)(r0 + s) * INC + 2816 + g * 64 + d0;
        const u32x4 w0 = *(const u32x4*)src, w1 = *(const u32x4*)(src + 8);
        float x[16];
        x[0] = bflo(w0.x); x[1] = bfhi(w0.x); x[2] = bflo(w0.y); x[3] = bfhi(w0.y); x[4] = bflo(w0.z); x[5] = bfhi(w0.z); x[6] = bflo(w0.w); x[7] = bfhi(w0.w);
        x[8] = bflo(w1.x); x[9] = bfhi(w1.x); x[10] = bflo(w1.y); x[11] = bfhi(w1.y); x[12] = bflo(w1.z); x[13] = bfhi(w1.z); x[14] = bflo(w1.w); x[15] = bfhi(w1.w);
        float sm = 0.f;
#pragma unroll
        for (int i = 0; i < 16; ++i) { x[i] = gelu_tanh(x[i]); sm += x[i]; }
        sm += __shfl_xor(sm, 1); sm += __shfl_xor(sm, 2);
        const float mu = sm * (1.0f / 64.0f); float q = 0.f;
#pragma unroll
        for (int i = 0; i < 16; ++i) { x[i] -= mu; q += x[i] * x[i]; }
        q += __shfl_xor(q, 1); q += __shfl_xor(q, 2);
        const float rs = rsqrtf(q * (1.0f / 64.0f) + EPS);
#pragma unroll
        for (int i = 0; i < 16; ++i) { const int d = d0 + i; const float y = x[i] * rs * ln_g[g * 64 + d] + ln_b[g * 64 + d]; VnT[d * 136 + s] = f2bf(y); }
    }
    __syncthreads();
    f32x4 acc[4];
#pragma unroll
    for (int db = 0; db < 4; ++db) acc[db] = (f32x4){0.f, 0.f, 0.f, 0.f};
#pragma unroll
    for (int ks = 0; ks < 4; ++ks) { const bf16x8 bw = *(const LAS bf16x8*)(Wl + (wid * 16 + fr) * 136 + ks * 32 + fq * 8);
#pragma unroll
        for (int db = 0; db < 4; ++db) { const bf16x8 av = *(const LAS bf16x8*)(VnT + (db * 16 + fr) * 136 + ks * 32 + fq * 8); acc[db] = mfma16(av, bw, acc[db]); } }
    {
        const int t = wid * 16 + fr, r = r0 + t; const float bias = b_s[g * 128 + t];
        u32x2 uw[4];
#pragma unroll
        for (int db = 0; db < 4; ++db) uw[db] = *(const u32x2*)(px + (size_t)r * INC + 2560 + g * 64 + db * 16 + 4 * fq);
#pragma unroll
        for (int db = 0; db < 4; ++db) { const int col = g * 64 + db * 16 + 4 * fq;
            const float u0 = gelu_tanh(bflo(uw[db].x)), u1 = gelu_tanh(bfhi(uw[db].x)), u2 = gelu_tanh(bflo(uw[db].y)), u3 = gelu_tanh(bfhi(uw[db].y));
            u32x2 w; w.x = pk2(u0 * (acc[db][0] + bias), u1 * (acc[db][1] + bias)); w.y = pk2(u2 * (acc[db][2] + bias), u3 * (acc[db][3] + bias));
            *(u32x2*)(ycat + (size_t)r * DM + 512 + col) = w; }
    }
    __syncthreads();
}

__device__ __forceinline__ void conv_unit(const Ctx& C, int tid, const bf16_t* px, bf16_t* ycat, const float* dw_w  , const float* dw_b, const float* ln_g, const float* ln_b, const bf16_t* pwt  , const float* pw_b, int tix) {
    LAS float* Z = (LAS float*)(C.lds);
    LAS bf16_t* Hn = (LAS bf16_t*)(C.lds + 96256);
    LAS float* Wd = (LAS float*)(C.lds + 130048);
    const int r0 = tix * 64, lane = tid & 63, wid = __builtin_amdgcn_readfirstlane(tid >> 6), fr = lane & 15, fq = lane >> 4;
    const int seg_lo = (r0 < MC) ? (r0 & ~255) : r0, seg_hi = seg_lo + ((r0 < MC) ? 256 : 64);
    {
        f32x4 wv[4]; u32x4 aw[6], gw[6]; bool zin[6];
#pragma unroll
        for (int q = 0; q < 4; ++q) { const int it = tid + q * NTHR; wv[q] = (it < 31 * 64) ? *(const f32x4*)(dw_w + it * 4) : (f32x4){0.f, 0.f, 0.f, 0.f}; }
#pragma unroll
        for (int q = 0; q < 6; ++q) { const int it = tid + q * NTHR, zr = it >> 5, c8 = (it & 31) * 8, r = r0 - 15 + zr;
            zin[q] = (it < 94 * 32) && r >= seg_lo && r < seg_hi;
            const size_t ro = (size_t)(zin[q] ? r : r0) * INC;
            aw[q] = *(const u32x4*)(px + ro + 3072 + c8); gw[q] = *(const u32x4*)(px + ro + 3328 + c8); }
#pragma unroll
        for (int q = 0; q < 4; ++q) { const int it = tid + q * NTHR; if (it < 31 * 64) *(LAS f32x4*)(Wd + it * 4) = wv[q]; }
#pragma unroll
        for (int q = 0; q < 6; ++q) { const int it = tid + q * NTHR, zr = it >> 5, c8 = (it & 31) * 8;
            if (it < 94 * 32) {
                f32x4 z0 = (f32x4){0.f, 0.f, 0.f, 0.f}, z1 = z0;
                if (zin[q]) {
                    z0[0] = bflo(aw[q].x) * sigmoidf_(bflo(gw[q].x)); z0[1] = bfhi(aw[q].x) * sigmoidf_(bfhi(gw[q].x)); z0[2] = bflo(aw[q].y) * sigmoidf_(bflo(gw[q].y)); z0[3] = bfhi(aw[q].y) * sigmoidf_(bfhi(gw[q].y));
                    z1[0] = bflo(aw[q].z) * sigmoidf_(bflo(gw[q].z)); z1[1] = bfhi(aw[q].z) * sigmoidf_(bfhi(gw[q].z)); z1[2] = bflo(aw[q].w) * sigmoidf_(bflo(gw[q].w)); z1[3] = bfhi(aw[q].w) * sigmoidf_(bfhi(gw[q].w));
                }
                *(LAS f32x4*)(Z + zr * 256 + c8) = z0; *(LAS f32x4*)(Z + zr * 256 + c8 + 4) = z1;
            }
        }
    }
    __syncthreads();
    {
        const int t0 = wid * 8, c4 = lane * 4;
        f32x4 acc[8], win[8];
#pragma unroll
        for (int t = 0; t < 8; ++t) acc[t] = (f32x4){0.f, 0.f, 0.f, 0.f};
#pragma unroll
        for (int t = 0; t < 7; ++t) win[t] = *(const LAS f32x4*)(Z + (t0 + t) * 256 + c4);
#pragma unroll 1
        for (int j0 = 0; j0 < 32; j0 += 8) {
#pragma unroll
            for (int jj = 0; jj < 8; ++jj) {
                const int j = j0 + jj;
                if (j < 31) {
                    win[(jj + 7) & 7] = *(const LAS f32x4*)(Z + (t0 + j + 7) * 256 + c4);
                    const f32x4 wj = *(const LAS f32x4*)(Wd + j * 256 + c4);
#pragma unroll
                    for (int t = 0; t < 8; ++t) acc[t] += win[(t + jj) & 7] * wj;
                }
            }
        }
        const f32x4 bv = *(const f32x4*)(dw_b + c4), gv = *(const f32x4*)(ln_g + c4), bb = *(const f32x4*)(ln_b + c4);
#pragma unroll
        for (int t = 0; t < 8; ++t) {
            f32x4 x = acc[t] + bv;
            float sm = (x[0] + x[1]) + (x[2] + x[3]);
            sm += __shfl_xor(sm, 1); sm += __shfl_xor(sm, 2); sm += __shfl_xor(sm, 4); sm += __shfl_xor(sm, 8);
            const float mu = sm * (1.0f / 64.0f);
            x = x - mu;
            float q = (x[0] * x[0] + x[1] * x[1]) + (x[2] * x[2] + x[3] * x[3]);
            q += __shfl_xor(q, 1); q += __shfl_xor(q, 2); q += __shfl_xor(q, 4); q += __shfl_xor(q, 8);
            const float rs = rsqrtf(q * (1.0f / 64.0f) + EPS);
            const f32x4 y = x * rs * gv + bb;
            u32x2 w; w.x = pk2(siluf_(y[0]), siluf_(y[1])); w.y = pk2(siluf_(y[2]), siluf_(y[3]));
            *(LAS u32x2*)(Hn + (t0 + t) * 264 + c4) = w;
        }
    }
    __syncthreads();
    {
        f32x4 acc[2][4];
#pragma unroll
        for (int e = 0; e < 2; ++e)
#pragma unroll
            for (int tb = 0; tb < 4; ++tb) acc[e][tb] = (f32x4){0.f, 0.f, 0.f, 0.f};
#pragma unroll
        for (int ks = 0; ks < 8; ++ks) {
            bf16x8 bh[4];
#pragma unroll
            for (int tb = 0; tb < 4; ++tb) bh[tb] = *(const LAS bf16x8*)(Hn + (tb * 16 + fr) * 264 + ks * 32 + fq * 8);
#pragma unroll
            for (int e = 0; e < 2; ++e) { const bf16x8 aw = *(const bf16x8*)(pwt + (size_t)((2 * wid + e) * 16 + fr) * 256 + ks * 32 + fq * 8);
#pragma unroll
                for (int tb = 0; tb < 4; ++tb) acc[e][tb] = mfma16(aw, bh[tb], acc[e][tb]); }
        }
#pragma unroll
        for (int e = 0; e < 2; ++e) { const int o = (2 * wid + e) * 16 + 4 * fq; const f32x4 pb = *(const f32x4*)(pw_b + o);
#pragma unroll
            for (int tb = 0; tb < 4; ++tb) { const int r = r0 + tb * 16 + fr; const f32x4 y = acc[e][tb] + pb;
                u32x2 w; w.x = pk2(y[0], y[1]); w.y = pk2(y[2], y[3]);
                *(u32x2*)(ycat + (size_t)r * DM + 768 + o) = w; } }
    }
    __syncthreads();
}

__device__ __forceinline__ void phase_xa(const Ctx& C, const bf16_t* px, bf16_t* ycat, const float* onorm_g, int r_lo) {
    PHASE_IDS();
    const int gw = C.bid * 8 + wid, NGW = C.G * 8;
    const int col = 8 * lane;
    const f32x4 gn0 = *(const f32x4*)(onorm_g + col), gn1 = *(const f32x4*)(onorm_g + col + 4);
    for (int r = r_lo + gw; r < MT; r += 4 * NGW) {
        u32x4 wf[4], wb[4], wg[4]; bool ok[4];
#pragma unroll
        for (int q = 0; q < 4; ++q) { const int rq = r + q * NGW; ok[q] = rq < MT; const bf16_t* pr = px + (size_t)(ok[q] ? rq : r) * INC;
            wf[q] = __builtin_nontemporal_load((const u32x4*)(pr + 512 + col)); wb[q] = __builtin_nontemporal_load((const u32x4*)(pr + 1024 + col)); wg[q] = __builtin_nontemporal_load((const u32x4*)(pr + 2048 + col)); }
#pragma unroll
        for (int q = 0; q < 4; ++q) {
            float o[8];
            o[0] = bflo(wf[q].x) + bflo(wb[q].x); o[1] = bfhi(wf[q].x) + bfhi(wb[q].x); o[2] = bflo(wf[q].y) + bflo(wb[q].y); o[3] = bfhi(wf[q].y) + bfhi(wb[q].y);
            o[4] = bflo(wf[q].z) + bflo(wb[q].z); o[5] = bfhi(wf[q].z) + bfhi(wb[q].z); o[6] = bflo(wf[q].w) + bflo(wb[q].w); o[7] = bfhi(wf[q].w) + bfhi(wb[q].w);
            float ss = 0.f;
#pragma unroll
            for (int i = 0; i < 8; ++i) ss += o[i] * o[i];
            ss += __shfl_xor(ss, 1); ss += __shfl_xor(ss, 2); ss += __shfl_xor(ss, 4); ss += __shfl_xor(ss, 8);
            const float rs = rsqrtf(ss * (1.0f / 128.0f) + EPS);
            const float g0 = siluf_(bflo(wg[q].x)), g1 = siluf_(bfhi(wg[q].x)), g2 = siluf_(bflo(wg[q].y)), g3 = siluf_(bfhi(wg[q].y));
            const float g4 = siluf_(bflo(wg[q].z)), g5 = siluf_(bfhi(wg[q].z)), g6 = siluf_(bflo(wg[q].w)), g7 = siluf_(bfhi(wg[q].w));
            u32x4 w;
            w.x = pk2(o[0] * rs * gn0[0] * g0, o[1] * rs * gn0[1] * g1); w.y = pk2(o[2] * rs * gn0[2] * g2, o[3] * rs * gn0[3] * g3);
            w.z = pk2(o[4] * rs * gn1[0] * g4, o[5] * rs * gn1[1] * g5); w.w = pk2(o[6] * rs * gn1[2] * g6, o[7] * rs * gn1[3] * g7);
            if (ok[q]) *(u32x4*)(ycat + (size_t)(r + q * NGW) * DM + col) = w;
        }
    }
}

#ifdef DBG_STOP
__device__ __forceinline__ void dbg_digest(const Ctx& C, const XcdBarrier& bar, float* out, const bf16_t* pb, size_t nb, const float* pf, size_t nf) {
    xcd_barrier(bar);
    const size_t NO = (size_t)ML * DM;
    for (size_t i = (size_t)C.bid * NTHR + threadIdx.x; i < NO; i += (size_t)C.G * NTHR) {
        float s = 0.f;
        for (size_t j = i; j < nb; j += NO) s += bf2f(pb[j]);
        for (size_t j = i; j < nf; j += NO) s += pf[j];
        if (!(fabsf(s) < 1e30f)) s = 7777.0f;
        out[i] = s;
    }
}
#define DBG_AT(n, pb, nb, pf, nf) if (DBG_STOP == (n) && l == DBG_L) { dbg_digest(C, bar, a.out, (pb), (nb), (pf), (nf)); return; }
#else
#define DBG_AT(n, pb, nb, pf, nf)
#define DBG_L 0
#endif
__global__ void __launch_bounds__(NTHR, 2) fwd_megakernel(Args a) {
    extern __shared__ __attribute__((aligned(16))) unsigned char lds_raw[];
    cg::grid_group grid = cg::this_grid();
    Ctx C;
    C.lds = (LAS unsigned char*)lds_raw;
    C.G = gridDim.x; C.bid = blockIdx.x;
    volatile LAS unsigned* barw = (volatile LAS unsigned*)(C.lds + LDS_BARW);
    if (threadIdx.x < 4) barw[threadIdx.x] = 0u;
    for (int i = C.bid * NTHR + threadIdx.x; i < (int)(CTL_BYTES / 16); i += C.G * NTHR) ((u32x4*)(a.ws + WS_CTL))[i] = (u32x4){0u, 0u, 0u, 0u};
    __syncthreads();

    float* MOD = (float*)(a.ws + WS_MOD);
    float* DEC = (float*)(a.ws + WS_DEC);
    float* XC = (float*)(a.ws + WS_XC);
    bf16_t* ABF = (bf16_t*)(a.ws + WS_ABF);
    bf16_t* PX = (bf16_t*)(a.ws + WS_PX);
    float* US = (float*)(a.ws + WS_US);
    float* PTAIL = (float*)(a.ws + WS_PX + (size_t)MT * DFF * 2);

#ifdef DBG_TIME
    unsigned long long t_last = __builtin_amdgcn_s_memrealtime(); unsigned long long t_cat[12] = {0,0,0,0,0,0,0,0,0,0,0,0};
#define TS(c) do { const unsigned long long _n = __builtin_amdgcn_s_memrealtime(); t_cat[c] += _n - t_last; t_last = _n; } while (0)
#else
#define TS(c)
#endif
    phase_p0(C, a);
    grid.sync();
    XcdBarrier bar = xcd_barrier_post((unsigned*)(a.ws + WS_CTL), barw);
    TS(0);

    const int dbgl = (a.in[0] == nullptr) ? 1 : 0; (void)dbgl;
    for (int l = 0; l < 2; ++l) {
        unsigned char* wt = a.ws + WS_WT + (size_t)l * WT_LAYER;
        const float* mod_l = MOD + (size_t)l * 5 * 6144;
        const float* srcc = (l == 0) ? a.in[2] : XC;
        const float* srcl = (l == 0) ? a.in[0] : a.out;
        DBG_AT(17, PX, 0, a.out, (size_t)ML * DM)
        { CtxFix fx{PTAIL, US, 6, (l == 0) ? 0 : 11, MOD + (size_t)4 * 6144 + 5 * 1024, nullptr};
          phase_norm(C, srcc, srcl, a.in[6] + l * DM, mod_l, 0, 1, ABF, 0, (l == 0) ? MT : MC, fx); }
        if (l == 0) { for (int i = C.bid * NTHR + threadIdx.x; i < MC * DM / 4; i += C.G * NTHR) ((f32x4*)XC)[i] = ((const f32x4*)a.in[2])[i]; }
        GRID_BAR();
        TS(1);

#if defined(DBG_STOP) && DBG_STOP == 14
        if (l == 1) {
            xcd_barrier(bar);
            const bf16_t* w1 = (const bf16_t*)(a.ws + WS_WT + WT_LAYER + WT_IN);
            for (size_t i = (size_t)C.bid * NTHR + threadIdx.x; i < (size_t)ML * DM; i += (size_t)C.G * NTHR) {
                float v = 0.f;
                #define BADF(x) (!(fabsf(x) < 1e30f))
                if (BADF(bf2f(ABF[i])) || (i + (size_t)ML * DM < (size_t)MT * DM && BADF(bf2f(ABF[i + (size_t)ML * DM])))) v = 500.f;
                if (i < (size_t)MC * DM && BADF(XC[i])) v = 1000.f;
                if (BADF(a.out[i])) v = 2000.f;
                if (i < 61440 && BADF(MOD[i])) v = 3000.f;
                if (i < (size_t)INC * DM && BADF(bf2f(w1[i]))) v = 4000.f;
                a.out[i] = v;
            }
            return;
        }
#endif
        DBG_AT(15, PX, 0, a.out, (size_t)ML * DM)
        DBG_AT(16, ABF, (size_t)MT * DM, XC, (size_t)MC * DM)
        { pg8::Gemm g{ABF, (const bf16_t*)(wt + WT_IN)}; pg8::StaticOrder S; S.init(MT / 256, INC / 256, C.G, C.bid, 0);
          pg8::EpiBf16 E{PX, INC}; pg8::gemm_phase<DM, DM, true>(C.lds, g, S, E); }
        GRID_BAR();
        TS(2);
        DBG_AT(1, PX, (size_t)MT * INC, MOD, (size_t)2 * 5 * 6144)
        { const int tid = fresh_tid(); for (int u = C.bid; u < 32 * 16; u += C.G) { if (l == 0) scan_pass1_unit<true>(C, tid, PX, US, DEC, a.in[8], l, u & 31, u >> 5); else scan_pass1_unit<false>(C, tid, PX, US, DEC, a.in[8], l, u & 31, u >> 5); } }
        GRID_BAR();
        TS(3);
        phase_s2(C, US, DEC);
        GRID_BAR();
        TS(4);
        DBG_AT(2, PX, 0, US, (size_t)32 * 16 * 128 * 128)
        {
            const int tid = fresh_tid();
            const int sc0 = (l == 0) ? 0 : 1, nS = 32 * (17 - sc0);
            const int cb0 = (l == 0) ? 0 : 8, nB = (136 - cb0) * 4, ct0 = (l == 0) ? 0 : 16, nC = 272 - ct0;
            int nscan = 0;
            for (int u = C.bid; u < nS; u += C.G) { if (l == 0) scan_unit<3, true>(C, tid, PX, US, DEC, a.in[8], l, u & 31, sc0 + (u >> 5)); else scan_unit<3, false>(C, tid, PX, US, DEC, a.in[8], l, u & 31, sc0 + (u >> 5)); ++nscan; }
            const int extra = nS % C.G;
            const int nsmall = nB + nC;
            int first, stride;
            if (extra > 0 && extra < C.G) { if (C.bid < extra) { first = nsmall; stride = 1; } else { first = C.bid - extra; stride = C.G - extra; } }
            else { first = C.bid; stride = C.G; }
            for (int v = first; v < nsmall; v += stride) {
                if (v < nC) conv_unit(C, tid, PX, ABF, a.in[14] + (size_t)l * 31 * 256, a.in[15] + l * 256, a.in[16] + l * 256, a.in[17] + l * 256, (const bf16_t*)(wt + WT_PW), a.in[19] + l * 256, ct0 + v);
                else { const int w = v - nC; gmlp_unit(C, tid, PX, ABF, a.in[12] + (size_t)l * 4 * 128 * 128, a.in[13] + l * 512, a.in[10] + l * 256, a.in[11] + l * 256, cb0 + (w >> 2), w & 3); }
            }
            (void)nscan;
        }
        GRID_BAR();
        TS(5);
        DBG_AT(3, PX, (size_t)MT * INC, US, 0)
        DBG_AT(4, ABF, (size_t)MT * DM, US, 0)
        phase_xa(C, PX, ABF, a.in[9] + l * 512, (l == 0) ? 0 : MC);
        GRID_BAR();
        TS(6);
        DBG_AT(5, ABF, (size_t)MT * DM, US, 0)
        { pg8::Gemm g{ABF, (const bf16_t*)(wt + WT_OUT)}; pg8::StaticOrder S; S.init(ML / 256, DM / 256, C.G, C.bid, 4);
          float* xb = (float*)(a.ws + WS_XB) + (size_t)(l * 2 + 0) * ML * 4; unsigned* cn = (unsigned*)(a.ws + WS_CNT) + (size_t)(l * 2 + 0) * 64 * 64;
          if (l == 0) { pg8::EpiResNorm<false> E{a.in[0], a.out, mod_l + 2 * 1024, a.in[21] + l * DM, mod_l + 3 * 1024, mod_l + 4 * 1024, ABF, xb, cn}; pg8::gemm_phase<DM, DM, false>(C.lds, g, S, E); }
          else        { pg8::EpiResNorm<true>  E{a.out, US, mod_l + 2 * 1024, a.in[21] + l * DM, mod_l + 3 * 1024, mod_l + 4 * 1024, ABF, xb, cn}; pg8::gemm_phase<DM, DM, false>(C.lds, g, S, E); }
          if (l == 0) { pg8::SliceOrder SS; SS.init(4, C.G, C.bid);
              pg8::EpiPartial EA{US, US, 4}; pg8::gemm_phase<DM, 256, false>(C.lds, g, SS, EA); } }
        GRID_BAR();
        TS(7);
        DBG_AT(6, PX, 0, a.out, (size_t)ML * DM)
        DBG_AT(11, ABF, (size_t)MC * DM, XC, (size_t)MC * DM)
        if (l == 0) {
            { CtxFix fx{US, US, 4, 4, mod_l + (size_t)4 * 6144 + 2 * 1024, XC};
              phase_norm(C, XC, a.out, a.in[21] + l * DM, mod_l, 3, 4, ABF, 0, MC, fx); }
            GRID_BAR();
        }
        TS(1);
        DBG_AT(7, ABF, (size_t)MT * DM, US, 0)
        { const int pm0 = (l == 0) ? 0 : 4;
          pg8::Gemm g{ABF, (const bf16_t*)(wt + WT_13)}; pg8::StaticOrder S; S.init(MT / 256 - pm0, 2 * DFF / 256, C.G, C.bid, pm0);
          pg8::EpiSwiglu E{PX, DFF}; pg8::gemm_phase<DM, DM, true>(C.lds, g, S, E); }
        GRID_BAR();
        TS(8);
        DBG_AT(8, PX, (size_t)MT * DFF, US, 0)
        { pg8::Gemm g{PX, (const bf16_t*)(wt + WT_2)}; pg8::StaticOrder S; S.init(ML / 256, DM / 256, C.G, C.bid, 4);
          const float* mod_n = MOD + (size_t)1 * 5 * 6144;
          float* xb = (float*)(a.ws + WS_XB) + (size_t)(l * 2 + 1) * ML * 4; unsigned* cn = (unsigned*)(a.ws + WS_CNT) + (size_t)(l * 2 + 1) * 64 * 64;
          if (l == 0) { pg8::EpiResNorm<true> E{a.out, a.out, mod_l + 5 * 1024, a.in[6] + DM, mod_n, mod_n + 1024, ABF, xb, cn}; pg8::gemm_phase<DFF, DFF, false>(C.lds, g, S, E); }
          else        { pg8::EpiResNorm<true> E{US, a.out, mod_l + 5 * 1024, a.in[24], nullptr, nullptr, nullptr, xb, cn}; pg8::gemm_phase<DFF, DFF, false>(C.lds, g, S, E); }
          if (l == 0) { pg8::SliceOrder SS; SS.init(11, C.G, C.bid);
              pg8::EpiPartial EA{PTAIL, US, 6}; pg8::gemm_phase<DFF, 256, false>(C.lds, g, SS, EA); } }
        if (l == 0) GRID_BAR();
        TS(9);
        DBG_AT(10, PX, 0, a.out, (size_t)ML * DM)
    }
    { const int l = DBG_L; DBG_AT(9, PX, 0, a.out, (size_t)ML * DM) }
#ifdef DBG_TIME
    TS(10);
    __syncthreads();
    if (C.bid == 0) {
        unsigned long long ta = 0, tb = 0;
#pragma unroll
        for (int c = 0; c < 12; ++c) { if ((DBG_SEL_A >> c) & 1) ta += t_cat[c]; if ((DBG_SEL_B >> c) & 1) tb += t_cat[c]; }
        const float fa = (float)ta * 0.01f, fb = (float)tb * 0.01f;
        for (int i = threadIdx.x; i <= 1000; i += NTHR) a.out[i] = (i == 0) ? fa * 0.25f : fb * 0.01f;
    }
#endif
}

extern "C" void kernel_launch(void* const* d_in, const int* in_sizes, int n_in, void* d_out, int out_size, void* d_ws, size_t ws_size, hipStream_t stream) {
    static int grid = 0;
    if (grid == 0) {
        int dev = 0, cus = 0, per_cu = 0;
        hipGetDevice(&dev);
        hipDeviceGetAttribute(&cus, hipDeviceAttributeMultiprocessorCount, dev);
        hipFuncSetAttribute((const void*)fwd_megakernel, hipFuncAttributeMaxDynamicSharedMemorySize, LDS_BYTES);
        hipOccupancyMaxActiveBlocksPerMultiprocessor(&per_cu, (const void*)fwd_megakernel, NTHR, LDS_BYTES);
        if (per_cu < 1) per_cu = 1;
        grid = cus;
        if (ws_size < WS_END) fprintf(stderr, "kernel_launch: workspace too small: %zu < %zu\n", ws_size, (size_t)WS_END);
        (void)hipGetLastError();
    }
    Args a{};
    for (int i = 0; i < 25; ++i) a.in[i] = (const float*)d_in[i];
    a.out = (float*)d_out; a.ws = (unsigned char*)d_ws;
    void* args[] = {&a};
    hipError_t e = hipLaunchCooperativeKernel((const void*)fwd_megakernel, dim3(grid), dim3(NTHR), args, LDS_BYTES, stream);
    if (e != hipSuccess) fprintf(stderr, "cooperative launch failed: %s (grid %d)\n", hipGetErrorString(e), grid);
}
```
